# Optimizing an MI355X kernel written in HIP

```python
import math
import jax, jax.numpy as jnp
from jax import lax
import numpy as np

D_MODEL = 2048
BATCH = 2
SEQ = 8192
DEPTH = 1

HEAD_DIM = 128
N_HEADS_SB = D_MODEL // (2 * HEAD_DIM)
N_HEADS_MOBA = D_MODEL // (2 * HEAD_DIM)
SB_WIDTH = N_HEADS_SB * HEAD_DIM
MOBA_WIDTH = N_HEADS_MOBA * HEAD_DIM
MIX_WIDTH = SB_WIDTH + MOBA_WIDTH
SB_Q_BLOCK = 128
MOBA_BLOCK = 256
MOBA_TOPK = 3
MOBA_Q_CHUNK = 32
N_EXPERTS = 32
TOP_K = 4
D_FF = D_MODEL
SWIGLU_LIMIT = 7.0
SWIGLU_ALPHA = 1.702
EXPERT_ROW_BLOCK = 256
PLE_DIM = 256
LN_EPS = 1e-5
RMS_EPS = 1e-6
NEG_INF = -1e30
DEEPNORM_ALPHA = (2.0 * DEPTH) ** 0.25
DEEPNORM_BETA = (8.0 * DEPTH) ** -0.25

kernel_name = 'hybrid_stickbreak_moba_moe_deepnorm'


def alibi_slopes(n):
    return jnp.asarray(2.0 ** (-8.0 * np.arange(1, n + 1) / n), dtype=jnp.float32)


def layer_norm(x, g, b):
    xf = x.astype(jnp.float32)
    mu = jnp.mean(xf, axis=-1, keepdims=True)
    var = jnp.mean(jnp.square(xf - mu), axis=-1, keepdims=True)
    y = (xf - mu) * lax.rsqrt(var + LN_EPS)
    return (y * g + b).astype(x.dtype)


def head_rms_norm(o, gain):
    b, h, s, d = o.shape
    of = o.astype(jnp.float32)
    y = of * lax.rsqrt(jnp.mean(jnp.square(of), axis=-1, keepdims=True) + RMS_EPS)
    y = y.transpose(0, 2, 1, 3).reshape(b, s, h * d)
    return (y * gain).astype(o.dtype)


def to_heads(t, n_heads):
    b, s, _ = t.shape
    return t.reshape(b, s, n_heads, HEAD_DIM).transpose(0, 2, 1, 3)


def stick_breaking_attention(q, k, v):
    b, h, s, d = q.shape
    n_blk = s // SB_Q_BLOCK
    scale = 1.0 / math.sqrt(d)
    key_pos = jnp.arange(s)

    def one_block(i):
        q0 = i * SB_Q_BLOCK
        qb = lax.dynamic_slice_in_dim(q, q0, SB_Q_BLOCK, axis=2)
        z = jnp.einsum('bhqd,bhkd->bhqk', qb, k).astype(jnp.float32) * scale
        qpos = q0 + jnp.arange(SB_Q_BLOCK)
        past = key_pos[None, :] < qpos[:, None]
        log_keep = jnp.where(past, jax.nn.log_sigmoid(-z), 0.0)
        between = lax.cumsum(log_keep, axis=3, reverse=True) - log_keep
        w = jnp.where(past, jnp.exp(jax.nn.log_sigmoid(z) + between), 0.0)
        return jnp.einsum('bhqk,bhkd->bhqd', w.astype(v.dtype), v)

    out = lax.map(one_block, jnp.arange(n_blk))
    return out.transpose(1, 2, 0, 3, 4).reshape(b, h, s, d)


def moba_attention(q, k, v, slopes):
    b, h, s, d = q.shape
    n_kb = -(-s // MOBA_BLOCK)
    s_pad = n_kb * MOBA_BLOCK
    pad = [(0, 0), (0, 0), (0, s_pad - s), (0, 0)]
    q = jnp.pad(q, pad)
    k = jnp.pad(k, pad)
    v = jnp.pad(v, pad)
    top = min(MOBA_TOPK, n_kb)
    scale = 1.0 / math.sqrt(d)
    k_blocks = k.reshape(b, h, n_kb, MOBA_BLOCK, d)
    v_blocks = v.reshape(b, h, n_kb, MOBA_BLOCK, d)
    k_mean = jnp.mean(k_blocks.astype(jnp.float32), axis=3).astype(k.dtype)
    blk_off = jnp.arange(MOBA_BLOCK)
    blk_ids = jnp.arange(n_kb)
    m = slopes.reshape(1, h, 1, 1)
    take = jax.vmap(jax.vmap(lambda blocks, idx: blocks[idx]))

    def one_chunk(i):
        q0 = i * MOBA_Q_CHUNK
        own = q0 // MOBA_BLOCK
        qc = lax.dynamic_slice_in_dim(q, q0, MOBA_Q_CHUNK, axis=2)
        qpos = q0 + jnp.arange(MOBA_Q_CHUNK)
        gate = jnp.einsum('bhqd,bhnd->bhqn', qc, k_mean).astype(jnp.float32)
        gate = jnp.where(blk_ids < own, gate, -jnp.inf)
        _, idx = lax.top_k(gate, top)
        sel_valid = idx < own
        k_sel = take(k_blocks, idx)
        v_sel = take(v_blocks, idx)
        s_sel = jnp.einsum('bhqd,bhqnld->bhqnl', qc, k_sel).astype(jnp.float32) * scale
        pos_sel = idx[..., None] * MOBA_BLOCK + blk_off
        dist_sel = (qpos[:, None, None] - pos_sel).astype(jnp.float32)
        s_sel = s_sel - m[..., None] * dist_sel
        s_sel = jnp.where(sel_valid[..., None], s_sel, NEG_INF)
        k_own = lax.dynamic_slice_in_dim(k, own * MOBA_BLOCK, MOBA_BLOCK, axis=2)
        v_own = lax.dynamic_slice_in_dim(v, own * MOBA_BLOCK, MOBA_BLOCK, axis=2)
        own_pos = own * MOBA_BLOCK + blk_off
        dist_own = (qpos[:, None] - own_pos[None, :]).astype(jnp.float32)
        s_own = jnp.einsum('bhqd,bhld->bhql', qc, k_own).astype(jnp.float32) * scale - m * dist_own
        s_own = jnp.where(own_pos[None, :] <= qpos[:, None], s_own, NEG_INF)
        logits = jnp.concatenate([s_sel.reshape(b, h, MOBA_Q_CHUNK, top * MOBA_BLOCK), s_own], axis=-1)
        probs = jax.nn.softmax(logits, axis=-1).astype(v.dtype)
        p_sel = probs[..., :top * MOBA_BLOCK].reshape(b, h, MOBA_Q_CHUNK, top, MOBA_BLOCK)
        p_own = probs[..., top * MOBA_BLOCK:]
        return (jnp.einsum('bhqnl,bhqnld->bhqd', p_sel, v_sel)
                + jnp.einsum('bhql,bhld->bhqd', p_own, v_own))

    out = lax.map(one_chunk, jnp.arange(s_pad // MOBA_Q_CHUNK))
    out = out.transpose(1, 2, 0, 3, 4).reshape(b, h, s_pad, d)
    return out[:, :, :s]


def moe_ffn(x, w_router, b_router, w_up, b_up, w_down, b_down):
    b, s, d = x.shape
    xf = x.reshape(-1, d)
    n = xf.shape[0]
    logits = (xf @ w_router + b_router).astype(jnp.float32)
    top_vals, top_idx = lax.top_k(logits, TOP_K)
    gates = jax.nn.softmax(top_vals, axis=-1).astype(x.dtype)
    n_assign = n * TOP_K
    flat_e = top_idx.reshape(-1)
    flat_tok = jnp.repeat(jnp.arange(n, dtype=jnp.int32), TOP_K)
    flat_g = gates.reshape(-1)
    order = jnp.argsort(flat_e)
    e_sorted = flat_e[order]
    counts = jnp.bincount(flat_e, length=N_EXPERTS)
    padded = (counts + EXPERT_ROW_BLOCK - 1) // EXPERT_ROW_BLOCK * EXPERT_ROW_BLOCK
    pad_end = jnp.cumsum(padded)
    pad_start = pad_end - padded
    start = jnp.cumsum(counts) - counts
    dest = pad_start[e_sorted] + (jnp.arange(n_assign) - start[e_sorted])
    n_blocks = -(-n_assign // EXPERT_ROW_BLOCK) + N_EXPERTS
    n_rows = n_blocks * EXPERT_ROW_BLOCK
    row_tok = jnp.full((n_rows,), n, dtype=jnp.int32).at[dest].set(flat_tok[order])
    row_gate = jnp.zeros((n_rows,), dtype=x.dtype).at[dest].set(flat_g[order])
    block_e = jnp.minimum(
        jnp.searchsorted(pad_end, jnp.arange(n_blocks) * EXPERT_ROW_BLOCK, side='right'),
        N_EXPERTS - 1)
    x_ext = jnp.concatenate([xf, jnp.zeros((1, d), xf.dtype)], axis=0)

    def expert_block(args):
        tok, gate, e = args
        xb = x_ext[tok]
        hdn = xb @ w_up[e] + b_up[e]
        glu = jnp.minimum(hdn[:, 0::2], SWIGLU_LIMIT)
        lin = jnp.clip(hdn[:, 1::2], -SWIGLU_LIMIT, SWIGLU_LIMIT)
        act = glu * jax.nn.sigmoid(SWIGLU_ALPHA * glu) * (lin + 1.0)
        return (act @ w_down[e] + b_down[e]) * gate[:, None]

    y = lax.map(expert_block, (row_tok.reshape(n_blocks, EXPERT_ROW_BLOCK),
                               row_gate.reshape(n_blocks, EXPERT_ROW_BLOCK), block_e))
    out = jnp.zeros((n + 1, d), dtype=x.dtype).at[row_tok].add(y.reshape(n_rows, d))[:n]
    return out.reshape(b, s, d)


def setup_inputs(seed: int = 0) -> dict:
    key = jax.random.key(seed)
    ks = jax.random.split(key, 20)
    f32 = jnp.float32
    beta = DEEPNORM_BETA

    def nrm(k, shape, scale):
        return jax.random.normal(k, shape, f32) * scale

    col_scale = np.ones((3 * MIX_WIDTH,), np.float32)
    col_scale[2 * SB_WIDTH:3 * SB_WIDTH] = beta
    col_scale[3 * SB_WIDTH + 2 * MOBA_WIDTH:] = beta
    x = nrm(ks[0], (BATCH, SEQ, D_MODEL), 1.0)
    p = nrm(ks[1], (DEPTH, BATCH, SEQ, PLE_DIM), 1.0)
    w_in = nrm(ks[2], (DEPTH, D_MODEL, 3 * MIX_WIDTH), D_MODEL ** -0.5) * jnp.asarray(col_scale)
    norm_sb = 1.0 + nrm(ks[3], (DEPTH, SB_WIDTH), 0.02)
    norm_moba = 1.0 + nrm(ks[4], (DEPTH, MOBA_WIDTH), 0.02)
    w_out = nrm(ks[5], (DEPTH, MIX_WIDTH, D_MODEL), MIX_WIDTH ** -0.5 * beta)
    ln1_g = 1.0 + nrm(ks[6], (DEPTH, D_MODEL), 0.02)
    ln1_b = nrm(ks[7], (DEPTH, D_MODEL), 0.02)
    w_router = nrm(ks[8], (DEPTH, D_MODEL, N_EXPERTS), D_MODEL ** -0.5)
    b_router = nrm(ks[9], (DEPTH, N_EXPERTS), 0.01)
    w_up = nrm(ks[10], (DEPTH, N_EXPERTS, D_MODEL, 2 * D_FF), D_MODEL ** -0.5 * beta)
    b_up = nrm(ks[11], (DEPTH, N_EXPERTS, 2 * D_FF), 0.01)
    w_down = nrm(ks[12], (DEPTH, N_EXPERTS, D_FF, D_MODEL), D_FF ** -0.5 * beta)
    b_down = nrm(ks[13], (DEPTH, N_EXPERTS, D_MODEL), 0.01)
    ln2_g = 1.0 + nrm(ks[14], (DEPTH, D_MODEL), 0.02)
    ln2_b = nrm(ks[15], (DEPTH, D_MODEL), 0.02)
    w_ple = nrm(ks[16], (DEPTH, PLE_DIM, D_MODEL), PLE_DIM ** -0.5)
    w_ple_gate = nrm(ks[17], (DEPTH, D_MODEL, D_MODEL), D_MODEL ** -0.5)
    b_ple_gate = nrm(ks[18], (DEPTH, D_MODEL), 0.01)
    return {'x': x, 'p': p, 'w_in': w_in, 'norm_sb': norm_sb, 'norm_moba': norm_moba,
            'w_out': w_out, 'ln1_g': ln1_g, 'ln1_b': ln1_b, 'w_router': w_router,
            'b_router': b_router, 'w_up': w_up, 'b_up': b_up, 'w_down': w_down,
            'b_down': b_down, 'ln2_g': ln2_g, 'ln2_b': ln2_b, 'w_ple': w_ple,
            'w_ple_gate': w_ple_gate, 'b_ple_gate': b_ple_gate}


def reference(x, p, w_in, norm_sb, norm_moba, w_out, ln1_g, ln1_b, w_router, b_router,
              w_up, b_up, w_down, b_down, ln2_g, ln2_b, w_ple, w_ple_gate, b_ple_gate):
    slopes = alibi_slopes(N_HEADS_MOBA)
    splits = [SB_WIDTH, 2 * SB_WIDTH, 3 * SB_WIDTH,
              3 * SB_WIDTH + MOBA_WIDTH, 3 * SB_WIDTH + 2 * MOBA_WIDTH]
    for i in range(DEPTH):
        proj = x @ w_in[i]
        q_sb, k_sb, v_sb, q_mb, k_mb, v_mb = jnp.split(proj, splits, axis=-1)
        o_sb = stick_breaking_attention(to_heads(q_sb, N_HEADS_SB), to_heads(k_sb, N_HEADS_SB),
                                        to_heads(v_sb, N_HEADS_SB))
        o_mb = moba_attention(to_heads(q_mb, N_HEADS_MOBA), to_heads(k_mb, N_HEADS_MOBA),
                              to_heads(v_mb, N_HEADS_MOBA), slopes)
        mixed = jnp.concatenate([head_rms_norm(o_sb, norm_sb[i]),
                                 head_rms_norm(o_mb, norm_moba[i])], axis=-1)
        y = mixed @ w_out[i]
        x = layer_norm(DEEPNORM_ALPHA * x + y, ln1_g[i], ln1_b[i])
        f = moe_ffn(x, w_router[i], b_router[i], w_up[i], b_up[i], w_down[i], b_down[i])
        x = layer_norm(DEEPNORM_ALPHA * x + f, ln2_g[i], ln2_b[i])
        x = x + jax.nn.sigmoid(x @ w_ple_gate[i] + b_ple_gate[i]) * (p[i] @ w_ple[i])
    return x
```

```cpp
#include <hip/hip_runtime.h>
#include <cstdio>
#include <cstdint>
#include <cmath>

#define GAS __attribute__((address_space(1)))
#define LAS __attribute__((address_space(3)))
typedef unsigned short bf16;
typedef unsigned short bf16_t;
typedef short bf16x8 __attribute__((ext_vector_type(8)));
typedef float f32x4 __attribute__((ext_vector_type(4)));
typedef float f32x2 __attribute__((ext_vector_type(2)));
typedef float f32x16 __attribute__((ext_vector_type(16)));
typedef unsigned u32x4 __attribute__((ext_vector_type(4)));
typedef unsigned u32x2 __attribute__((ext_vector_type(2)));
typedef GAS unsigned gu32;
#define RLX_AGENT __ATOMIC_RELAXED, __HIP_MEMORY_SCOPE_AGENT
#define LDS_WAIT() asm volatile("s_waitcnt lgkmcnt(0)" ::: "memory")
#define VM_WAIT() asm volatile("s_waitcnt vmcnt(0)" ::: "memory")

constexpr int BATCH = 2, SEQ = 8192, M = BATCH * SEQ, D = 2048, NQKV = 6144, HD = 128, NH = 8, NE = 32, TOPK = 4, DFF = 2048, PLE = 256;
constexpr int ECAP = 16384;
constexpr int ACT_ROWS = M * TOPK + NE * 256;
constexpr float LN_EPS = 1e-5f, RMS_EPS = 1e-6f;
constexpr float DN_ALPHA = 1.189207115002721f;
constexpr float LOG2E = 1.4426950408889634f;
constexpr float QSCALE = 0.08838834764831845f * LOG2E;
constexpr float SWIGLU_LIMIT = 7.0f, SWIGLU_ALPHA = 1.702f;
constexpr float YSCALE = 64.f;
constexpr float WSCALE = 512.f, XSCALE = 16.f, ASCALE = 8.f, UP_DESCALE = 1.f / (512.f * 16.f), DN_DESCALE = 1.f / (512.f * 8.f);

constexpr size_t MiB = 1u << 20;
constexpr size_t WS_CTL = 0, CTL_ZERO_BYTES = 1 * MiB;
constexpr size_t WS_WINT = 2 * MiB, WS_WOUTT = 26 * MiB, WS_WGT = 34 * MiB, WS_WPLET = 42 * MiB, WS_BUPP = 43 * MiB, WS_KMEAN = 44 * MiB;
constexpr size_t WS_XB = 48 * MiB, WS_PB = 112 * MiB, WS_QKV = 128 * MiB, WS_MIXED = 320 * MiB, WS_H = 384 * MiB, WS_X1 = 512 * MiB, WS_X1B = 640 * MiB;
constexpr size_t WS_PLEB = 704 * MiB, WS_ROWTOK = 768 * MiB, WS_ROWG = 770 * MiB, WS_TOKSL = 772 * MiB, WS_X2B = 776 * MiB;
constexpr size_t WS_ACT = 840 * MiB, WS_Y = 1128 * MiB, WS_WUPT = 1416 * MiB, WS_WDNT = 1928 * MiB;
constexpr size_t WS_MLIST = 2184 * MiB, WS_MPO = 2200 * MiB, WS_MPML = 2328 * MiB, WS_X1Q = 2336 * MiB, WS_X2Q = 2368 * MiB, WS_END = 2400 * MiB;
static_assert((size_t)ACT_ROWS * DFF * 2 <= 288 * MiB, "act rows");
constexpr int CW_TMO = 0, CW_CODE = 1;
constexpr int CW_BAR = 4096;
constexpr int CW_MCNT = 32768;
constexpr int CW_DONE = 49152;
constexpr int CW_CUR = 53248;
constexpr int CW_ECNT = 16384;

constexpr int RING_OFF = 0, RING_BYTES = 131072;
constexpr int LDSCTL_OFF = 135168;
constexpr int MISC_OFF = LDSCTL_OFF;
constexpr int MOE_OFF = LDSCTL_OFF + 256;
constexpr int LDS_BYTES = 163840;

__device__ __forceinline__ unsigned f2bf(float f) { unsigned u = __builtin_bit_cast(unsigned, f); return (u + 0x7fffu + ((u >> 16) & 1u)) >> 16; }
__device__ __forceinline__ unsigned pk2(float lo, float hi) { return f2bf(lo) | (f2bf(hi) << 16); }
__device__ __forceinline__ float bf_lo(unsigned w) { return __builtin_bit_cast(float, w << 16); }
__device__ __forceinline__ float bf_hi(unsigned w) { return __builtin_bit_cast(float, w & 0xffff0000u); }

__device__ __forceinline__ float clamp448(float v) { return __builtin_amdgcn_fmed3f(v, -448.f, 448.f); }
__device__ __forceinline__ unsigned pack_fp8x4(float a, float b, float c, float d) {
    unsigned w = 0; w = __builtin_amdgcn_cvt_pk_fp8_f32(clamp448(a), clamp448(b), w, false); w = __builtin_amdgcn_cvt_pk_fp8_f32(clamp448(c), clamp448(d), w, true); return w;
}

__device__ __forceinline__ unsigned pack_fp8x4_nc(float a, float b, float c, float d) {
    unsigned w = 0; w = __builtin_amdgcn_cvt_pk_fp8_f32(a, b, w, false); w = __builtin_amdgcn_cvt_pk_fp8_f32(c, d, w, true); return w;
}

namespace pg8 {
constexpr bool DMA_IN_MMA = false;
constexpr bool BAL_DMA = true;
constexpr int BM = 256, BK = 64, HALF = 128, HTB = HALF * BK * 2, STAGE_BYTES = 8 * HTB;
__host__ __device__ __forceinline__ int lds_byte(int r, int c) { const int st = (r >> 4) * 2 + (c >> 5), rr = r & 15, cc = c & 31, ob = rr * 64 + cc * 2; return st * 1024 + (ob ^ (((ob >> 9) & 1) << 5)); }
__host__ __device__ __forceinline__ void stage_rc(int b, int& R, int& C) { const int st = b / 1024, sb = b % 1024, swz = sb ^ (((sb >> 9) & 1) << 5); R = (st >> 1) * 16 + swz / 64; C = (st & 1) * 32 + (swz % 64) / 2; }
__host__ __device__ __forceinline__ int q_f(int r) { return ((r >> 1) & 1) | (((r >> 3) & 1) << 2); }
__host__ __device__ __forceinline__ int lds_byte_q(int r, int c16) { return r * 128 + 16 * (c16 ^ q_f(r & 15)); }
__host__ __device__ __forceinline__ void stage_rc_q(int b, int& R, int& C) { const int s = b >> 4; R = s >> 3; C = 8 * ((s & 7) ^ q_f(R & 15)); }
__host__ __device__ __forceinline__ int perm32(int rho) { const int n = rho >> 4, i = rho & 15; return 8 * (i >> 2) + 4 * n + (i & 3); }

struct Unit { int pm, pn, e, tab, cnt; };
struct Gemm { const bf16_t* A; const bf16_t* Bt; int K; size_t bstride; const int* rowtab; };

__device__ __forceinline__ unsigned cvt_pk_bf16(float lo, float hi) { unsigned r; asm volatile("v_cvt_pk_bf16_f32 %0, %1, %2" : "=v"(r) : "v"(lo), "v"(hi)); return r; }

typedef int v8i __attribute__((ext_vector_type(8)));
typedef int v8i_u __attribute__((ext_vector_type(8), aligned(16)));
template <class Epi, class Sched, bool GATHER, bool ALIGN_EPI, bool FP8 = false>
__device__ __forceinline__ void gemm_phase(LAS unsigned char* lds, const Gemm g, const Sched& S, const Epi& E) {
    const int tid = threadIdx.x, wid = __builtin_amdgcn_readfirstlane(tid >> 6), lane = tid & 63, wr = wid >> 2, wc = wid & 3, fr = lane & 15, fq = lane >> 4;
    const int K = g.K, nt = K / BK;
    unsigned voffA[2], voffB[2]; int RA[2], CA[2];
#pragma unroll
    for (int i = 0; i < 2; ++i) { int R, C; if constexpr (FP8) stage_rc_q(tid * 16 + i * 8192, R, C); else stage_rc(tid * 16 + i * 8192, R, C); const int Rb = Epi::PERM ? ((R & ~31) + perm32(R & 31)) : R;
        voffA[i] = (unsigned)(R * K + C) * 2u; voffB[i] = (unsigned)(Rb * K + C) * 2u; RA[i] = R; CA[i] = C; }
    const size_t kstep = (size_t)(BK * 2);
    const size_t hstep = (size_t)HALF * K * 2;
    const size_t tstep = 2 * hstep;
    const unsigned ldsw = (unsigned)wid * 1024u;
    const int aoff = lds_byte(wr * 64 + fr, fq * 8), boff = lds_byte(wc * 32 + fr, fq * 8);
    const int aoq0 = lds_byte_q(wr * 64 + fr, 2 * fq), aoq1 = lds_byte_q(wr * 64 + fr, 2 * fq + 1), boq0 = lds_byte_q(wc * 32 + fr, 2 * fq), boq1 = lds_byte_q(wc * 32 + fr, 2 * fq + 1);
#define PG8_SA(b, h) (((b) * 2 + (h)) * HTB)
#define PG8_SB(b, h) ((4 + (b) * 2 + (h)) * HTB)
#define PG8_STAGE(bufoff, gbase, voff) do { _Pragma("unroll") for (int _i = 0; _i < 2; ++_i) { unsigned keep_; \
        asm volatile("s_mov_b32 %0, m0\n\ts_mov_b32 m0, %3\n\ts_nop 0\n\tglobal_load_lds_dwordx4 %1, %2\n\ts_mov_b32 m0, %0" \
            : "=&s"(keep_) : "v"((voff)[_i]), "s"((const char*)(gbase)), "s"((unsigned)(uintptr_t)(lds + (bufoff) + _i * 8192) + ldsw) : "memory"); } } while (0)
#define PG8_LDQ(dst, base, o0, o1) do { const u32x4 lo_ = *(const LAS u32x4*)(lds + (base) + (o0)), hi_ = *(const LAS u32x4*)(lds + (base) + (o1)); \
        dst = (v8i){(int)lo_.x, (int)lo_.y, (int)lo_.z, (int)lo_.w, (int)hi_.x, (int)hi_.y, (int)hi_.z, (int)hi_.w}; } while (0)
#define PG8_LDA(dst, b, h) do { if constexpr (FP8) { _Pragma("unroll") for (int m = 0; m < 4; ++m) PG8_LDQ(dst##q[m], PG8_SA(b, h) + m * 2048, aoq0, aoq1); } \
        else { _Pragma("unroll") for (int m = 0; m < 4; ++m) _Pragma("unroll") for (int k = 0; k < 2; ++k) dst[m][k] = *(const LAS bf16x8*)(lds + PG8_SA(b, h) + aoff + m * 2048 + k * 1024); } } while (0)
#define PG8_LDB(dst, b, h) do { if constexpr (FP8) { _Pragma("unroll") for (int n = 0; n < 2; ++n) PG8_LDQ(dst##q[n], PG8_SB(b, h) + n * 2048, boq0, boq1); } \
        else { _Pragma("unroll") for (int n = 0; n < 2; ++n) _Pragma("unroll") for (int k = 0; k < 2; ++k) dst[n][k] = *(const LAS bf16x8*)(lds + PG8_SB(b, h) + boff + n * 2048 + k * 1024); } } while (0)
#define PG8_MMA(ai, bj, At, Bt) do { __builtin_amdgcn_s_setprio(1); if constexpr (FP8) { _Pragma("unroll") for (int m = 0; m < 4; ++m) _Pragma("unroll") for (int n = 0; n < 2; ++n) \
            asm volatile("v_mfma_scale_f32_16x16x128_f8f6f4 %0, %1, %2, %0, %3, %3 op_sel_hi:[0,0,0]" : "+v"(acc[ai][bj][m][n]) : "v"(Bt##q[n]), "v"(At##q[m]), "v"(one_scale)); } \
        else { _Pragma("unroll") for (int m = 0; m < 4; ++m) _Pragma("unroll") for (int n = 0; n < 2; ++n) _Pragma("unroll") for (int k = 0; k < 2; ++k) \
            acc[ai][bj][m][n] = __builtin_amdgcn_mfma_f32_16x16x32_bf16(Bt[n][k], At[m][k], acc[ai][bj][m][n], 0, 0, 0); } __builtin_amdgcn_s_setprio(0); } while (0)
#define PG8_WAIT_V(n) asm volatile("s_waitcnt vmcnt(" #n ")" ::: "memory")
#define PG8_WAIT_L(n) asm volatile("s_waitcnt lgkmcnt(" #n ")" ::: "memory")
#define PG8_BAR __builtin_amdgcn_s_barrier()
#define PG8_SCHED __builtin_amdgcn_sched_barrier(0)
    const int one_scale = 0x7f7f7f7f;
    Unit cur, nxt; int ui = 0;
    if (!S.next(0, cur)) return;
    f32x4 acc[2][2][4][2];
#pragma unroll
    for (int a = 0; a < 2; ++a)
#pragma unroll
        for (int b = 0; b < 2; ++b)
#pragma unroll
            for (int m = 0; m < 4; ++m)
#pragma unroll
                for (int n = 0; n < 2; ++n) acc[a][b][m][n] = (f32x4){0.f, 0.f, 0.f, 0.f};
    bf16x8 At[4][2], B0[2][2], B1[2][2]; v8i Atq[4], B0q[2], B1q[2];
    unsigned voA[2][2], voN[2][2];
    const char* cA; const char* cB;
#define PG8_UNIT_PTRS(u, pa, pb, vo) do { \
        pb = (const char*)g.Bt + ((size_t)(u).e * g.bstride) * 2 + (size_t)(u).pn * tstep; \
        if constexpr (GATHER) { pa = (const char*)g.A; \
            _Pragma("unroll") for (int h = 0; h < 2; ++h) _Pragma("unroll") for (int i = 0; i < 2; ++i) { const int r = h * HALF + RA[i]; int tok = 0; if (r < (u).cnt) tok = g.rowtab[(u).tab + r]; \
                vo[h][i] = (unsigned)tok * (unsigned)(K * 2) + (unsigned)(CA[i] * 2); } \
        } else { pa = (const char*)g.A + (size_t)(u).pm * tstep; \
            _Pragma("unroll") for (int h = 0; h < 2; ++h) _Pragma("unroll") for (int i = 0; i < 2; ++i) vo[h][i] = voffA[i] + (unsigned)(h * hstep); } } while (0)
    PG8_UNIT_PTRS(cur, cA, cB, voA);
    PG8_STAGE(PG8_SB(0, 0), cB, voffB); PG8_STAGE(PG8_SB(0, 1), cB + hstep, voffB); PG8_STAGE(PG8_SA(0, 0), cA, voA[0]); PG8_STAGE(PG8_SA(0, 1), cA, voA[1]);
    if (wr == 1) PG8_BAR;
    PG8_WAIT_V(2); PG8_BAR;
    if constexpr (BAL_DMA) { PG8_STAGE(PG8_SB(1, 0), cB + kstep, voffB); PG8_STAGE(PG8_SB(1, 1), cB + hstep + kstep, voffB); PG8_WAIT_V(4); PG8_BAR; }
    else { PG8_STAGE(PG8_SB(1, 0), cB + kstep, voffB); PG8_STAGE(PG8_SA(1, 0), cA + kstep, voA[0]); PG8_STAGE(PG8_SB(1, 1), cB + hstep + kstep, voffB); PG8_WAIT_V(6); PG8_BAR; }
    for (;;) {
        const bool has_next = S.next(ui + 1, nxt);
        const char* nA = cA; const char* nB = cB;
#pragma unroll
        for (int h = 0; h < 2; ++h)
#pragma unroll
            for (int i = 0; i < 2; ++i) voN[h][i] = voA[h][i];
        if (has_next) PG8_UNIT_PTRS(nxt, nA, nB, voN);
        for (int t = 0; t < nt; t += 2) {
            const bool last = (t == nt - 2);
            const char* a1 = cA + (size_t)(t + 1) * kstep;
            const char* a2 = last ? nA : cA + (size_t)(t + 2) * kstep; const char* b2 = last ? nB : cB + (size_t)(t + 2) * kstep;
            const char* a3 = a2 + kstep; const char* b3 = b2 + kstep;
            unsigned vo2[2][2];
#pragma unroll
            for (int h = 0; h < 2; ++h)
#pragma unroll
                for (int i = 0; i < 2; ++i) vo2[h][i] = last ? voN[h][i] : voA[h][i];
            if constexpr (BAL_DMA) {
            PG8_LDB(B0, 0, 0); PG8_LDB(B1, 0, 1); PG8_SCHED; PG8_LDA(At, 0, 0); PG8_STAGE(PG8_SA(1, 0), a1, voA[0]); PG8_STAGE(PG8_SA(1, 1), a1, voA[1]);
            PG8_WAIT_V(8); PG8_WAIT_L(0); PG8_BAR; PG8_MMA(0, 0, At, B0); PG8_MMA(0, 1, At, B1); PG8_BAR; PG8_SCHED;
            PG8_LDA(At, 0, 1); PG8_STAGE(PG8_SB(0, 0), b2, voffB); PG8_STAGE(PG8_SB(0, 1), b2 + hstep, voffB);
            PG8_WAIT_V(6); PG8_WAIT_L(0); PG8_BAR; PG8_MMA(1, 0, At, B0); PG8_MMA(1, 1, At, B1); PG8_BAR; PG8_SCHED;
            PG8_LDB(B0, 1, 0); PG8_LDB(B1, 1, 1); PG8_SCHED; PG8_LDA(At, 1, 0); PG8_STAGE(PG8_SA(0, 0), a2, vo2[0]); PG8_STAGE(PG8_SA(0, 1), a2, vo2[1]);
            PG8_WAIT_V(8); PG8_WAIT_L(0); PG8_BAR; PG8_MMA(0, 0, At, B0); PG8_MMA(0, 1, At, B1); PG8_BAR; PG8_SCHED;
            PG8_LDA(At, 1, 1); PG8_STAGE(PG8_SB(1, 0), b3, voffB); PG8_STAGE(PG8_SB(1, 1), b3 + hstep, voffB);
            PG8_WAIT_V(6); PG8_WAIT_L(0); PG8_BAR; PG8_MMA(1, 0, At, B0); PG8_MMA(1, 1, At, B1); PG8_BAR; PG8_SCHED;
            } else if constexpr (DMA_IN_MMA) {
            PG8_LDB(B0, 0, 0); PG8_LDB(B1, 0, 1); PG8_SCHED; PG8_LDA(At, 0, 0);
            PG8_WAIT_V(6); PG8_WAIT_L(0); PG8_BAR; PG8_MMA(0, 0, At, B0); PG8_SCHED; PG8_STAGE(PG8_SA(1, 1), a1, voA[1]); PG8_SCHED; PG8_MMA(0, 1, At, B1); PG8_BAR; PG8_SCHED;
            PG8_LDA(At, 0, 1);
            PG8_WAIT_V(2); PG8_WAIT_L(0); PG8_BAR; PG8_MMA(1, 0, At, B0); PG8_SCHED; PG8_STAGE(PG8_SB(0, 0), b2, voffB); PG8_STAGE(PG8_SB(0, 1), b2 + hstep, voffB); PG8_SCHED;
            PG8_MMA(1, 1, At, B1); PG8_SCHED; PG8_STAGE(PG8_SA(0, 0), a2, vo2[0]); PG8_BAR; PG8_SCHED;
            PG8_LDB(B0, 1, 0); PG8_LDB(B1, 1, 1); PG8_SCHED; PG8_LDA(At, 1, 0);
            PG8_WAIT_V(6); PG8_WAIT_L(0); PG8_BAR; PG8_MMA(0, 0, At, B0); PG8_SCHED; PG8_STAGE(PG8_SA(0, 1), a2, vo2[1]); PG8_SCHED; PG8_MMA(0, 1, At, B1); PG8_BAR; PG8_SCHED;
            PG8_LDA(At, 1, 1);
            PG8_WAIT_V(2); PG8_WAIT_L(0); PG8_BAR; PG8_MMA(1, 0, At, B0); PG8_SCHED; PG8_STAGE(PG8_SB(1, 0), b3, voffB); PG8_STAGE(PG8_SB(1, 1), b3 + hstep, voffB); PG8_SCHED;
            PG8_MMA(1, 1, At, B1); PG8_SCHED; PG8_STAGE(PG8_SA(1, 0), a3, vo2[0]); PG8_BAR; PG8_SCHED;
            } else {
            PG8_LDB(B0, 0, 0); PG8_LDB(B1, 0, 1); PG8_SCHED; PG8_LDA(At, 0, 0); PG8_STAGE(PG8_SA(1, 1), a1, voA[1]);
            PG8_WAIT_V(8); PG8_WAIT_L(0); PG8_BAR; PG8_MMA(0, 0, At, B0); PG8_MMA(0, 1, At, B1); PG8_BAR; PG8_SCHED;
            PG8_LDA(At, 0, 1); PG8_STAGE(PG8_SB(0, 0), b2, voffB); PG8_STAGE(PG8_SB(0, 1), b2 + hstep, voffB); PG8_STAGE(PG8_SA(0, 0), a2, vo2[0]);
            PG8_WAIT_V(8); PG8_WAIT_L(0); PG8_BAR; PG8_MMA(1, 0, At, B0); PG8_MMA(1, 1, At, B1); PG8_BAR; PG8_SCHED;
            PG8_LDB(B0, 1, 0); PG8_LDB(B1, 1, 1); PG8_SCHED; PG8_LDA(At, 1, 0); PG8_STAGE(PG8_SA(0, 1), a2, vo2[1]);
            PG8_WAIT_V(8); PG8_WAIT_L(0); PG8_BAR; PG8_MMA(0, 0, At, B0); PG8_MMA(0, 1, At, B1); PG8_BAR; PG8_SCHED;
            PG8_LDA(At, 1, 1); PG8_STAGE(PG8_SB(1, 0), b3, voffB); PG8_STAGE(PG8_SB(1, 1), b3 + hstep, voffB); PG8_STAGE(PG8_SA(1, 0), a3, vo2[0]);
            PG8_WAIT_V(8); PG8_WAIT_L(0); PG8_BAR; PG8_MMA(1, 0, At, B0); PG8_MMA(1, 1, At, B1); PG8_BAR; PG8_SCHED;
            }
        }
        if constexpr (FP8) asm volatile("s_nop 15\n\ts_nop 15" ::: "memory");
        if constexpr (ALIGN_EPI) { if (wr == 0) PG8_BAR; }
        E(acc, cur, wr, wc, fr, fq);
        if (!has_next) break;
#pragma unroll
        for (int a = 0; a < 2; ++a)
#pragma unroll
            for (int b = 0; b < 2; ++b)
#pragma unroll
                for (int m = 0; m < 4; ++m)
#pragma unroll
                    for (int n = 0; n < 2; ++n) acc[a][b][m][n] = (f32x4){0.f, 0.f, 0.f, 0.f};
        cur = nxt; cA = nA; cB = nB; ++ui;
#pragma unroll
        for (int h = 0; h < 2; ++h)
#pragma unroll
            for (int i = 0; i < 2; ++i) voA[h][i] = voN[h][i];
        if constexpr (ALIGN_EPI) { if (wr == 1) PG8_BAR; }
    }
    PG8_WAIT_V(0);
    if constexpr (!ALIGN_EPI) { if (wr == 0) PG8_BAR; }
    PG8_BAR;
#undef PG8_UNIT_PTRS
#undef PG8_SA
#undef PG8_SB
#undef PG8_STAGE
#undef PG8_LDA
#undef PG8_LDQ
#undef PG8_LDB
#undef PG8_MMA
#undef PG8_WAIT_V
#undef PG8_WAIT_L
#undef PG8_BAR
#undef PG8_SCHED
}
}

#define XB_TMO      128
#define XB_XCNT(j)  (256  + 64 * (j))
#define XB_XSUB(j)  (1280 + 64 * (j))
#define XB_XGEN(j)  (2304 + 64 * (j))
#define XB_TOP      3328
#define XB_TOPGEN   3392
#define XCD_BAR_WORDS 3456
#define XB_SPIN_CAP (1u << 18)

__device__ __forceinline__ unsigned xb_ld(unsigned* p)              { return __hip_atomic_load(p, __ATOMIC_RELAXED, __HIP_MEMORY_SCOPE_AGENT); }
__device__ __forceinline__ unsigned xb_add(unsigned* p, unsigned v) { return __hip_atomic_fetch_add(p, v, __ATOMIC_RELAXED, __HIP_MEMORY_SCOPE_AGENT); }
__device__ __forceinline__ unsigned xb_xcc_id() { return (unsigned)__builtin_amdgcn_s_getreg((3 << 11) | 20) & 0xFu; }
#define XB_SPIN(cond, bar) do { unsigned _sp = 0; while (cond) { __builtin_amdgcn_s_sleep(1); \
    if ((++_sp & 255u) == 0u) { if (xb_ld(&(bar)[XB_TMO])) break; if (_sp > XB_SPIN_CAP) { atomicAdd(&(bar)[XB_TMO], 1u); break; } } } } while (0)

struct XcdBarrier {
    unsigned* bar; unsigned x;
    volatile LAS unsigned* st;
};

__device__ __forceinline__ XcdBarrier xcd_barrier_post(unsigned* bar, volatile LAS unsigned* st) {
    XcdBarrier b; b.bar = bar; b.x = xb_xcc_id(); b.st = st;
    if (threadIdx.x == 0) (void)xb_add(&bar[XB_XCNT(b.x)], 1u);
    return b;
}
__device__ __forceinline__ void xcd_barrier_complete(unsigned* bar, unsigned x, unsigned& nloc, unsigned& nx) {
    const unsigned G = gridDim.x * gridDim.y * gridDim.z;
    unsigned sum, cnt, mine, sp = 0u;
    for (;;) {
        sum = 0u; cnt = 0u; mine = 0u;
#pragma unroll
        for (unsigned j = 0; j < 16; ++j) { const unsigned c = xb_ld(&bar[XB_XCNT(j)]); sum += c; cnt += (c > 0u) ? 1u : 0u; mine = (j == x) ? c : mine; }
        if (sum == G) break;
        __builtin_amdgcn_s_sleep(1);
        if ((++sp & 255u) == 0u) { if (xb_ld(&bar[XB_TMO])) break; if (sp > XB_SPIN_CAP) { atomicAdd(&bar[XB_TMO], 1u); break; } }
    }
    nloc = mine > 0u ? mine : 1u; nx = cnt > 0u ? cnt : 1u;
}

__device__ __forceinline__ void xcd_barrier(const XcdBarrier& b) {
    asm volatile("s_waitcnt vmcnt(0)" ::: "memory");
    __syncthreads();
    if (threadIdx.x == 0) {
        unsigned* bar = b.bar;
        __builtin_amdgcn_s_waitcnt(0);
        unsigned nloc = b.st[0], nx = b.st[1];
        if (nloc == 0u) { xcd_barrier_complete(bar, b.x, nloc, nx); b.st[0] = nloc; b.st[1] = nx; }
        const unsigned old = xb_add(&bar[XB_XSUB(b.x)], 1u);
        const unsigned gen = old / nloc;
        if (old + 1u == (gen + 1u) * nloc) {
            __builtin_amdgcn_fence(__ATOMIC_RELEASE, "agent");
            asm volatile("s_waitcnt vmcnt(0)" ::: "memory");
            const unsigned og = xb_add(&bar[XB_TOP], 1u);
            const unsigned tg = og / nx;
            if (og + 1u == (tg + 1u) * nx) xb_add(&bar[XB_TOPGEN], 1u);
            else XB_SPIN(xb_ld(&bar[XB_TOPGEN]) == tg, bar);
            __builtin_amdgcn_fence(__ATOMIC_ACQUIRE, "agent");
            xb_add(&bar[XB_XGEN(b.x)], 1u);
            asm volatile("s_waitcnt vmcnt(0)" ::: "memory");
        } else {
            XB_SPIN(xb_ld(&bar[XB_XGEN(b.x)]) == gen, bar);
            __builtin_amdgcn_fence(__ATOMIC_ACQUIRE, "agent");
            asm volatile("s_waitcnt vmcnt(0)" ::: "memory");
        }
    }
    __syncthreads();
}

struct Args {
    const float* x; const float* p; const float* w_in; const float* norm_sb; const float* norm_moba; const float* w_out; const float* ln1_g; const float* ln1_b;
    const float* w_router; const float* b_router; const float* w_up; const float* b_up; const float* w_down; const float* b_down; const float* ln2_g; const float* ln2_b;
    const float* w_ple; const float* w_ple_gate; const float* b_ple_gate;
    float* out; unsigned char* ws; int ph_lo, ph_hi;
};

__device__ __forceinline__ float wave_sum(float v) {
#pragma unroll
    for (int o = 1; o < 64; o <<= 1) v += __shfl_xor(v, o);
    return v;
}
template <int CTRL> __device__ __forceinline__ float dppmov(float v) { return __builtin_bit_cast(float, __builtin_amdgcn_update_dpp(0, __builtin_bit_cast(int, v), CTRL, 0xF, 0xF, true)); }
__device__ __forceinline__ float reduce16(float v) { v += dppmov<0xB1>(v); v += dppmov<0x4E>(v); v += dppmov<0x141>(v); v += dppmov<0x140>(v); return v; }

struct DenseSched {
    int nM, nN, nwg, G, c;
    __device__ void init(int Mrows, int N, int G_, int c_) { nM = Mrows / 256; nN = N / 256; nwg = nM * nN; G = G_; c = c_; }
    __device__ __forceinline__ bool next(int i, pg8::Unit& u) const {
        const long L = (long)i * G + c; if (L >= nwg) return false;
        int wgid = (int)L; { const int q = nwg / 8, r = nwg % 8, xcd = wgid % 8, off = wgid / 8; wgid = (xcd < r ? xcd * (q + 1) : r * (q + 1) + (xcd - r) * q) + off; }
        const int nig = 8 * nN, gid = wgid / nig, fm = gid * 8, gsz = (nM - fm) < 8 ? (nM - fm) : 8;
        u.pm = fm + ((wgid % nig) % gsz); u.pn = (wgid % nig) / gsz; u.e = 0; u.tab = 0; u.cnt = 256; return true;
    }
};
struct MoeSched {
    const LAS int* tab; int NPN, G, c;
    __device__ __forceinline__ bool next(int i, pg8::Unit& u) const {
        int tt, pn;
        if (G == 256 && (NPN == 8 || NPN == 16)) {
            const int x = c & 7, s = c >> 3;
            if (NPN == 8) { tt = 32 * i + 8 * (x >> 1) + (s >> 2); pn = 4 * (x & 1) + (s & 3); }
            else { tt = 16 * i + 8 * (x >> 2) + (s >> 2); pn = 4 * (x & 3) + (s & 3); }
            if (tt >= tab[32]) return false;
        } else {
            const int total = tab[32] * NPN; const int L = i * G + c; if (L >= total) return false;
            tt = L / NPN; pn = L - tt * NPN;
        }
        int e = 0;
        for (int k = 1; k < 32; ++k) e += (tab[k] <= tt) ? 1 : 0;
        e = __builtin_amdgcn_readfirstlane(e);
        const int mt = tt - tab[e]; const int cnt = tab[33 + e] - mt * 256;
        u.pm = __builtin_amdgcn_readfirstlane(tt); u.pn = __builtin_amdgcn_readfirstlane(pn); u.e = e; u.tab = __builtin_amdgcn_readfirstlane(e * ECAP + mt * 256); u.cnt = __builtin_amdgcn_readfirstlane(cnt < 256 ? cnt : 256); return true;
    }
};
__device__ __forceinline__ void moe_table(LAS int* tab, const unsigned* ecnt_words) {
    if (threadIdx.x < 32) tab[33 + threadIdx.x] = (int)ecnt_words[32 * threadIdx.x];
    __syncthreads();
    if (threadIdx.x == 0) { int s = 0; for (int e = 0; e < 32; ++e) { tab[e] = s; s += (tab[33 + e] + 255) >> 8; } tab[32] = s; }
    __syncthreads();
}

using pg8::Unit; using pg8::cvt_pk_bf16;
struct EpiQKV {
    static constexpr bool PERM = true;
    bf16* O; int ldc; bool qscale; float* kmean;
    __device__ __forceinline__ void operator()(const f32x4 (&acc)[2][2][4][2], const Unit& u, int wr, int wc, int fr, int fq) const {
        asm volatile("" : "+v"(fr), "+v"(fq));
        const int row0 = u.pm * 256 + wr * 64 + fr, col0 = u.pn * 256 + wc * 32 + 8 * fq;
        const float sc = (qscale && (u.pn < 4 || (u.pn >= 12 && u.pn < 16))) ? QSCALE : 1.f;
#pragma unroll
        for (int ai = 0; ai < 2; ++ai)
#pragma unroll
            for (int m = 0; m < 4; ++m) { bf16* rowp = O + (size_t)(row0 + ai * 128 + m * 16) * ldc + col0;
#pragma unroll
                for (int bj = 0; bj < 2; ++bj) { const f32x4 v0 = acc[ai][bj][m][0] * sc, v1 = acc[ai][bj][m][1] * sc;
                    u32x4 w; w.x = cvt_pk_bf16(v0[0], v0[1]); w.y = cvt_pk_bf16(v0[2], v0[3]); w.z = cvt_pk_bf16(v1[0], v1[1]); w.w = cvt_pk_bf16(v1[2], v1[3]);
                    *(u32x4*)(rowp + bj * 128) = w; } }
        if (qscale && u.pn >= 16 && u.pn < 20) {
#pragma unroll
            for (int bj = 0; bj < 2; ++bj)
#pragma unroll
                for (int n = 0; n < 2; ++n) { f32x4 cs = {0.f, 0.f, 0.f, 0.f};
#pragma unroll
                    for (int ai = 0; ai < 2; ++ai)
#pragma unroll
                        for (int m = 0; m < 4; ++m) cs += acc[ai][bj][m][n];
#pragma unroll
                    for (int j = 0; j < 4; ++j) { const float t = reduce16(cs[j]) * (1.f / 256.f);
                        if (fr == 0) { const int kc = (u.pn - 16) * 256 + bj * 128 + wc * 32 + 8 * fq + 4 * n + j;
                            const int bb = u.pm >> 5, blk = u.pm & 31;
                            atomicAdd(kmean + ((size_t)((bb * 8 + (kc >> 7)) * 32 + blk)) * 128 + (kc & 127), t); } } }
        }
    }
};
struct EpiH {
    static constexpr bool PERM = true;
    const bf16* XB; bf16* Hh;
    __device__ __forceinline__ void operator()(const f32x4 (&acc)[2][2][4][2], const Unit& u, int wr, int wc, int fr, int fq) const {
        asm volatile("" : "+v"(fr), "+v"(fq));
        const int row0 = u.pm * 256 + wr * 64 + fr, col0 = u.pn * 256 + wc * 32 + 8 * fq;
        u32x4 xw[2][4][2];
#pragma unroll
        for (int ai = 0; ai < 2; ++ai)
#pragma unroll
            for (int m = 0; m < 4; ++m)
#pragma unroll
                for (int bj = 0; bj < 2; ++bj) xw[ai][m][bj] = *(const u32x4*)(XB + (size_t)(row0 + ai * 128 + m * 16) * D + col0 + bj * 128);
        asm volatile("" : "+v"(xw[0][0][0]), "+v"(xw[0][0][1]), "+v"(xw[0][1][0]), "+v"(xw[0][1][1]), "+v"(xw[0][2][0]), "+v"(xw[0][2][1]), "+v"(xw[0][3][0]), "+v"(xw[0][3][1]),
                          "+v"(xw[1][0][0]), "+v"(xw[1][0][1]), "+v"(xw[1][1][0]), "+v"(xw[1][1][1]), "+v"(xw[1][2][0]), "+v"(xw[1][2][1]), "+v"(xw[1][3][0]), "+v"(xw[1][3][1]));
#pragma unroll
        for (int ai = 0; ai < 2; ++ai)
#pragma unroll
            for (int m = 0; m < 4; ++m) { const size_t ro = (size_t)(row0 + ai * 128 + m * 16) * D + col0;
#pragma unroll
                for (int bj = 0; bj < 2; ++bj) { const u32x4 x4 = xw[ai][m][bj];
                    const f32x4 a0 = acc[ai][bj][m][0], a1 = acc[ai][bj][m][1]; u32x4 w;
                    w.x = cvt_pk_bf16(fmaf(bf_lo(x4.x), DN_ALPHA, a0[0]), fmaf(bf_hi(x4.x), DN_ALPHA, a0[1])); w.y = cvt_pk_bf16(fmaf(bf_lo(x4.y), DN_ALPHA, a0[2]), fmaf(bf_hi(x4.y), DN_ALPHA, a0[3]));
                    w.z = cvt_pk_bf16(fmaf(bf_lo(x4.z), DN_ALPHA, a1[0]), fmaf(bf_hi(x4.z), DN_ALPHA, a1[1])); w.w = cvt_pk_bf16(fmaf(bf_lo(x4.w), DN_ALPHA, a1[2]), fmaf(bf_hi(x4.w), DN_ALPHA, a1[3]));
                    *(u32x4*)(Hh + ro + bj * 128) = w; } }
    }
};
struct EpiUp {
    static constexpr bool PERM = true;
    unsigned char* ACT; const float* biasp;
    __device__ __forceinline__ void operator()(const f32x4 (&acc)[2][2][4][2], const Unit& u, int wr, int wc, int fr, int fq) const {
        asm volatile("" : "+v"(fr), "+v"(fq));
        const int row0 = u.pm * 256 + wr * 64 + fr, cw = wc * 32 + 8 * fq;
        const float* bp = biasp + (size_t)u.e * 4096 + u.pn * 256 + cw;
        f32x4 bg[2], bl[2];
#pragma unroll
        for (int n = 0; n < 2; ++n) { bg[n] = *(const f32x4*)(bp + 4 * n); bl[n] = *(const f32x4*)(bp + 128 + 4 * n); }
#pragma unroll
        for (int ai = 0; ai < 2; ++ai)
#pragma unroll
            for (int m = 0; m < 4; ++m) {
                float a[8];
#pragma unroll
                for (int n = 0; n < 2; ++n)
#pragma unroll
                    for (int j = 0; j < 4; ++j) {
                        const float g8 = fminf(fmaf(acc[ai][0][m][n][j], 8.f * UP_DESCALE, bg[n][j]), 8.f * SWIGLU_LIMIT);
                        const float l1 = __builtin_amdgcn_fmed3f(fmaf(acc[ai][1][m][n][j], UP_DESCALE, bl[n][j]), 1.f - SWIGLU_LIMIT, 1.f + SWIGLU_LIMIT);
                        const float sg = __builtin_amdgcn_rcpf(1.f + __builtin_amdgcn_exp2f(g8 * (-SWIGLU_ALPHA * LOG2E / 8.f)));
                        a[n * 4 + j] = g8 * sg * l1;
                    }
                u32x2 w; w.x = pack_fp8x4_nc(a[0], a[1], a[2], a[3]); w.y = pack_fp8x4_nc(a[4], a[5], a[6], a[7]);
                *(u32x2*)(ACT + (size_t)(row0 + ai * 128 + m * 16) * DFF + u.pn * 128 + cw) = w;
            }
    }
};
struct EpiDown {
    static constexpr bool PERM = true;
    unsigned char* Y; const float* bias; const float* rowg;
    __device__ __forceinline__ void operator()(const f32x4 (&acc)[2][2][4][2], const Unit& u, int wr, int wc, int fr, int fq) const {
        asm volatile("" : "+v"(fr), "+v"(fq));
        const int rl0 = wr * 64 + fr, col0 = u.pn * 256 + wc * 32 + 8 * fq;
        const float* bp = bias + (size_t)u.e * D + col0;
        f32x4 bv[2][2];
#pragma unroll
        for (int bj = 0; bj < 2; ++bj)
#pragma unroll
            for (int n = 0; n < 2; ++n) bv[bj][n] = *(const f32x4*)(bp + bj * 128 + 4 * n);
        float gtv[2][4];
#pragma unroll
        for (int ai = 0; ai < 2; ++ai)
#pragma unroll
            for (int m = 0; m < 4; ++m) { const int rl = rl0 + ai * 128 + m * 16; gtv[ai][m] = (rl < u.cnt) ? rowg[u.tab + rl] : 0.f; }
        asm volatile("" : "+v"(gtv[0][0]), "+v"(gtv[0][1]), "+v"(gtv[0][2]), "+v"(gtv[0][3]), "+v"(gtv[1][0]), "+v"(gtv[1][1]), "+v"(gtv[1][2]), "+v"(gtv[1][3]));
#pragma unroll
        for (int ai = 0; ai < 2; ++ai)
#pragma unroll
            for (int m = 0; m < 4; ++m) { const int rl = rl0 + ai * 128 + m * 16; const float gt = gtv[ai][m] * YSCALE;
                unsigned char* rowp = Y + (size_t)(u.pm * 256 + rl) * D + col0;
#pragma unroll
                for (int bj = 0; bj < 2; ++bj) { const f32x4 v0 = (acc[ai][bj][m][0] * DN_DESCALE + bv[bj][0]) * gt, v1 = (acc[ai][bj][m][1] * DN_DESCALE + bv[bj][1]) * gt;
                    u32x2 w; w.x = pack_fp8x4(v0[0], v0[1], v0[2], v0[3]); w.y = pack_fp8x4(v1[0], v1[1], v1[2], v1[3]);
                    *(u32x2*)(rowp + bj * 128) = w; } }
    }
};
struct EpiOut {
    static constexpr bool PERM = true;
    float* OUT; const float* bias; const bf16* PLEB; const bf16* X2B;
    __device__ __forceinline__ void operator()(const f32x4 (&acc)[2][2][4][2], const Unit& u, int wr, int wc, int fr, int fq) const {
        asm volatile("" : "+v"(fr), "+v"(fq));
        const int row0 = u.pm * 256 + wr * 64 + fr, col0 = u.pn * 256 + wc * 32 + 8 * fq;
        f32x4 bv[2][2];
#pragma unroll
        for (int bj = 0; bj < 2; ++bj)
#pragma unroll
            for (int n = 0; n < 2; ++n) bv[bj][n] = *(const f32x4*)(bias + col0 + bj * 128 + 4 * n);
#pragma unroll
        for (int ai = 0; ai < 2; ++ai) {
            u32x4 xw[4][2], pw[4][2];
#pragma unroll
            for (int m = 0; m < 4; ++m)
#pragma unroll
                for (int bj = 0; bj < 2; ++bj) { const size_t o = (size_t)(row0 + ai * 128 + m * 16) * D + col0 + bj * 128; xw[m][bj] = *(const u32x4*)(X2B + o); pw[m][bj] = *(const u32x4*)(PLEB + o); }
            asm volatile("" : "+v"(xw[0][0]), "+v"(xw[0][1]), "+v"(xw[1][0]), "+v"(xw[1][1]), "+v"(xw[2][0]), "+v"(xw[2][1]), "+v"(xw[3][0]), "+v"(xw[3][1]),
                              "+v"(pw[0][0]), "+v"(pw[0][1]), "+v"(pw[1][0]), "+v"(pw[1][1]), "+v"(pw[2][0]), "+v"(pw[2][1]), "+v"(pw[3][0]), "+v"(pw[3][1]));
#pragma unroll
            for (int m = 0; m < 4; ++m) { const size_t ro = (size_t)(row0 + ai * 128 + m * 16) * D + col0;
#pragma unroll
                for (int bj = 0; bj < 2; ++bj) { const size_t o = ro + bj * 128; const u32x4 x4 = xw[m][bj], p4 = pw[m][bj];
                    const float xv[8] = {bf_lo(x4.x), bf_hi(x4.x), bf_lo(x4.y), bf_hi(x4.y), bf_lo(x4.z), bf_hi(x4.z), bf_lo(x4.w), bf_hi(x4.w)};
                    const float pl[8] = {bf_lo(p4.x), bf_hi(p4.x), bf_lo(p4.y), bf_hi(p4.y), bf_lo(p4.z), bf_hi(p4.z), bf_lo(p4.w), bf_hi(p4.w)};
#pragma unroll
                    for (int n = 0; n < 2; ++n) { const f32x4 g = acc[ai][bj][m][n] * UP_DESCALE + bv[bj][n]; f32x4 r;
#pragma unroll
                        for (int j = 0; j < 4; ++j) r[j] = xv[4 * n + j] + __builtin_amdgcn_rcpf(1.f + __builtin_amdgcn_exp2f(-LOG2E * g[j])) * pl[4 * n + j];
                        *(f32x4*)(OUT + o + 4 * n) = r; } } }
        }
    }
};

struct P0Job { const float* W; void* WT; int K, N, mode; };
__device__ __forceinline__ void cv_load(const P0Job& j, int blk, int lane, f32x4 (&v)[16]) {
    const int nb64 = j.N >> 6, kb = blk / nb64, nbp = blk - kb * nb64;
    const float* p = j.W + (size_t)(64 * kb + 16 * (lane >> 4)) * j.N + 64 * nbp + 4 * (lane & 15);
#pragma unroll
    for (int i = 0; i < 16; ++i) v[i] = __builtin_nontemporal_load((const GAS f32x4*)(p + (size_t)i * j.N));
}
__device__ __forceinline__ void cv_store(const P0Job& j, int blk, int lane, const f32x4 (&v)[16]) {
    const int nb64 = j.N >> 6, kb = blk / nb64, nbp = blk - kb * nb64, K = j.K;
    const int kk = 64 * kb + 16 * (lane >> 4), nc = 64 * nbp + 4 * (lane & 15);
#pragma unroll
    for (int jj = 0; jj < 4; ++jj) {
        int nn = nc + jj; if (j.mode & 1) { const int a2 = nn >> 1, bj = nn & 1; nn = 256 * (a2 >> 7) + 128 * bj + (a2 & 127); }
        if (j.mode < 2) {
            u32x4 o0, o1;
            o0.x = pk2(v[0][jj], v[1][jj]); o0.y = pk2(v[2][jj], v[3][jj]); o0.z = pk2(v[4][jj], v[5][jj]); o0.w = pk2(v[6][jj], v[7][jj]);
            o1.x = pk2(v[8][jj], v[9][jj]); o1.y = pk2(v[10][jj], v[11][jj]); o1.z = pk2(v[12][jj], v[13][jj]); o1.w = pk2(v[14][jj], v[15][jj]);
            GAS u32x4* d = (GAS u32x4*)((bf16*)j.WT + (size_t)nn * K + kk);
            __builtin_nontemporal_store(o0, d); __builtin_nontemporal_store(o1, d + 1);
        } else {
            u32x4 o;
            o.x = pack_fp8x4(v[0][jj] * WSCALE, v[1][jj] * WSCALE, v[2][jj] * WSCALE, v[3][jj] * WSCALE);
            o.y = pack_fp8x4(v[4][jj] * WSCALE, v[5][jj] * WSCALE, v[6][jj] * WSCALE, v[7][jj] * WSCALE);
            o.z = pack_fp8x4(v[8][jj] * WSCALE, v[9][jj] * WSCALE, v[10][jj] * WSCALE, v[11][jj] * WSCALE);
            o.w = pack_fp8x4(v[12][jj] * WSCALE, v[13][jj] * WSCALE, v[14][jj] * WSCALE, v[15][jj] * WSCALE);
            __builtin_nontemporal_store(o, (GAS u32x4*)((unsigned char*)j.WT + (size_t)nn * K + kk));
        }
    }
}
constexpr int P0_I_IN = (D / 64) * (NQKV / 32), P0_I_OUT = (D / 64) * (D / 32), P0_I_G = P0_I_OUT, P0_I_PLE = (PLE / 64) * (D / 32), P0_I_UP1 = (D / 64) * (2 * DFF / 32), P0_I_DN1 = (DFF / 64) * (D / 32);
constexpr int P0_NA = P0_I_IN + P0_I_OUT + P0_I_PLE, P0_NB = P0_I_G + NE * P0_I_UP1 + NE * P0_I_DN1;
constexpr int CV_LISTS = 2048, CV_BLOCKS = P0_NB / 2;
constexpr int CV_UP_END = (P0_I_G + NE * P0_I_UP1) / 2;
static_assert(P0_NA % 2 == 0 && P0_NB % 2 == 0, "item pairs");
__device__ __forceinline__ int cv_list_len(int l, int nblocks) { return l < nblocks ? (nblocks - l + CV_LISTS - 1) / CV_LISTS : 0; }
__device__ __forceinline__ void p0_locate_a(const Args& a, int it, P0Job& j, int& item) {
    unsigned char* ws = a.ws; int r = it;
    if (r < P0_I_IN) { j = P0Job{a.w_in, ws + WS_WINT, D, NQKV, 0}; item = r; return; } r -= P0_I_IN;
    if (r < P0_I_OUT) { j = P0Job{a.w_out, ws + WS_WOUTT, D, D, 0}; item = r; return; } r -= P0_I_OUT;
    j = P0Job{a.w_ple, ws + WS_WPLET, PLE, D, 0}; item = r;
}
__device__ __forceinline__ void p0_locate_b(const Args& a, int it, P0Job& j, int& item) {
    unsigned char* ws = a.ws; int r = it;
    if (r < P0_I_G) { j = P0Job{a.w_ple_gate, ws + WS_WGT, D, D, 2}; item = r; return; } r -= P0_I_G;
    if (r < NE * P0_I_UP1) { const int e = r / P0_I_UP1; item = r - e * P0_I_UP1; j = P0Job{a.w_up + (size_t)e * D * 2 * DFF, ws + WS_WUPT + (size_t)e * 2 * DFF * D, D, 2 * DFF, 3}; return; } r -= NE * P0_I_UP1;
    { const int e = r / P0_I_DN1; item = r - e * P0_I_DN1; j = P0Job{a.w_down + (size_t)e * DFF * D, ws + WS_WDNT + (size_t)e * D * DFF, DFF, D, 2}; }
}
__device__ __forceinline__ void cv_range(const Args& a, int l, int i0, int i1, int lane) {
    if (i0 >= i1) return;
    P0Job j0; int it0; f32x4 v0[16];
    { p0_locate_b(a, 2 * (l + CV_LISTS * i0), j0, it0); cv_load(j0, it0 >> 1, lane, v0); }
    for (int i = i0;;) {
        const int in = i + 1; const bool hn = in < i1;
        P0Job n0 = j0; int nit = it0; f32x4 w0[16];
        if (hn) { p0_locate_b(a, 2 * (l + CV_LISTS * in), n0, nit); cv_load(n0, nit >> 1, lane, w0); }
        cv_store(j0, it0 >> 1, lane, v0);
        if (!hn) break;
#pragma unroll
        for (int k = 0; k < 16; ++k) v0[k] = w0[k];
        j0 = n0; it0 = nit; i = in;
    }
}
__device__ __forceinline__ void p0_prologue(const Args& a, LAS unsigned char* lds, int gw, int NGW, int wave, int lane) {
    unsigned char* ws = a.ws;
    for (int pr = gw; pr < P0_NA / 2; pr += NGW) {
        P0Job j0; int it0; p0_locate_a(a, 2 * pr, j0, it0);
        f32x4 v0[16]; cv_load(j0, it0 >> 1, lane, v0); cv_store(j0, it0 >> 1, lane, v0);
    }
    { const GAS f32x4* src = (const GAS f32x4*)a.x; GAS u32x2* dst = (GAS u32x2*)(ws + WS_XB); const size_t n4 = (size_t)M * D / 4, stride = (size_t)NGW * 64;
      for (size_t i = (size_t)gw * 64 + lane; i < n4; i += 4 * stride) { f32x4 v[4];
#pragma unroll
          for (int u = 0; u < 4; ++u) if (i + u * stride < n4) v[u] = src[i + u * stride];
#pragma unroll
          for (int u = 0; u < 4; ++u) if (i + u * stride < n4) { u32x2 o; o.x = pk2(v[u].x, v[u].y); o.y = pk2(v[u].z, v[u].w); dst[i + u * stride] = o; } } }
    { const GAS f32x4* src = (const GAS f32x4*)a.p; GAS u32x2* dst = (GAS u32x2*)(ws + WS_PB); const size_t n4 = (size_t)M * PLE / 4;
      for (size_t i = (size_t)gw * 64 + lane; i < n4; i += (size_t)NGW * 64) { const f32x4 v = src[i]; u32x2 o; o.x = pk2(v.x, v.y); o.y = pk2(v.z, v.w); dst[i] = o; } }
    { float* km = (float*)(ws + WS_KMEAN); for (int i = gw * 64 + lane; i < 16 * 32 * 128; i += NGW * 64) km[i] = 0.f; }
    { float* bp = (float*)(ws + WS_BUPP);
      for (int i = gw * 64 + lane; i < NE * 2 * DFF; i += NGW * 64) { const int e = i >> 12, nn = i & 4095; const int a2 = nn >> 1, bj = nn & 1; bp[e * 4096 + 256 * (a2 >> 7) + 128 * bj + (a2 & 127)] = bj ? a.b_up[i] + 1.f : 8.f * a.b_up[i]; } }
}

__device__ __forceinline__ void p2_kmean(const Args& a, LAS unsigned char* lds, int G) {
    const bf16* qkv = (const bf16*)(a.ws + WS_QKV); float* km = (float*)(a.ws + WS_KMEAN);
    LAS float* red = (LAS float*)(lds + RING_OFF);
    const int tid = threadIdx.x, c = tid & 15, rg = tid >> 4;
    for (int it = blockIdx.x; it < 16 * 32; it += G) {
        const int bh = it >> 5, blk = it & 31, b = bh >> 3, h = bh & 7;
        float s[8] = {0, 0, 0, 0, 0, 0, 0, 0};
#pragma unroll
        for (int i = 0; i < 8; ++i) { const int row = b * SEQ + blk * 256 + rg + 32 * i; const u32x4 w = *(const u32x4*)(qkv + (size_t)row * NQKV + 4096 + h * 128 + 8 * c);
            s[0] += bf_lo(w.x); s[1] += bf_hi(w.x); s[2] += bf_lo(w.y); s[3] += bf_hi(w.y); s[4] += bf_lo(w.z); s[5] += bf_hi(w.z); s[6] += bf_lo(w.w); s[7] += bf_hi(w.w); }
#pragma unroll
        for (int j = 0; j < 8; ++j) red[rg * 128 + 8 * c + j] = s[j];
        __syncthreads();
        if (tid < 128) { float t = 0.f; for (int r = 0; r < 32; ++r) t += red[r * 128 + tid]; km[(size_t)it * 128 + tid] = t * (1.f / 256.f); }
        __syncthreads();
    }
}

namespace mix {
typedef short s16x4 __attribute__((ext_vector_type(4)));
#define KSWZ(row, colB) ((row) * 256 + ((colB) ^ (((row) & 7) << 4)))
constexpr int L_V = 0, L_K = 16384, L_WS = 32768, L_FLAG = 36864, L_PRE = 40960;
constexpr float THR2 = 11.5f;
__device__ __forceinline__ int crow(int r, int hi) { return (r & 3) + 8 * (r >> 2) + 4 * hi; }
__device__ __forceinline__ unsigned cvtpk(float lo, float hi) { unsigned r; asm volatile("v_cvt_pk_bf16_f32 %0, %1, %2" : "=v"(r) : "v"(lo), "v"(hi)); return r; }
__device__ __forceinline__ int v_st(int k, int c) { const int kk = (k & ~0xC) | ((k & 4) << 1) | ((k & 8) >> 1); return ((kk >> 3) * 4 + (c >> 5)) * 512 + ((kk & 7) * 32 + (c & 31)) * 2; }
__device__ __forceinline__ int v_rd_base(int lane) { return ((lane & 3) << 3) | (((lane >> 2) & 3) << 6) | (((lane >> 4) & 1) << 5) | (((lane >> 5) & 1) << 8); }
constexpr int v_rd_off(int d0, int ks, int half) { return d0 * 512 + ks * 4096 + half * 2048; }
template <int OFF> __device__ __forceinline__ s16x4 tr_read(int vb) { s16x4 r; asm volatile("ds_read_b64_tr_b16 %0, %1 offset:%2" : "=&v"(r) : "v"(vb), "i"(OFF) : "memory"); return r; }
template <int D0> __device__ __forceinline__ void pv_one(f32x16& od, int vb, bf16x8 pa0, bf16x8 pa1, bf16x8 pa2, bf16x8 pa3) {
    const s16x4 l0 = tr_read<v_rd_off(D0, 0, 0)>(vb), h0 = tr_read<v_rd_off(D0, 0, 1)>(vb), l1 = tr_read<v_rd_off(D0, 1, 0)>(vb), h1 = tr_read<v_rd_off(D0, 1, 1)>(vb);
    const s16x4 l2 = tr_read<v_rd_off(D0, 2, 0)>(vb), h2 = tr_read<v_rd_off(D0, 2, 1)>(vb), l3 = tr_read<v_rd_off(D0, 3, 0)>(vb), h3 = tr_read<v_rd_off(D0, 3, 1)>(vb);
    asm volatile("s_waitcnt lgkmcnt(0)" ::: "memory"); __builtin_amdgcn_sched_barrier(0);
#define PK(L, H) (bf16x8){L[0], L[1], L[2], L[3], H[0], H[1], H[2], H[3]}
    od = __builtin_amdgcn_mfma_f32_32x32x16_bf16(pa0, PK(l0, h0), od, 0, 0, 0);
    od = __builtin_amdgcn_mfma_f32_32x32x16_bf16(pa1, PK(l1, h1), od, 0, 0, 0);
    od = __builtin_amdgcn_mfma_f32_32x32x16_bf16(pa2, PK(l2, h2), od, 0, 0, 0);
    od = __builtin_amdgcn_mfma_f32_32x32x16_bf16(pa3, PK(l3, h3), od, 0, 0, 0);
#undef PK
}
__device__ __forceinline__ void pv_d0(f32x16 (&o)[4], int vb, bf16x8 pa0, bf16x8 pa1, bf16x8 pa2, bf16x8 pa3) {
    pv_one<0>(o[0], vb, pa0, pa1, pa2, pa3); pv_one<1>(o[1], vb, pa0, pa1, pa2, pa3); pv_one<2>(o[2], vb, pa0, pa1, pa2, pa3); pv_one<3>(o[3], vb, pa0, pa1, pa2, pa3);
}
__device__ __forceinline__ void qkt(f32x16& p0, f32x16& p1, const LAS unsigned char* Ks, const bf16x8 (&qr)[8], int r32, int hi) {
#pragma unroll
    for (int i = 0; i < 16; ++i) { p0[i] = 0.f; p1[i] = 0.f; }
#pragma unroll
    for (int d0 = 0; d0 < 8; ++d0) { const int cb = (d0 * 16 + hi * 8) * 2;
        const bf16x8 b0 = *(const LAS bf16x8*)(Ks + KSWZ(r32, cb));
        const bf16x8 b1 = *(const LAS bf16x8*)(Ks + KSWZ(32 + r32, cb));
        p0 = __builtin_amdgcn_mfma_f32_32x32x16_bf16(b0, qr[d0], p0, 0, 0, 0);
        p1 = __builtin_amdgcn_mfma_f32_32x32x16_bf16(b1, qr[d0], p1, 0, 0, 0); }
}
__device__ __forceinline__ void pack_p(const f32x16& p0, const f32x16& p1, bf16x8& pa0, bf16x8& pa1, bf16x8& pa2, bf16x8& pa3) {
#define PK4(P, BASE, OUT) do { unsigned a0 = cvtpk(P[BASE + 0], P[BASE + 1]), a1 = cvtpk(P[BASE + 2], P[BASE + 3]);   \
    unsigned b0 = cvtpk(P[BASE + 4], P[BASE + 5]), b1 = cvtpk(P[BASE + 6], P[BASE + 7]);                              \
    auto r0 = __builtin_amdgcn_permlane32_swap(a0, b0, false, false); auto r1 = __builtin_amdgcn_permlane32_swap(a1, b1, false, false); \
    u32x4 w = {r0[0], r1[0], r0[1], r1[1]}; OUT = __builtin_bit_cast(bf16x8, w); } while (0)
    PK4(p0, 0, pa0); PK4(p0, 8, pa1); PK4(p1, 0, pa2); PK4(p1, 8, pa3);
#undef PK4
}
__device__ __forceinline__ float pair_other(float x, int hi) {
    auto rr = __builtin_amdgcn_permlane32_swap(__builtin_bit_cast(unsigned, x), __builtin_bit_cast(unsigned, x), false, false);
    return __builtin_bit_cast(float, hi ? rr[0] : rr[1]);
}
struct TileRegs { u32x4 k0, k1, v0, v1; };
__device__ __forceinline__ void stage_load(TileRegs& r, const bf16* kg, const bf16* vg, int tid) {
    const int sr = tid >> 4, sc = (tid & 15) * 8;
    r.k0 = *(const u32x4*)(kg + (size_t)sr * NQKV + sc); r.k1 = *(const u32x4*)(kg + (size_t)(32 + sr) * NQKV + sc);
    r.v0 = *(const u32x4*)(vg + (size_t)sr * NQKV + sc); r.v1 = *(const u32x4*)(vg + (size_t)(32 + sr) * NQKV + sc);
}
__device__ __forceinline__ void stage_write(LAS unsigned char* lds, const TileRegs& r, int tid) {
    const int sr = tid >> 4, sc = (tid & 15) * 8;
    *(LAS u32x4*)(lds + L_V + v_st(sr, sc)) = r.v0; *(LAS u32x4*)(lds + L_V + v_st(32 + sr, sc)) = r.v1;
    *(LAS u32x4*)(lds + L_K + KSWZ(sr, sc * 2)) = r.k0; *(LAS u32x4*)(lds + L_K + KSWZ(32 + sr, sc * 2)) = r.k1;
}
__device__ __forceinline__ float reduce32(float v) { v = reduce16(v); v += __shfl_xor(v, 16); return v; }

__device__ __forceinline__ void sb_unit(const Args& a, LAS unsigned char* lds, int bh, int qb) {
    const bf16* qkv = (const bf16*)(a.ws + WS_QKV); bf16* mixed = (bf16*)(a.ws + WS_MIXED);
    const int tid = threadIdx.x, wid = __builtin_amdgcn_readfirstlane(tid >> 6), lane = tid & 63, r32 = lane & 31, hi = lane >> 5;
    const int b = bh >> 3, h = bh & 7, q0 = qb * 256, qpos = q0 + wid * 32 + r32;
    const bf16* base = qkv + (size_t)b * SEQ * NQKV + h * 128;
    volatile LAS int* flags = (volatile LAS int*)(lds + L_FLAG);
    bf16x8 qr[8];
#pragma unroll
    for (int d0 = 0; d0 < 8; ++d0) qr[d0] = *(const bf16x8*)(base + (size_t)qpos * NQKV + d0 * 16 + hi * 8);
    f32x16 o[4];
#pragma unroll
    for (int d = 0; d < 4; ++d)
#pragma unroll
        for (int i = 0; i < 16; ++i) o[d][i] = 0.f;
    float P = 1.f; bool wdone = false;
    const int vb0 = (int)(uintptr_t)(lds + L_V) + v_rd_base(lane);
    __syncthreads();
    if (tid < 8) flags[tid] = 0;
    TileRegs tr; stage_load(tr, base + (size_t)((qb * 4 + 3) * 64) * NQKV + 1024, base + (size_t)((qb * 4 + 3) * 64) * NQKV + 2048, tid);
    for (int kt = qb * 4 + 3; kt >= 0; --kt) {
        __syncthreads();
        { int alld = 1;
#pragma unroll
          for (int w = 0; w < 8; ++w) alld &= flags[w];
          if (alld) break; }
        stage_write(lds, tr, tid);
        if (kt > 0) stage_load(tr, base + (size_t)((kt - 1) * 64) * NQKV + 1024, base + (size_t)((kt - 1) * 64) * NQKV + 2048, tid);
        __syncthreads();
        const int kbase = kt * 64;
        if (!wdone && kbase < q0 + wid * 32 + 31) {
            f32x16 p0, p1; qkt(p0, p1, lds + L_K, qr, r32, hi);
            const int d0i = kbase + 4 * hi - qpos;
            f32x16 m0, m1;
#pragma unroll
            for (int r = 0; r < 16; ++r) {
                const int c = (r & 3) + 8 * (r >> 2);
                { const float z = fminf(fmaxf(p0[r], -120.f), 120.f); const float e = __builtin_amdgcn_exp2f(-z), be = __builtin_amdgcn_rcpf(1.f + e); const bool ok = (d0i + c) < 0;
                  p0[r] = ok ? be : 0.f; m0[r] = ok ? e * be : 1.f; }
                { const float z = fminf(fmaxf(p1[r], -120.f), 120.f); const float e = __builtin_amdgcn_exp2f(-z), be = __builtin_amdgcn_rcpf(1.f + e); const bool ok = (d0i + 32 + c) < 0;
                  p1[r] = ok ? be : 0.f; m1[r] = ok ? e * be : 1.f; }
            }
            float Go[2][4], Gp[2][4];
#pragma unroll
            for (int g = 0; g < 4; ++g) { Go[0][g] = (m0[4 * g] * m0[4 * g + 1]) * (m0[4 * g + 2] * m0[4 * g + 3]); Go[1][g] = (m1[4 * g] * m1[4 * g + 1]) * (m1[4 * g + 2] * m1[4 * g + 3]); }
#pragma unroll
            for (int ph = 0; ph < 2; ++ph)
#pragma unroll
                for (int g = 0; g < 4; ++g) Gp[ph][g] = pair_other(Go[ph][g], hi);
            float R = P;
#pragma unroll
            for (int ph = 1; ph >= 0; --ph)
#pragma unroll
                for (int g = 3; g >= 0; --g) {
                    const float Gf = hi ? Go[ph][g] : Gp[ph][g], Gs = hi ? Gp[ph][g] : Go[ph][g];
                    const float sA = R; R *= Gf; const float sB = R; R *= Gs;
                    float S = hi ? sA : sB;
                    if (ph == 1) { p1[4 * g + 3] *= S; S *= m1[4 * g + 3]; p1[4 * g + 2] *= S; S *= m1[4 * g + 2]; p1[4 * g + 1] *= S; S *= m1[4 * g + 1]; p1[4 * g] *= S; }
                    else         { p0[4 * g + 3] *= S; S *= m0[4 * g + 3]; p0[4 * g + 2] *= S; S *= m0[4 * g + 2]; p0[4 * g + 1] *= S; S *= m0[4 * g + 1]; p0[4 * g] *= S; }
                }
            P = R;
            bf16x8 pa0, pa1, pa2, pa3; pack_p(p0, p1, pa0, pa1, pa2, pa3);
            pv_d0(o, vb0, pa0, pa1, pa2, pa3);
            wdone = __builtin_amdgcn_ballot_w64(P >= 1e-30f) == 0ull;
        }
        if (lane == 0) flags[wid] = (wdone || kt == 0) ? 1 : 0;
    }
    f32x4 gn; gn.x = a.norm_sb[h * 128 + r32]; gn.y = a.norm_sb[h * 128 + 32 + r32]; gn.z = a.norm_sb[h * 128 + 64 + r32]; gn.w = a.norm_sb[h * 128 + 96 + r32];
#pragma unroll
    for (int r = 0; r < 16; ++r) {
        float ss = (o[0][r] * o[0][r] + o[1][r] * o[1][r]) + (o[2][r] * o[2][r] + o[3][r] * o[3][r]);
        ss = reduce32(ss) * (1.f / 128.f);
        const float rn = 1.f / sqrtf(ss + RMS_EPS);
        bf16* orow = mixed + (size_t)(b * SEQ + q0 + wid * 32 + crow(r, hi)) * D + h * 128 + r32;
        orow[0] = (bf16)f2bf(o[0][r] * rn * gn.x); orow[32] = (bf16)f2bf(o[1][r] * rn * gn.y); orow[64] = (bf16)f2bf(o[2][r] * rn * gn.z); orow[96] = (bf16)f2bf(o[3][r] * rn * gn.w);
    }
}

__device__ __forceinline__ void moba_unit(const Args& a, LAS unsigned char* lds, int bh, int j, const int* list, int n, bool own_unit) {
    const bf16* qkv = (const bf16*)(a.ws + WS_QKV); bf16* po = (bf16*)(a.ws + WS_MPO); float* pml = (float*)(a.ws + WS_MPML);
    const int tid = threadIdx.x, wid = __builtin_amdgcn_readfirstlane(tid >> 6), lane = tid & 63, r32 = lane & 31, hi = lane >> 5;
    const int b = bh >> 3, h = bh & 7;
    const bf16* base = qkv + (size_t)b * SEQ * NQKV + h * 128;
    LAS float* wsf = (LAS float*)(lds + L_WS + wid * 512); LAS float* al_l = wsf; LAS float* li_l = wsf + 32; LAS int* tb = (LAS int*)(wsf + 64);
    const int ei = wid * 32 + r32; int ent;
    if (own_unit) ent = (j * 256 + ei) | (3 << 16); else ent = list[ei < n ? ei : 0];
    const bool evalid = own_unit || (ei < n);
    const int qpos = ent & 0xffff, slot = ent >> 16;
    const int pslot = evalid ? (((bh * SEQ + qpos) << 2) + slot) : -1;
    __syncthreads();
    if (hi == 0) tb[r32] = pslot;
    bf16x8 qr[8];
#pragma unroll
    for (int d0 = 0; d0 < 8; ++d0) qr[d0] = *(const bf16x8*)(base + (size_t)qpos * NQKV + 3072 + d0 * 16 + hi * 8);
    f32x16 o[4];
#pragma unroll
    for (int d = 0; d < 4; ++d)
#pragma unroll
        for (int i = 0; i < 16; ++i) o[d][i] = 0.f;
    float m_reg = -1e30f, l_reg = 0.f;
    const float slope2 = __builtin_amdgcn_exp2f(-(float)(h + 1)) * LOG2E;
    const int vb0 = (int)(uintptr_t)(lds + L_V) + v_rd_base(lane);
    TileRegs tr; stage_load(tr, base + (size_t)(j * 256) * NQKV + 4096, base + (size_t)(j * 256) * NQKV + 5120, tid);
    for (int jt = 0; jt < 4; ++jt) {
        if (jt) __syncthreads();
        const int kbase = j * 256 + jt * 64;
        stage_write(lds, tr, tid);
        if (jt < 3) stage_load(tr, base + (size_t)(kbase + 64) * NQKV + 4096, base + (size_t)(kbase + 64) * NQKV + 5120, tid);
        __syncthreads();
        if (own_unit && jt * 64 > wid * 32 + 31) continue;
        f32x16 p0, p1; qkt(p0, p1, lds + L_K, qr, r32, hi);
        const int d0i = kbase + 4 * hi - qpos;
        float pmax = -1e30f;
#pragma unroll
        for (int r = 0; r < 16; ++r) {
            const int c = (r & 3) + 8 * (r >> 2);
            { const int x = d0i + c; const float s = fmaf(slope2, (float)x, p0[r]); p0[r] = (x <= 0) ? s : -1e30f; pmax = fmaxf(pmax, p0[r]); }
            { const int x = d0i + 32 + c; const float s = fmaf(slope2, (float)x, p1[r]); p1[r] = (x <= 0) ? s : -1e30f; pmax = fmaxf(pmax, p1[r]); }
        }
        pmax = fmaxf(pmax, pair_other(pmax, hi));
        float mn, alpha;
        if (__builtin_amdgcn_ballot_w64(pmax - m_reg > THR2) == 0ull) { mn = m_reg; alpha = 1.f; }
        else { mn = fmaxf(m_reg, pmax); alpha = __builtin_amdgcn_exp2f(m_reg - mn); m_reg = mn; }
        float ps = 0.f;
#pragma unroll
        for (int r = 0; r < 16; ++r) { p0[r] = __builtin_amdgcn_exp2f(p0[r] - mn); p1[r] = __builtin_amdgcn_exp2f(p1[r] - mn); ps += p0[r] + p1[r]; }
        ps += pair_other(ps, hi);
        l_reg = l_reg * alpha + ps;
        if (__builtin_amdgcn_ballot_w64(alpha < 1.f) != 0ull) {
            if (hi == 0) al_l[r32] = alpha;
            asm volatile("s_waitcnt lgkmcnt(0)" ::: "memory");
#pragma unroll
            for (int r = 0; r < 16; ++r) { const float al = al_l[crow(r, hi)];
#pragma unroll
                for (int d = 0; d < 4; ++d) o[d][r] *= al; }
        }
        bf16x8 pa0, pa1, pa2, pa3; pack_p(p0, p1, pa0, pa1, pa2, pa3);
        pv_d0(o, vb0, pa0, pa1, pa2, pa3);
    }
    if (hi == 0) { li_l[r32] = l_reg; if (evalid) { f32x2 ml; ml.x = m_reg; ml.y = l_reg; *(f32x2*)(pml + 2 * (size_t)pslot) = ml; } }
    asm volatile("s_waitcnt lgkmcnt(0)" ::: "memory");
#pragma unroll
    for (int r = 0; r < 16; ++r) {
        const int rw = crow(r, hi); const int ps_ = tb[rw]; const float rl = __builtin_amdgcn_rcpf(li_l[rw]);
        if (ps_ >= 0) { bf16* orow = po + (size_t)ps_ * 128 + r32;
            orow[0] = (bf16)f2bf(o[0][r] * rl); orow[32] = (bf16)f2bf(o[1][r] * rl); orow[64] = (bf16)f2bf(o[2][r] * rl); orow[96] = (bf16)f2bf(o[3][r] * rl); }
    }
}
}

__device__ __forceinline__ void unpack8(const u32x4 w, float (&f)[8]) { f[0] = bf_lo(w.x); f[1] = bf_hi(w.x); f[2] = bf_lo(w.y); f[3] = bf_hi(w.y); f[4] = bf_lo(w.z); f[5] = bf_hi(w.z); f[6] = bf_lo(w.w); f[7] = bf_hi(w.w); }
__device__ __forceinline__ float dot8(const float (&q)[8], const float (&k)[8]) { float s = q[0] * k[0];
#pragma unroll
    for (int j = 1; j < 8; ++j) s = fmaf(q[j], k[j], s); return s; }
__device__ __forceinline__ bool gate_better(float v, int i, float w, int j) { return (v > w) || (v == w && i < j); }
#define TOP3_INSERT(ok, g, n) do { const float g_ = (g); const int n_ = (n); const bool ok_ = (ok); \
    const bool b0_ = ok_ && gate_better(g_, n_, v0, i0), b1_ = ok_ && gate_better(g_, n_, v1, i1), b2_ = ok_ && gate_better(g_, n_, v2, i2); \
    v2 = b1_ ? v1 : (b2_ ? g_ : v2); i2 = b1_ ? i1 : (b2_ ? n_ : i2); \
    v1 = b0_ ? v0 : (b1_ ? g_ : v1); i1 = b0_ ? i0 : (b1_ ? n_ : i1); \
    v0 = b0_ ? g_ : v0; i0 = b0_ ? n_ : i0; } while (0)
__device__ __forceinline__ void p3_gate_tile(const Args& a, int bh, int qt, int lane) {
    const bf16* qkv = (const bf16*)(a.ws + WS_QKV); const float* km = (const float*)(a.ws + WS_KMEAN);
    unsigned* mcnt = (unsigned*)(a.ws + WS_CTL) + CW_MCNT; int* mlist = (int*)(a.ws + WS_MLIST);
    const int b = bh >> 3, h = bh & 7, r32 = lane & 31, hi = lane >> 5, t0 = 32 * qt, own = t0 >> 8, t = t0 + r32;
    if (own == 0) return;
    f32x16 p;
#pragma unroll
    for (int i = 0; i < 16; ++i) p[i] = 0.f;
    const float* kp = km + ((size_t)bh * 32 + r32) * 128 + hi * 8;
    const bf16* qp = qkv + (size_t)(b * SEQ + t) * NQKV + 3072 + h * 128 + hi * 8;
#pragma unroll
    for (int d0 = 0; d0 < 8; ++d0) {
        const f32x4 k0 = *(const f32x4*)(kp + d0 * 16), k1 = *(const f32x4*)(kp + d0 * 16 + 4);
        u32x4 kw; kw.x = pk2(k0.x, k0.y); kw.y = pk2(k0.z, k0.w); kw.z = pk2(k1.x, k1.y); kw.w = pk2(k1.z, k1.w);
        const bf16x8 qf = *(const bf16x8*)(qp + d0 * 16);
        p = __builtin_amdgcn_mfma_f32_32x32x16_bf16(__builtin_bit_cast(bf16x8, kw), qf, p, 0, 0, 0);
    }
    float v0 = -INFINITY, v1 = -INFINITY, v2 = -INFINITY; int i0 = 64, i1 = 64, i2 = 64;
#pragma unroll
    for (int r = 0; r < 16; ++r) { const int n = (r & 3) + 8 * (r >> 2) + 4 * hi; TOP3_INSERT(n < own, p[r], n); }
    { const float w0 = mix::pair_other(v0, hi), w1 = mix::pair_other(v1, hi), w2 = mix::pair_other(v2, hi);
      const int j0 = __builtin_bit_cast(int, mix::pair_other(__builtin_bit_cast(float, i0), hi)), j1 = __builtin_bit_cast(int, mix::pair_other(__builtin_bit_cast(float, i1), hi)), j2 = __builtin_bit_cast(int, mix::pair_other(__builtin_bit_cast(float, i2), hi));
      TOP3_INSERT(j0 < 64, w0, j0); TOP3_INSERT(j1 < 64, w1, j1); TOP3_INSERT(j2 < 64, w2, j2); }
    const int nsel = own < 3 ? own : 3;
    const bool ql = hi == 0;
    const bool s1 = nsel > 1, s2 = nsel > 2;
    const unsigned long long ltmask = (1ull << lane) - 1ull;
    int mycount = 0, r0 = 0, r1 = 0, r2 = 0;
    for (int n = 0; n < own; ++n) {
        const unsigned long long mk = __builtin_amdgcn_ballot_w64(ql && (i0 == n || (s1 && i1 == n) || (s2 && i2 == n)));
        const int c = __builtin_popcountll(mk), rk = __builtin_popcountll(mk & ltmask);
        if (lane == n) mycount = c;
        if (i0 == n) r0 = rk; if (i1 == n) r1 = rk; if (i2 == n) r2 = rk;
    }
    int basev = 0;
    if (lane < own && mycount > 0) basev = (int)__hip_atomic_fetch_add(mcnt + 16 * (bh * 32 + lane), (unsigned)mycount, RLX_AGENT);
    const int q0 = __shfl(basev, i0 & 31) + r0, q1 = __shfl(basev, i1 & 31) + r1, q2 = __shfl(basev, i2 & 31) + r2;
    if (ql) {
        mlist[(size_t)(bh * 32 + i0) * SEQ + q0] = t | (0 << 16);
        if (s1) mlist[(size_t)(bh * 32 + i1) * SEQ + q1] = t | (1 << 16);
        if (s2) mlist[(size_t)(bh * 32 + i2) * SEQ + q2] = t | (2 << 16);
    }
}
__device__ __forceinline__ void p3_sb_and_gate(const Args& a, LAS unsigned char* lds, int G, int wg, int gw, int NGW, int lane) {
    for (int it = gw; it < 16 * (SEQ / 32); it += NGW) p3_gate_tile(a, it >> 8, it & 255, lane);
}
__device__ __forceinline__ void p4_moba(const Args& a, LAS unsigned char* lds, int G, int wg) {
    const unsigned* mcnt = (const unsigned*)(a.ws + WS_CTL) + CW_MCNT; const int* mlist = (const int*)(a.ws + WS_MLIST);
    LAS int* pre = (LAS int*)(lds + mix::L_PRE);
    const int tid = threadIdx.x;
    __syncthreads();
    if (tid < 64) {
        int c[8], s = 0;
#pragma unroll
        for (int i = 0; i < 8; ++i) { c[i] = ((int)mcnt[16 * (tid * 8 + i)] + 255) >> 8; s += c[i]; }
        int inc = s;
#pragma unroll
        for (int o = 1; o < 64; o <<= 1) { const int v = __shfl_up(inc, o); if (tid >= o) inc += v; }
        int run = inc - s;
#pragma unroll
        for (int i = 0; i < 8; ++i) { pre[tid * 8 + i] = run; run += c[i]; }
        if (tid == 63) pre[512] = run;
    }
    __syncthreads();
    const int usel = pre[512], total = usel + 512;
    for (int uu = wg; uu < total + 16 * 32; uu += G) {
        if (uu < 16 * 32) { mix::sb_unit(a, lds, uu >> 5, uu & 31); continue; }
        const int u = uu - 16 * 32;
        if (u < usel) {
            int lo = 0, hi = 511;
            while (lo < hi) { const int mid = (lo + hi + 1) >> 1; if (pre[mid] <= u) lo = mid; else hi = mid - 1; }
            const int k = __builtin_amdgcn_readfirstlane(lo), c = u - pre[k];
            const int cnt = (int)mcnt[16 * k];
            mix::moba_unit(a, lds, k >> 5, k & 31, mlist + (size_t)k * SEQ + c * 256, (cnt - c * 256) < 256 ? (cnt - c * 256) : 256, false);
        } else { const int k = u - usel; mix::moba_unit(a, lds, k >> 5, k & 31, nullptr, 256, true); }
    }
}
__device__ __forceinline__ void p5_combine(const Args& a, int gw, int NGW, int lane) {
    const bf16* po = (const bf16*)(a.ws + WS_MPO); const float* pml = (const float*)(a.ws + WS_MPML); bf16* mixed = (bf16*)(a.ws + WS_MIXED);
    const int sub = lane >> 4, dl = lane & 15;
    for (int it = gw; it < 16 * (SEQ / 4); it += NGW) {
        const int bh = it & 15, t = 4 * (it >> 4) + sub, b = bh >> 3, h = bh & 7, own = t >> 8, nsel = own < 3 ? own : 3;
        const size_t ps0 = ((size_t)(bh * SEQ + t)) << 2;
        f32x2 ml[4]; float M = -1e30f;
#pragma unroll
        for (int s = 0; s < 4; ++s) { const bool ok = (s == 3) || (s < nsel); ml[s] = ok ? *(const f32x2*)(pml + 2 * (ps0 + s)) : (f32x2){-1e30f, 0.f}; M = fmaxf(M, ml[s].x); }
        float w[4], W = 0.f;
#pragma unroll
        for (int s = 0; s < 4; ++s) { w[s] = ml[s].y * __builtin_amdgcn_exp2f(ml[s].x - M); W += w[s]; }
        const float iw = 1.f / W;
        float o[8] = {0, 0, 0, 0, 0, 0, 0, 0};
#pragma unroll
        for (int s = 0; s < 4; ++s) { const bool ok = (s == 3) || (s < nsel);
            if (ok) { float f[8]; unpack8(*(const u32x4*)(po + (ps0 + s) * 128 + 8 * dl), f); const float ws_ = w[s] * iw;
#pragma unroll
                for (int jj = 0; jj < 8; ++jj) o[jj] = fmaf(ws_, f[jj], o[jj]); } }
        float ss = 0.f;
#pragma unroll
        for (int jj = 0; jj < 8; ++jj) ss = fmaf(o[jj], o[jj], ss);
        ss = reduce16(ss) * (1.f / 128.f);
        const float r = 1.f / sqrtf(ss + RMS_EPS);
        const float* gain = a.norm_moba + h * 128 + 8 * dl; const f32x4 g0 = *(const f32x4*)gain, g1 = *(const f32x4*)(gain + 4);
        u32x4 wv; wv.x = pk2(o[0] * r * g0.x, o[1] * r * g0.y); wv.y = pk2(o[2] * r * g0.z, o[3] * r * g0.w); wv.z = pk2(o[4] * r * g1.x, o[5] * r * g1.y); wv.w = pk2(o[6] * r * g1.z, o[7] * r * g1.w);
        *(u32x4*)(mixed + (size_t)(b * SEQ + t) * D + 1024 + h * 128 + 8 * dl) = wv;
    }
}

constexpr int LNT_STRIDE = 2052;
__device__ __forceinline__ void ln1_row_tile(const bf16* src, const float* g, const float* bta, bf16* dst_bf16, unsigned char* dst_q, LAS float* trow, int lane) {
    const GAS u32x2* xr = (const GAS u32x2*)src + lane;
    f32x4 v[8]; float s = 0.f;
#pragma unroll
    for (int j = 0; j < 8; ++j) { const u32x2 w = xr[64 * j]; v[j].x = bf_lo(w.x); v[j].y = bf_hi(w.x); v[j].z = bf_lo(w.y); v[j].w = bf_hi(w.y); s += (v[j].x + v[j].y) + (v[j].z + v[j].w); }
    const float mean = wave_sum(s) * (1.f / D); float s2 = 0.f;
#pragma unroll
    for (int j = 0; j < 8; ++j) { v[j] = v[j] - mean; s2 += (v[j].x * v[j].x + v[j].y * v[j].y) + (v[j].z * v[j].z + v[j].w * v[j].w); }
    const float rstd = 1.f / sqrtf(wave_sum(s2) * (1.f / D) + LN_EPS);
#pragma unroll
    for (int j = 0; j < 8; ++j) { const f32x4 gg = ((const GAS f32x4*)g)[lane + 64 * j], bb = ((const GAS f32x4*)bta)[lane + 64 * j]; const f32x4 y = v[j] * rstd * gg + bb;
        *(LAS f32x4*)(trow + 4 * (lane + 64 * j)) = y; u32x2 o; o.x = pk2(y.x, y.y); o.y = pk2(y.z, y.w); ((GAS u32x2*)dst_bf16)[lane + 64 * j] = o;
        ((GAS unsigned*)dst_q)[lane + 64 * j] = pack_fp8x4(y.x * XSCALE, y.y * XSCALE, y.z * XSCALE, y.w * XSCALE); }
}
constexpr int LNP_OFF = 136192;
__device__ __forceinline__ void router_top4(const Args& a, LAS unsigned char* lds, int r0, int lane) {
    int* rowtok = (int*)(a.ws + WS_ROWTOK); float* rowg = (float*)(a.ws + WS_ROWG); int* toksl = (int*)(a.ws + WS_TOKSL);
    unsigned* ecnt = (unsigned*)(a.ws + WS_CTL) + CW_ECNT;
    const LAS float* Pp = (const LAS float*)(lds + LNP_OFF);
    const int row = lane & 15; const bool tl = lane < 16;
    float v0 = -INFINITY, v1 = -INFINITY, v2 = -INFINITY, v3 = -INFINITY; int e0 = 0, e1 = 0, e2 = 0, e3 = 0;
    for (int e = 0; e < 32; ++e) { float g = a.b_router[e];
#pragma unroll
        for (int w = 0; w < 8; ++w) g += Pp[(w * 16 + row) * 32 + e];
        if (g > v0) { v3 = v2; e3 = e2; v2 = v1; e2 = e1; v1 = v0; e1 = e0; v0 = g; e0 = e; }
        else if (g > v1) { v3 = v2; e3 = e2; v2 = v1; e2 = e1; v1 = g; e1 = e; }
        else if (g > v2) { v3 = v2; e3 = e2; v2 = g; e2 = e; }
        else if (g > v3) { v3 = g; e3 = e; } }
    const float p1 = __expf(v1 - v0), p2 = __expf(v2 - v0), p3 = __expf(v3 - v0), inv = 1.f / (1.f + p1 + p2 + p3);
    const unsigned long long ltmask = (1ull << lane) - 1ull;
    int mycount = 0, r0k = 0, r1k = 0, r2k = 0, r3k = 0;
    for (int e = 0; e < 32; ++e) {
        const unsigned long long mk = __builtin_amdgcn_ballot_w64(tl && (e0 == e || e1 == e || e2 == e || e3 == e));
        const int c = __builtin_popcountll(mk), rk = __builtin_popcountll(mk & ltmask);
        if (lane == e) mycount = c;
        if (e0 == e) r0k = rk; if (e1 == e) r1k = rk; if (e2 == e) r2k = rk; if (e3 == e) r3k = rk;
    }
    int basev = 0;
    { int ln = lane; asm volatile("" : "+v"(ln));
      if (ln < 32 && mycount > 0) basev = (int)__hip_atomic_fetch_add(ecnt + 32 * ln, (unsigned)mycount, RLX_AGENT); }
    const int q0 = __shfl(basev, e0) + r0k, q1 = __shfl(basev, e1) + r1k, q2 = __shfl(basev, e2) + r2k, q3 = __shfl(basev, e3) + r3k;
    if (tl) {
        const int tok = r0 + lane;
        rowtok[e0 * ECAP + q0] = tok; rowg[e0 * ECAP + q0] = inv;
        rowtok[e1 * ECAP + q1] = tok; rowg[e1 * ECAP + q1] = p1 * inv;
        rowtok[e2 * ECAP + q2] = tok; rowg[e2 * ECAP + q2] = p2 * inv;
        rowtok[e3 * ECAP + q3] = tok; rowg[e3 * ECAP + q3] = p3 * inv;
        int4 sl; sl.x = (e0 << 16) | q0; sl.y = (e1 << 16) | q1; sl.z = (e2 << 16) | q2; sl.w = (e3 << 16) | q3;
        *(int4*)(toksl + 4 * tok) = sl;
    }
}
__device__ __forceinline__ void p7_ln1_router(const Args& a, LAS unsigned char* lds, int vcu, int G, int wave, int lane) {
    const bf16* hh = (const bf16*)(a.ws + WS_H); bf16* x1b = (bf16*)(a.ws + WS_X1B); unsigned char* x1q = (unsigned char*)(a.ws + WS_X1Q);
    LAS float* T = (LAS float*)(lds + RING_OFF); LAS float* Pp = (LAS float*)(lds + LNP_OFF);
    const int n16 = lane & 15, kq = lane >> 4;
    float breg[64][2];
#pragma unroll
    for (int sI = 0; sI < 64; ++sI) { const float* bp = a.w_router + (size_t)(256 * wave + 4 * sI + kq) * NE + n16; breg[sI][0] = bp[0]; breg[sI][1] = bp[16]; }
    int prev_r0 = -1;
    for (int tile = vcu;; tile += G) {
        const bool has = tile < M / 16;
        const int r0 = tile * 16;
        if (wave == 0) { if (prev_r0 >= 0) router_top4(a, lds, prev_r0, lane); }
        else if (has) {
            const int nr = wave <= 2 ? 3 : 2;
            for (int rr = 0; rr < nr; ++rr) { const int rl = rr < 2 ? 2 * (wave - 1) + rr : 13 + wave;
                ln1_row_tile(hh + (size_t)(r0 + rl) * D, a.ln1_g, a.ln1_b, x1b + (size_t)(r0 + rl) * D, x1q + (size_t)(r0 + rl) * D, T + rl * LNT_STRIDE, lane); }
        }
        if (!has) break;
        __syncthreads();
        f32x4 acc0 = {0.f, 0.f, 0.f, 0.f}, acc1 = {0.f, 0.f, 0.f, 0.f};
        const LAS float* ap = T + n16 * LNT_STRIDE + 256 * wave + kq;
#pragma unroll
        for (int sI = 0; sI < 64; ++sI) { if ((sI & 15) == 0) __builtin_amdgcn_sched_barrier(0);
            const float av = ap[4 * sI];
            acc0 = __builtin_amdgcn_mfma_f32_16x16x4f32(av, breg[sI][0], acc0, 0, 0, 0);
            acc1 = __builtin_amdgcn_mfma_f32_16x16x4f32(av, breg[sI][1], acc1, 0, 0, 0); }
#pragma unroll
        for (int i = 0; i < 4; ++i) { Pp[(wave * 16 + 4 * kq + i) * 32 + n16] = acc0[i]; Pp[(wave * 16 + 4 * kq + i) * 32 + 16 + n16] = acc1[i]; }
        __syncthreads();
        prev_r0 = r0;
    }
    __syncthreads();
}

__device__ __forceinline__ void p9_ln2(const Args& a, const LAS int* tab, int gw, int NGW, int lane) {
    const bf16* x1b = (const bf16*)(a.ws + WS_X1B); const unsigned char* Y = (const unsigned char*)(a.ws + WS_Y); const int* toksl = (const int*)(a.ws + WS_TOKSL);
    bf16* x2b = (bf16*)(a.ws + WS_X2B); unsigned char* x2q = (unsigned char*)(a.ws + WS_X2Q);
    for (int m = gw; m < M; m += NGW) {
        const int4 sl = *(const int4*)(toksl + 4 * m);
        const int rr[4] = {tab[sl.x >> 16] * 256 + (sl.x & 0xffff), tab[sl.y >> 16] * 256 + (sl.y & 0xffff), tab[sl.z >> 16] * 256 + (sl.z & 0xffff), tab[sl.w >> 16] * 256 + (sl.w & 0xffff)};
        const GAS u32x2* xr = (const GAS u32x2*)(x1b + (size_t)m * D) + lane;
        f32x4 v[8]; float s = 0.f;
#pragma unroll
        for (int j = 0; j < 8; ++j) { const u32x2 xw = xr[64 * j]; f32x4 t; t.x = bf_lo(xw.x) * DN_ALPHA; t.y = bf_hi(xw.x) * DN_ALPHA; t.z = bf_lo(xw.y) * DN_ALPHA; t.w = bf_hi(xw.y) * DN_ALPHA;
#pragma unroll
            for (int k = 0; k < 4; ++k) { const unsigned w = ((const GAS unsigned*)(Y + (size_t)rr[k] * D))[lane + 64 * j]; const f32x2 lo = __builtin_amdgcn_cvt_pk_f32_fp8(w, false), hi = __builtin_amdgcn_cvt_pk_f32_fp8(w, true);
                t.x = fmaf(lo.x, 1.f / YSCALE, t.x); t.y = fmaf(lo.y, 1.f / YSCALE, t.y); t.z = fmaf(hi.x, 1.f / YSCALE, t.z); t.w = fmaf(hi.y, 1.f / YSCALE, t.w); }
            v[j] = t; s += (t.x + t.y) + (t.z + t.w); }
        const float mean = wave_sum(s) * (1.f / D); float s2 = 0.f;
#pragma unroll
        for (int j = 0; j < 8; ++j) { v[j] = v[j] - mean; s2 += (v[j].x * v[j].x + v[j].y * v[j].y) + (v[j].z * v[j].z + v[j].w * v[j].w); }
        const float rstd = 1.f / sqrtf(wave_sum(s2) * (1.f / D) + LN_EPS);
#pragma unroll
        for (int j = 0; j < 8; ++j) { const f32x4 gg = ((const GAS f32x4*)a.ln2_g)[lane + 64 * j], bb = ((const GAS f32x4*)a.ln2_b)[lane + 64 * j]; const f32x4 y = v[j] * rstd * gg + bb;
            u32x2 o; o.x = pk2(y.x, y.y); o.y = pk2(y.z, y.w); ((GAS u32x2*)(x2b + (size_t)m * D))[lane + 64 * j] = o;
            ((GAS unsigned*)(x2q + (size_t)m * D))[lane + 64 * j] = pack_fp8x4(y.x * XSCALE, y.y * XSCALE, y.z * XSCALE, y.w * XSCALE); }
    }
}

#ifndef REP_PHASE
#define REP_PHASE (-1)
#endif
constexpr int NPHASE = 13;
__global__ void __launch_bounds__(512, 2) fwd_kernel(Args args) {
    extern __shared__ __attribute__((aligned(16))) unsigned char lds_raw[];
    LAS unsigned char* lds = (LAS unsigned char*)lds_raw;
    volatile LAS unsigned* MISC = (volatile LAS unsigned*)(lds + MISC_OFF);
    const int tid = threadIdx.x, lane = tid & 63, wave = __builtin_amdgcn_readfirstlane(tid >> 6);
    const int G = gridDim.x; const int bx = blockIdx.x;
    const int vcu = (G % 8 == 0) ? (bx % 8) * (G / 8) + bx / 8 : bx;
    const int gw = vcu * 8 + wave, NGW = G * 8;
    unsigned char* ws = args.ws;
    unsigned* ctl = (unsigned*)(ws + WS_CTL);
    for (int u = tid; u < (LDS_BYTES - LDSCTL_OFF) / 4; u += 512) ((LAS unsigned*)(lds + LDSCTL_OFF))[u] = 0u;
    __syncthreads();
    const int lo = args.ph_lo, hi = args.ph_hi;
    const bool use_bar = (hi - lo) > 1;
    XcdBarrier bar; bar.bar = ctl + CW_BAR; bar.x = 0; bar.st = nullptr;
    if (use_bar) bar = xcd_barrier_post(ctl + CW_BAR, MISC + 8);
#ifdef ONLY_PHASE
#define IN(k) ((k) == ONLY_PHASE)
#else
#define IN(k) (lo <= (k) && (k) < hi)
#endif
#define SEAM(k) do { if (IN(k) && IN((k) + 1)) xcd_barrier(bar); } while (0)
    LAS int* moetab = (LAS int*)(lds + MOE_OFF);
    const bool cvon = (NGW == CV_LISTS);
    const bool cvfirst = ((bx >> 3) & 1) == 0;
    const int len_up = cvon ? cv_list_len(gw, CV_UP_END) : 0, len_all = cvon ? cv_list_len(gw, CV_BLOCKS) : 0;

    if (IN(0)) { p0_prologue(args, lds, gw, NGW, wave, lane); SEAM(0); }
    if (IN(1)) {
        if (cvon && cvfirst) cv_range(args, gw, 0, len_up, lane);
        { pg8::Gemm g{(const bf16*)(ws + WS_XB), (const bf16*)(ws + WS_WINT), D, 0, nullptr}; DenseSched S; S.init(M, NQKV, G, bx);
          EpiQKV E{(bf16*)(ws + WS_QKV), NQKV, true, (float*)(ws + WS_KMEAN)};
          pg8::gemm_phase<EpiQKV, DenseSched, false, true>(lds + RING_OFF, g, S, E); }
        { pg8::Gemm g{(const bf16*)(ws + WS_PB), (const bf16*)(ws + WS_WPLET), PLE, 0, nullptr}; DenseSched S; S.init(M, D, G, bx);
          EpiQKV E{(bf16*)(ws + WS_PLEB), D, false, nullptr};
          pg8::gemm_phase<EpiQKV, DenseSched, false, true>(lds + RING_OFF, g, S, E); }
        if (cvon && !cvfirst) cv_range(args, gw, 0, len_up, lane);
        SEAM(1);
    }
    if (IN(3)) { p3_sb_and_gate(args, lds, G, bx, gw, NGW, lane); SEAM(3); }
    if (IN(4)) { p4_moba(args, lds, G, bx); SEAM(4); }
    if (IN(5)) { p5_combine(args, gw, NGW, lane); SEAM(5); }
    if (IN(6)) {
        pg8::Gemm g{(const bf16*)(ws + WS_MIXED), (const bf16*)(ws + WS_WOUTT), D, 0, nullptr}; DenseSched S; S.init(M, D, G, bx);
        EpiH E{(const bf16*)(ws + WS_XB), (bf16*)(ws + WS_H)};
        pg8::gemm_phase<EpiH, DenseSched, false, true>(lds + RING_OFF, g, S, E);
        SEAM(6);
    }
    if (IN(7)) { p7_ln1_router(args, lds, vcu, G, wave, lane); SEAM(7); }
    if (IN(8)) {
        if (!cvon) { for (int blk = gw; blk < CV_BLOCKS; blk += NGW) { P0Job j0; int it0; p0_locate_b(args, 2 * blk, j0, it0); f32x4 v0[16]; cv_load(j0, it0 >> 1, lane, v0); cv_store(j0, it0 >> 1, lane, v0); } SEAM(8); }
    }
    if (IN(9)) {
        if (cvon && !cvfirst) cv_range(args, gw, len_up, len_all, lane);
        moe_table(moetab, ctl + CW_ECNT);
        pg8::Gemm g{(const bf16*)(ws + WS_X1Q), (const bf16*)(ws + WS_WUPT), D / 2, (size_t)2 * DFF * D / 2, (const int*)(ws + WS_ROWTOK)};
        MoeSched S{moetab, 2 * DFF / 256, G, bx};
        EpiUp E{(unsigned char*)(ws + WS_ACT), (const float*)(ws + WS_BUPP)};
        pg8::gemm_phase<EpiUp, MoeSched, true, true, true>(lds + RING_OFF, g, S, E);
        if (cvon && cvfirst) cv_range(args, gw, len_up, len_all, lane);
        SEAM(9);
    }
    if (IN(10)) {
        moe_table(moetab, ctl + CW_ECNT);
        pg8::Gemm g{(const bf16*)(ws + WS_ACT), (const bf16*)(ws + WS_WDNT), DFF / 2, (size_t)D * DFF / 2, nullptr};
        MoeSched S{moetab, D / 256, G, bx};
        EpiDown E{(unsigned char*)(ws + WS_Y), args.b_down, (const float*)(ws + WS_ROWG)};
        pg8::gemm_phase<EpiDown, MoeSched, false, true, true>(lds + RING_OFF, g, S, E);
        SEAM(10);
    }
    if (IN(11)) { moe_table(moetab, ctl + CW_ECNT); p9_ln2(args, moetab, gw, NGW, lane); SEAM(11); }
    if (IN(12)) {
        pg8::Gemm g{(const bf16*)(ws + WS_X2Q), (const bf16*)(ws + WS_WGT), D / 2, 0, nullptr}; DenseSched S; S.init(M, D, G, bx);
        EpiOut E{args.out, args.b_ple_gate, (const bf16*)(ws + WS_PLEB), (const bf16*)(ws + WS_X2B)};
        pg8::gemm_phase<EpiOut, DenseSched, false, true, true>(lds + RING_OFF, g, S, E);
    }
#undef IN
#undef SEAM
}

#ifndef N_LAUNCHES
#define N_LAUNCHES 1
#endif
extern "C" void kernel_launch(void* const* d_in, const int* in_sizes, int n_in, void* d_out, int out_size, void* d_ws, size_t ws_size, hipStream_t stream) {
    static int grid = 0;
    if (grid == 0) {
        if (n_in != 19 || in_sizes[0] != M * D || out_size != M * D || ws_size < WS_END) { fprintf(stderr, "kernel_launch: unexpected shapes: n_in %d in0 %d out %d ws %zu (need %zu)\n", n_in, n_in > 0 ? in_sizes[0] : -1, out_size, ws_size, (size_t)WS_END); grid = -1; return; }
        int dev = 0, cus = 0, per_cu = 0;
        if (hipGetDevice(&dev) != hipSuccess || hipDeviceGetAttribute(&cus, hipDeviceAttributeMultiprocessorCount, dev) != hipSuccess) { grid = -1; return; }
        if (hipFuncSetAttribute((const void*)fwd_kernel, hipFuncAttributeMaxDynamicSharedMemorySize, LDS_BYTES) != hipSuccess) { fprintf(stderr, "kernel_launch: hipFuncSetAttribute failed\n"); grid = -1; return; }
        if (hipOccupancyMaxActiveBlocksPerMultiprocessor(&per_cu, (const void*)fwd_kernel, 512, LDS_BYTES) != hipSuccess || per_cu < 1) fprintf(stderr, "kernel_launch: occupancy query says %d\n", per_cu);
        (void)hipGetLastError();
        grid = cus;
    }
    if (grid < 0) return;
    if (hipMemsetAsync((char*)d_ws + WS_CTL, 0, CTL_ZERO_BYTES, stream) != hipSuccess) { fprintf(stderr, "kernel_launch: memset failed\n"); return; }
    Args a{};
    a.x = (const float*)d_in[0]; a.p = (const float*)d_in[1]; a.w_in = (const float*)d_in[2]; a.norm_sb = (const float*)d_in[3]; a.norm_moba = (const float*)d_in[4];
    a.w_out = (const float*)d_in[5]; a.ln1_g = (const float*)d_in[6]; a.ln1_b = (const float*)d_in[7]; a.w_router = (const float*)d_in[8]; a.b_router = (const float*)d_in[9];
    a.w_up = (const float*)d_in[10]; a.b_up = (const float*)d_in[11]; a.w_down = (const float*)d_in[12]; a.b_down = (const float*)d_in[13]; a.ln2_g = (const float*)d_in[14]; a.ln2_b = (const float*)d_in[15];
    a.w_ple = (const float*)d_in[16]; a.w_ple_gate = (const float*)d_in[17]; a.b_ple_gate = (const float*)d_in[18];
    a.out = (float*)d_out; a.ws = (unsigned char*)d_ws;
    if (N_LAUNCHES == 1) { a.ph_lo = 0; a.ph_hi = NPHASE; hipLaunchKernelGGL(fwd_kernel, dim3(grid), dim3(512), LDS_BYTES, stream, a); }
    else for (int li = 0; li < NPHASE; ++li) { a.ph_lo = li; a.ph_hi = li + 1; hipLaunchKernelGGL(fwd_kernel, dim3(grid), dim3(512), LDS_BYTES, stream, a); }
    const hipError_t le = hipPeekAtLastError();
    if (le != hipSuccess) fprintf(stderr, "kernel_launch: launch failed: %s\n", hipGetErrorName(le));
}
```

```cpp
#include <hip/hip_runtime.h>
#include <cstdio>
#include <cstdint>
#include <cmath>

#define GAS __attribute__((address_space(1)))
#define LAS __attribute__((address_space(3)))
typedef unsigned short bf16;
typedef unsigned short bf16_t;
typedef short bf16x8 __attribute__((ext_vector_type(8)));
typedef float f32x4 __attribute__((ext_vector_type(4)));
typedef float f32x2 __attribute__((ext_vector_type(2)));
typedef float f32x16 __attribute__((ext_vector_type(16)));
typedef unsigned u32x4 __attribute__((ext_vector_type(4)));
typedef unsigned u32x2 __attribute__((ext_vector_type(2)));
typedef GAS unsigned gu32;
#define RLX_AGENT __ATOMIC_RELAXED, __HIP_MEMORY_SCOPE_AGENT
#define LDS_WAIT() asm volatile("s_waitcnt lgkmcnt(0)" ::: "memory")
#define VM_WAIT() asm volatile("s_waitcnt vmcnt(0)" ::: "memory")

#ifndef PROBE_ID
#define PROBE_ID 0
#endif
__device__ __forceinline__ unsigned pb_begin(int id) { return (PROBE_ID == id) ? (unsigned)__builtin_amdgcn_readfirstlane((int)(unsigned)__builtin_amdgcn_s_memrealtime()) : 0u; }
__device__ __forceinline__ void pb_end(int id, unsigned t0) {
    if (PROBE_ID == id) { const unsigned t1 = (unsigned)__builtin_amdgcn_s_memrealtime(), dt = t1 - t0; while ((unsigned)__builtin_amdgcn_s_memrealtime() - t1 < dt) __builtin_amdgcn_s_sleep(8); }
}
constexpr int BATCH = 2, SEQ = 8192, M = BATCH * SEQ, D = 2048, NQKV = 6144, HD = 128, NH = 8, NE = 32, TOPK = 4, DFF = 2048, PLE = 256;
constexpr int ECAP = 16384;
constexpr int ACT_ROWS = M * TOPK + NE * 256;
constexpr float LN_EPS = 1e-5f, RMS_EPS = 1e-6f;
constexpr float DN_ALPHA = 1.189207115002721f;
constexpr float LOG2E = 1.4426950408889634f;
constexpr float QSCALE = 0.08838834764831845f * LOG2E;
constexpr float SWIGLU_LIMIT = 7.0f, SWIGLU_ALPHA = 1.702f;
constexpr float YSCALE = 64.f;
constexpr float WSCALE = 512.f, XSCALE = 16.f, ASCALE = 8.f, UP_DESCALE = 1.f / (512.f * 16.f), DN_DESCALE = 1.f / (512.f * 8.f);

constexpr size_t MiB = 1u << 20;
constexpr size_t WS_CTL = 0, CTL_ZERO_BYTES = 1 * MiB;
constexpr size_t WS_WINT = 2 * MiB, WS_WOUTT = 26 * MiB, WS_WGT = 34 * MiB, WS_WPLET = 42 * MiB, WS_BUPP = 43 * MiB, WS_KMEAN = 44 * MiB;
constexpr size_t WS_XB = 48 * MiB, WS_PB = 112 * MiB, WS_QKV = 128 * MiB, WS_MIXED = 320 * MiB, WS_H = 384 * MiB, WS_X1 = 512 * MiB, WS_X1B = 640 * MiB;
constexpr size_t WS_PLEB = 704 * MiB, WS_ROWTOK = 768 * MiB, WS_ROWG = 770 * MiB, WS_TOKSL = 772 * MiB, WS_X2B = 776 * MiB;
constexpr size_t WS_ACT = 840 * MiB, WS_Y = 1128 * MiB, WS_WUPT = 1416 * MiB, WS_WDNT = 1928 * MiB;
constexpr size_t WS_MLIST = 2184 * MiB, WS_MPO = 2200 * MiB, WS_MPML = 2328 * MiB, WS_X1Q = 2336 * MiB, WS_X2Q = 2368 * MiB, WS_END = 2400 * MiB;
static_assert((size_t)ACT_ROWS * DFF * 2 <= 288 * MiB, "act rows");
constexpr int CW_TMO = 0, CW_CODE = 1;
constexpr int CW_BAR = 4096;
constexpr int CW_MCNT = 32768;
constexpr int CW_DONE = 49152;
constexpr int CW_CUR = 53248;
constexpr int CW_ECNT = 16384;

constexpr int RING_OFF = 0, RING_BYTES = 131072;
constexpr int LDSCTL_OFF = 135168;
constexpr int MISC_OFF = LDSCTL_OFF;
constexpr int MOE_OFF = LDSCTL_OFF + 256;
constexpr int LDS_BYTES = 163840;

__device__ __forceinline__ unsigned f2bf(float f) { unsigned u = __builtin_bit_cast(unsigned, f); return (u + 0x7fffu + ((u >> 16) & 1u)) >> 16; }
__device__ __forceinline__ unsigned pk2(float lo, float hi) { unsigned r; asm("v_cvt_pk_bf16_f32 %0, %1, %2" : "=v"(r) : "v"(lo), "v"(hi)); return r; }
__device__ __forceinline__ float bf_lo(unsigned w) { return __builtin_bit_cast(float, w << 16); }
__device__ __forceinline__ float bf_hi(unsigned w) { return __builtin_bit_cast(float, w & 0xffff0000u); }

__device__ __forceinline__ float clamp448(float v) { return __builtin_amdgcn_fmed3f(v, -448.f, 448.f); }
__device__ __forceinline__ unsigned pack_fp8x4(float a, float b, float c, float d) {
    unsigned w = 0; w = __builtin_amdgcn_cvt_pk_fp8_f32(clamp448(a), clamp448(b), w, false); w = __builtin_amdgcn_cvt_pk_fp8_f32(clamp448(c), clamp448(d), w, true); return w;
}

__device__ __forceinline__ unsigned pack_fp8x4_nc(float a, float b, float c, float d) {
    unsigned w = 0; w = __builtin_amdgcn_cvt_pk_fp8_f32(a, b, w, false); w = __builtin_amdgcn_cvt_pk_fp8_f32(c, d, w, true); return w;
}

namespace pg8 {
constexpr bool DMA_IN_MMA = false;
constexpr bool BAL_DMA = true;
constexpr int BM = 256, BK = 64, HALF = 128, HTB = HALF * BK * 2, STAGE_BYTES = 8 * HTB;
__host__ __device__ __forceinline__ int lds_byte(int r, int c) { const int st = (r >> 4) * 2 + (c >> 5), rr = r & 15, cc = c & 31, ob = rr * 64 + cc * 2; return st * 1024 + (ob ^ (((ob >> 9) & 1) << 5)); }
__host__ __device__ __forceinline__ void stage_rc(int b, int& R, int& C) { const int st = b / 1024, sb = b % 1024, swz = sb ^ (((sb >> 9) & 1) << 5); R = (st >> 1) * 16 + swz / 64; C = (st & 1) * 32 + (swz % 64) / 2; }
__host__ __device__ __forceinline__ int q_f(int r) { return ((r >> 1) & 1) | (((r >> 3) & 1) << 2); }
__host__ __device__ __forceinline__ int lds_byte_q(int r, int c16) { return r * 128 + 16 * (c16 ^ q_f(r & 15)); }
__host__ __device__ __forceinline__ void stage_rc_q(int b, int& R, int& C) { const int s = b >> 4; R = s >> 3; C = 8 * ((s & 7) ^ q_f(R & 15)); }
__host__ __device__ __forceinline__ int perm32(int rho) { const int n = rho >> 4, i = rho & 15; return 8 * (i >> 2) + 4 * n + (i & 3); }

struct Unit { int pm, pn, e, tab, cnt; };
struct Gemm { const bf16_t* A; const bf16_t* Bt; int K; size_t bstride; const int* rowtab; };

__device__ __forceinline__ unsigned cvt_pk_bf16(float lo, float hi) { unsigned r; asm volatile("v_cvt_pk_bf16_f32 %0, %1, %2" : "=v"(r) : "v"(lo), "v"(hi)); return r; }

typedef int v8i __attribute__((ext_vector_type(8)));
typedef int v8i_u __attribute__((ext_vector_type(8), aligned(16)));
template <class Epi, class Sched, bool GATHER, bool ALIGN_EPI, bool FP8 = false>
__device__ __forceinline__ void gemm_phase(LAS unsigned char* lds, const Gemm g, const Sched& S, const Epi& E) {
    const int tid = threadIdx.x, wid = __builtin_amdgcn_readfirstlane(tid >> 6), lane = tid & 63, wr = wid >> 2, wc = wid & 3, fr = lane & 15, fq = lane >> 4;
    const int K = g.K, nt = K / BK;
    unsigned voffA[2], voffB[2]; int RA[2], CA[2];
#pragma unroll
    for (int i = 0; i < 2; ++i) { int R, C; if constexpr (FP8) stage_rc_q(tid * 16 + i * 8192, R, C); else stage_rc(tid * 16 + i * 8192, R, C); const int Rb = Epi::PERM ? ((R & ~31) + perm32(R & 31)) : R;
        voffA[i] = (unsigned)(R * K + C) * 2u; voffB[i] = (unsigned)(Rb * K + C) * 2u; RA[i] = R; CA[i] = C; }
    const size_t kstep = (size_t)(BK * 2);
    const size_t hstep = (size_t)HALF * K * 2;
    const size_t tstep = 2 * hstep;
    const unsigned ldsw = (unsigned)wid * 1024u;
    const int aoff = lds_byte(wr * 64 + fr, fq * 8), boff = lds_byte(wc * 32 + fr, fq * 8);
    const int aoq0 = lds_byte_q(wr * 64 + fr, 2 * fq), aoq1 = lds_byte_q(wr * 64 + fr, 2 * fq + 1), boq0 = lds_byte_q(wc * 32 + fr, 2 * fq), boq1 = lds_byte_q(wc * 32 + fr, 2 * fq + 1);
#define PG8_SA(b, h) (((b) * 2 + (h)) * HTB)
#define PG8_SB(b, h) ((4 + (b) * 2 + (h)) * HTB)
#define PG8_STAGE(bufoff, gbase, voff) do { _Pragma("unroll") for (int _i = 0; _i < 2; ++_i) { unsigned keep_; \
        asm volatile("s_mov_b32 %0, m0\n\ts_mov_b32 m0, %3\n\ts_nop 0\n\tglobal_load_lds_dwordx4 %1, %2\n\ts_mov_b32 m0, %0" \
            : "=&s"(keep_) : "v"((voff)[_i]), "s"((const char*)(gbase)), "s"((unsigned)(uintptr_t)(lds + (bufoff) + _i * 8192) + ldsw) : "memory"); } } while (0)
#define PG8_LDQ(dst, base, o0, o1) do { const u32x4 lo_ = *(const LAS u32x4*)(lds + (base) + (o0)), hi_ = *(const LAS u32x4*)(lds + (base) + (o1)); \
        dst = (v8i){(int)lo_.x, (int)lo_.y, (int)lo_.z, (int)lo_.w, (int)hi_.x, (int)hi_.y, (int)hi_.z, (int)hi_.w}; } while (0)
#define PG8_LDA(dst, b, h) do { if constexpr (FP8) { _Pragma("unroll") for (int m = 0; m < 4; ++m) PG8_LDQ(dst##q[m], PG8_SA(b, h) + m * 2048, aoq0, aoq1); } \
        else { _Pragma("unroll") for (int m = 0; m < 4; ++m) _Pragma("unroll") for (int k = 0; k < 2; ++k) dst[m][k] = *(const LAS bf16x8*)(lds + PG8_SA(b, h) + aoff + m * 2048 + k * 1024); } } while (0)
#define PG8_LDB(dst, b, h) do { if constexpr (FP8) { _Pragma("unroll") for (int n = 0; n < 2; ++n) PG8_LDQ(dst##q[n], PG8_SB(b, h) + n * 2048, boq0, boq1); } \
        else { _Pragma("unroll") for (int n = 0; n < 2; ++n) _Pragma("unroll") for (int k = 0; k < 2; ++k) dst[n][k] = *(const LAS bf16x8*)(lds + PG8_SB(b, h) + boff + n * 2048 + k * 1024); } } while (0)
#define PG8_MMA(ai, bj, At, Bt) do { __builtin_amdgcn_s_setprio(1); if constexpr (FP8) { _Pragma("unroll") for (int m = 0; m < 4; ++m) _Pragma("unroll") for (int n = 0; n < 2; ++n) \
            asm volatile("v_mfma_scale_f32_16x16x128_f8f6f4 %0, %1, %2, %0, %3, %3 op_sel_hi:[0,0,0]" : "+v"(acc[ai][bj][m][n]) : "v"(Bt##q[n]), "v"(At##q[m]), "v"(one_scale)); } \
        else { _Pragma("unroll") for (int m = 0; m < 4; ++m) _Pragma("unroll") for (int n = 0; n < 2; ++n) _Pragma("unroll") for (int k = 0; k < 2; ++k) \
            acc[ai][bj][m][n] = __builtin_amdgcn_mfma_f32_16x16x32_bf16(Bt[n][k], At[m][k], acc[ai][bj][m][n], 0, 0, 0); } __builtin_amdgcn_s_setprio(0); } while (0)
#define PG8_WAIT_V(n) asm volatile("s_waitcnt vmcnt(" #n ")" ::: "memory")
#define PG8_WAIT_L(n) asm volatile("s_waitcnt lgkmcnt(" #n ")" ::: "memory")
#define PG8_BAR __builtin_amdgcn_s_barrier()
#define PG8_SCHED __builtin_amdgcn_sched_barrier(0)
    const int one_scale = 0x7f7f7f7f;
    Unit cur, nxt; int ui = 0;
    if (!S.next(0, cur)) return;
    f32x4 acc[2][2][4][2];
#pragma unroll
    for (int a = 0; a < 2; ++a)
#pragma unroll
        for (int b = 0; b < 2; ++b)
#pragma unroll
            for (int m = 0; m < 4; ++m)
#pragma unroll
                for (int n = 0; n < 2; ++n) acc[a][b][m][n] = (f32x4){0.f, 0.f, 0.f, 0.f};
    bf16x8 At[4][2], B0[2][2], B1[2][2]; v8i Atq[4], B0q[2], B1q[2];
    unsigned voA[2][2], voN[2][2];
    const char* cA; const char* cB;
#define PG8_UNIT_PTRS(u, pa, pb, vo) do { \
        pb = (const char*)g.Bt + ((size_t)(u).e * g.bstride) * 2 + (size_t)(u).pn * tstep; \
        if constexpr (GATHER) { pa = (const char*)g.A; \
            _Pragma("unroll") for (int h = 0; h < 2; ++h) _Pragma("unroll") for (int i = 0; i < 2; ++i) { const int r = h * HALF + RA[i]; int tok = 0; if (r < (u).cnt) tok = g.rowtab[(u).tab + r]; \
                vo[h][i] = (unsigned)tok * (unsigned)(K * 2) + (unsigned)(CA[i] * 2); } \
        } else { pa = (const char*)g.A + (size_t)(u).pm * tstep; \
            _Pragma("unroll") for (int h = 0; h < 2; ++h) _Pragma("unroll") for (int i = 0; i < 2; ++i) vo[h][i] = voffA[i] + (unsigned)(h * hstep); } } while (0)
    PG8_UNIT_PTRS(cur, cA, cB, voA);
    PG8_STAGE(PG8_SB(0, 0), cB, voffB); PG8_STAGE(PG8_SB(0, 1), cB + hstep, voffB); PG8_STAGE(PG8_SA(0, 0), cA, voA[0]); PG8_STAGE(PG8_SA(0, 1), cA, voA[1]);
    if (wr == 1) PG8_BAR;
    PG8_WAIT_V(2); PG8_BAR;
    if constexpr (BAL_DMA) { PG8_STAGE(PG8_SB(1, 0), cB + kstep, voffB); PG8_STAGE(PG8_SB(1, 1), cB + hstep + kstep, voffB); PG8_WAIT_V(4); PG8_BAR; }
    else { PG8_STAGE(PG8_SB(1, 0), cB + kstep, voffB); PG8_STAGE(PG8_SA(1, 0), cA + kstep, voA[0]); PG8_STAGE(PG8_SB(1, 1), cB + hstep + kstep, voffB); PG8_WAIT_V(6); PG8_BAR; }
    for (;;) {
        const bool has_next = S.next(ui + 1, nxt);
        const char* nA = cA; const char* nB = cB;
#pragma unroll
        for (int h = 0; h < 2; ++h)
#pragma unroll
            for (int i = 0; i < 2; ++i) voN[h][i] = voA[h][i];
        if (has_next) PG8_UNIT_PTRS(nxt, nA, nB, voN);
        for (int t = 0; t < nt; t += 2) {
            const bool last = (t == nt - 2);
            const char* a1 = cA + (size_t)(t + 1) * kstep;
            const char* a2 = last ? nA : cA + (size_t)(t + 2) * kstep; const char* b2 = last ? nB : cB + (size_t)(t + 2) * kstep;
            const char* a3 = a2 + kstep; const char* b3 = b2 + kstep;
            unsigned vo2[2][2];
#pragma unroll
            for (int h = 0; h < 2; ++h)
#pragma unroll
                for (int i = 0; i < 2; ++i) vo2[h][i] = last ? voN[h][i] : voA[h][i];
            if constexpr (BAL_DMA) {
            PG8_LDB(B0, 0, 0); PG8_LDB(B1, 0, 1); PG8_SCHED; PG8_LDA(At, 0, 0); PG8_STAGE(PG8_SA(1, 0), a1, voA[0]); PG8_STAGE(PG8_SA(1, 1), a1, voA[1]);
            PG8_WAIT_V(8); PG8_WAIT_L(0); PG8_BAR; PG8_MMA(0, 0, At, B0); PG8_MMA(0, 1, At, B1); PG8_BAR; PG8_SCHED;
            PG8_LDA(At, 0, 1); PG8_STAGE(PG8_SB(0, 0), b2, voffB); PG8_STAGE(PG8_SB(0, 1), b2 + hstep, voffB);
            PG8_WAIT_V(6); PG8_WAIT_L(0); PG8_BAR; PG8_MMA(1, 0, At, B0); PG8_MMA(1, 1, At, B1); PG8_BAR; PG8_SCHED;
            PG8_LDB(B0, 1, 0); PG8_LDB(B1, 1, 1); PG8_SCHED; PG8_LDA(At, 1, 0); PG8_STAGE(PG8_SA(0, 0), a2, vo2[0]); PG8_STAGE(PG8_SA(0, 1), a2, vo2[1]);
            PG8_WAIT_V(8); PG8_WAIT_L(0); PG8_BAR; PG8_MMA(0, 0, At, B0); PG8_MMA(0, 1, At, B1); PG8_BAR; PG8_SCHED;
            PG8_LDA(At, 1, 1); PG8_STAGE(PG8_SB(1, 0), b3, voffB); PG8_STAGE(PG8_SB(1, 1), b3 + hstep, voffB);
            PG8_WAIT_V(6); PG8_WAIT_L(0); PG8_BAR; PG8_MMA(1, 0, At, B0); PG8_MMA(1, 1, At, B1); PG8_BAR; PG8_SCHED;
            } else if constexpr (DMA_IN_MMA) {
            PG8_LDB(B0, 0, 0); PG8_LDB(B1, 0, 1); PG8_SCHED; PG8_LDA(At, 0, 0);
            PG8_WAIT_V(6); PG8_WAIT_L(0); PG8_BAR; PG8_MMA(0, 0, At, B0); PG8_SCHED; PG8_STAGE(PG8_SA(1, 1), a1, voA[1]); PG8_SCHED; PG8_MMA(0, 1, At, B1); PG8_BAR; PG8_SCHED;
            PG8_LDA(At, 0, 1);
            PG8_WAIT_V(2); PG8_WAIT_L(0); PG8_BAR; PG8_MMA(1, 0, At, B0); PG8_SCHED; PG8_STAGE(PG8_SB(0, 0), b2, voffB); PG8_STAGE(PG8_SB(0, 1), b2 + hstep, voffB); PG8_SCHED;
            PG8_MMA(1, 1, At, B1); PG8_SCHED; PG8_STAGE(PG8_SA(0, 0), a2, vo2[0]); PG8_BAR; PG8_SCHED;
            PG8_LDB(B0, 1, 0); PG8_LDB(B1, 1, 1); PG8_SCHED; PG8_LDA(At, 1, 0);
            PG8_WAIT_V(6); PG8_WAIT_L(0); PG8_BAR; PG8_MMA(0, 0, At, B0); PG8_SCHED; PG8_STAGE(PG8_SA(0, 1), a2, vo2[1]); PG8_SCHED; PG8_MMA(0, 1, At, B1); PG8_BAR; PG8_SCHED;
            PG8_LDA(At, 1, 1);
            PG8_WAIT_V(2); PG8_WAIT_L(0); PG8_BAR; PG8_MMA(1, 0, At, B0); PG8_SCHED; PG8_STAGE(PG8_SB(1, 0), b3, voffB); PG8_STAGE(PG8_SB(1, 1), b3 + hstep, voffB); PG8_SCHED;
            PG8_MMA(1, 1, At, B1); PG8_SCHED; PG8_STAGE(PG8_SA(1, 0), a3, vo2[0]); PG8_BAR; PG8_SCHED;
            } else {
            PG8_LDB(B0, 0, 0); PG8_LDB(B1, 0, 1); PG8_SCHED; PG8_LDA(At, 0, 0); PG8_STAGE(PG8_SA(1, 1), a1, voA[1]);
            PG8_WAIT_V(8); PG8_WAIT_L(0); PG8_BAR; PG8_MMA(0, 0, At, B0); PG8_MMA(0, 1, At, B1); PG8_BAR; PG8_SCHED;
            PG8_LDA(At, 0, 1); PG8_STAGE(PG8_SB(0, 0), b2, voffB); PG8_STAGE(PG8_SB(0, 1), b2 + hstep, voffB); PG8_STAGE(PG8_SA(0, 0), a2, vo2[0]);
            PG8_WAIT_V(8); PG8_WAIT_L(0); PG8_BAR; PG8_MMA(1, 0, At, B0); PG8_MMA(1, 1, At, B1); PG8_BAR; PG8_SCHED;
            PG8_LDB(B0, 1, 0); PG8_LDB(B1, 1, 1); PG8_SCHED; PG8_LDA(At, 1, 0); PG8_STAGE(PG8_SA(0, 1), a2, vo2[1]);
            PG8_WAIT_V(8); PG8_WAIT_L(0); PG8_BAR; PG8_MMA(0, 0, At, B0); PG8_MMA(0, 1, At, B1); PG8_BAR; PG8_SCHED;
            PG8_LDA(At, 1, 1); PG8_STAGE(PG8_SB(1, 0), b3, voffB); PG8_STAGE(PG8_SB(1, 1), b3 + hstep, voffB); PG8_STAGE(PG8_SA(1, 0), a3, vo2[0]);
            PG8_WAIT_V(8); PG8_WAIT_L(0); PG8_BAR; PG8_MMA(1, 0, At, B0); PG8_MMA(1, 1, At, B1); PG8_BAR; PG8_SCHED;
            }
        }
        if constexpr (FP8) asm volatile("s_nop 15\n\ts_nop 15" ::: "memory");
        if constexpr (ALIGN_EPI) { if (wr == 0) PG8_BAR; }
        E(acc, cur, wr, wc, fr, fq);
        if (!has_next) break;
#pragma unroll
        for (int a = 0; a < 2; ++a)
#pragma unroll
            for (int b = 0; b < 2; ++b)
#pragma unroll
                for (int m = 0; m < 4; ++m)
#pragma unroll
                    for (int n = 0; n < 2; ++n) acc[a][b][m][n] = (f32x4){0.f, 0.f, 0.f, 0.f};
        cur = nxt; cA = nA; cB = nB; ++ui;
#pragma unroll
        for (int h = 0; h < 2; ++h)
#pragma unroll
            for (int i = 0; i < 2; ++i) voA[h][i] = voN[h][i];
        if constexpr (ALIGN_EPI) { if (wr == 1) PG8_BAR; }
    }
    PG8_WAIT_V(0);
    if constexpr (!ALIGN_EPI) { if (wr == 0) PG8_BAR; }
    PG8_BAR;
#undef PG8_UNIT_PTRS
#undef PG8_SA
#undef PG8_SB
#undef PG8_STAGE
#undef PG8_LDA
#undef PG8_LDQ
#undef PG8_LDB
#undef PG8_MMA
#undef PG8_WAIT_V
#undef PG8_WAIT_L
#undef PG8_BAR
#undef PG8_SCHED
}
}

#define XB_TMO      128
#define XB_XCNT(j)  (256  + 64 * (j))
#define XB_XSUB(j)  (1280 + 64 * (j))
#define XB_XGEN(j)  (2304 + 64 * (j))
#define XB_TOP      3328
#define XB_TOPGEN   3392
#define XCD_BAR_WORDS 3456
#define XB_SPIN_CAP (1u << 18)

__device__ __forceinline__ unsigned xb_ld(unsigned* p)              { return __hip_atomic_load(p, __ATOMIC_RELAXED, __HIP_MEMORY_SCOPE_AGENT); }
__device__ __forceinline__ unsigned xb_add(unsigned* p, unsigned v) { return __hip_atomic_fetch_add(p, v, __ATOMIC_RELAXED, __HIP_MEMORY_SCOPE_AGENT); }
__device__ __forceinline__ unsigned xb_xcc_id() { return (unsigned)__builtin_amdgcn_s_getreg((3 << 11) | 20) & 0xFu; }
#define XB_SPIN(cond, bar) do { unsigned _sp = 0; while (cond) { __builtin_amdgcn_s_sleep(1); \
    if ((++_sp & 255u) == 0u) { if (xb_ld(&(bar)[XB_TMO])) break; if (_sp > XB_SPIN_CAP) { atomicAdd(&(bar)[XB_TMO], 1u); break; } } } } while (0)

struct XcdBarrier {
    unsigned* bar; unsigned x;
    volatile LAS unsigned* st;
};

__device__ __forceinline__ XcdBarrier xcd_barrier_post(unsigned* bar, volatile LAS unsigned* st) {
    XcdBarrier b; b.bar = bar; b.x = xb_xcc_id(); b.st = st;
    if (threadIdx.x == 0) (void)xb_add(&bar[XB_XCNT(b.x)], 1u);
    return b;
}
__device__ __forceinline__ void xcd_barrier_complete(unsigned* bar, unsigned x, unsigned& nloc, unsigned& nx) {
    const unsigned G = gridDim.x * gridDim.y * gridDim.z;
    unsigned sum, cnt, mine, sp = 0u;
    for (;;) {
        sum = 0u; cnt = 0u; mine = 0u;
#pragma unroll
        for (unsigned j = 0; j < 16; ++j) { const unsigned c = xb_ld(&bar[XB_XCNT(j)]); sum += c; cnt += (c > 0u) ? 1u : 0u; mine = (j == x) ? c : mine; }
        if (sum == G) break;
        __builtin_amdgcn_s_sleep(1);
        if ((++sp & 255u) == 0u) { if (xb_ld(&bar[XB_TMO])) break; if (sp > XB_SPIN_CAP) { atomicAdd(&bar[XB_TMO], 1u); break; } }
    }
    nloc = mine > 0u ? mine : 1u; nx = cnt > 0u ? cnt : 1u;
}

__device__ __forceinline__ void xcd_barrier(const XcdBarrier& b) {
    asm volatile("s_waitcnt vmcnt(0)" ::: "memory");
    __syncthreads();
    if (threadIdx.x == 0) {
        unsigned* bar = b.bar;
        __builtin_amdgcn_s_waitcnt(0);
        unsigned nloc = b.st[0], nx = b.st[1];
        if (nloc == 0u) { xcd_barrier_complete(bar, b.x, nloc, nx); b.st[0] = nloc; b.st[1] = nx; }
        const unsigned old = xb_add(&bar[XB_XSUB(b.x)], 1u);
        const unsigned gen = old / nloc;
        if (old + 1u == (gen + 1u) * nloc) {
            __builtin_amdgcn_fence(__ATOMIC_RELEASE, "agent");
            asm volatile("s_waitcnt vmcnt(0)" ::: "memory");
            const unsigned og = xb_add(&bar[XB_TOP], 1u);
            const unsigned tg = og / nx;
            if (og + 1u == (tg + 1u) * nx) xb_add(&bar[XB_TOPGEN], 1u);
            else XB_SPIN(xb_ld(&bar[XB_TOPGEN]) == tg, bar);
            __builtin_amdgcn_fence(__ATOMIC_ACQUIRE, "agent");
            xb_add(&bar[XB_XGEN(b.x)], 1u);
            asm volatile("s_waitcnt vmcnt(0)" ::: "memory");
        } else {
            XB_SPIN(xb_ld(&bar[XB_XGEN(b.x)]) == gen, bar);
            __builtin_amdgcn_fence(__ATOMIC_ACQUIRE, "agent");
            asm volatile("s_waitcnt vmcnt(0)" ::: "memory");
        }
    }
    __syncthreads();
}

struct Args {
    const float* x; const float* p; const float* w_in; const float* norm_sb; const float* norm_moba; const float* w_out; const float* ln1_g; const float* ln1_b;
    const float* w_router; const float* b_router; const float* w_up; const float* b_up; const float* w_down; const float* b_down; const float* ln2_g; const float* ln2_b;
    const float* w_ple; const float* w_ple_gate; const float* b_ple_gate;
    float* out; unsigned char* ws; int ph_lo, ph_hi;
};

__device__ __forceinline__ float wave_sum(float v) {
#pragma unroll
    for (int o = 1; o < 64; o <<= 1) v += __shfl_xor(v, o);
    return v;
}
template <int CTRL> __device__ __forceinline__ float dppmov(float v) { return __builtin_bit_cast(float, __builtin_amdgcn_update_dpp(0, __builtin_bit_cast(int, v), CTRL, 0xF, 0xF, true)); }
__device__ __forceinline__ float reduce16(float v) { v += dppmov<0xB1>(v); v += dppmov<0x4E>(v); v += dppmov<0x141>(v); v += dppmov<0x140>(v); return v; }

struct DenseSched {
    int nM, nN, nwg, G, c;
    __device__ void init(int Mrows, int N, int G_, int c_) { nM = Mrows / 256; nN = N / 256; nwg = nM * nN; G = G_; c = c_; }
    __device__ __forceinline__ bool next(int i, pg8::Unit& u) const {
        const long L = (long)i * G + c; if (L >= nwg) return false;
        int wgid = (int)L; { const int q = nwg / 8, r = nwg % 8, xcd = wgid % 8, off = wgid / 8; wgid = (xcd < r ? xcd * (q + 1) : r * (q + 1) + (xcd - r) * q) + off; }
        const int nig = 8 * nN, gid = wgid / nig, fm = gid * 8, gsz = (nM - fm) < 8 ? (nM - fm) : 8;
        u.pm = fm + ((wgid % nig) % gsz); u.pn = (wgid % nig) / gsz; u.e = 0; u.tab = 0; u.cnt = 256; return true;
    }
};
struct MoeSched {
    const LAS int* tab; int NPN, G, c;
    __device__ __forceinline__ bool next(int i, pg8::Unit& u) const {
        int tt, pn;
        if (G == 256 && (NPN == 8 || NPN == 16)) {
            const int x = c & 7, s = c >> 3;
            if (NPN == 8) { tt = 32 * i + 8 * (x >> 1) + (s >> 2); pn = 4 * (x & 1) + (s & 3); }
            else { tt = 16 * i + 8 * (x >> 2) + (s >> 2); pn = 4 * (x & 3) + (s & 3); }
            if (tt >= tab[32]) return false;
        } else {
            const int total = tab[32] * NPN; const int L = i * G + c; if (L >= total) return false;
            tt = L / NPN; pn = L - tt * NPN;
        }
        int e = 0;
        for (int k = 1; k < 32; ++k) e += (tab[k] <= tt) ? 1 : 0;
        e = __builtin_amdgcn_readfirstlane(e);
        const int mt = tt - tab[e]; const int cnt = tab[33 + e] - mt * 256;
        u.pm = __builtin_amdgcn_readfirstlane(tt); u.pn = __builtin_amdgcn_readfirstlane(pn); u.e = e; u.tab = __builtin_amdgcn_readfirstlane(e * ECAP + mt * 256); u.cnt = __builtin_amdgcn_readfirstlane(cnt < 256 ? cnt : 256); return true;
    }
};
__device__ __forceinline__ void moe_table(LAS int* tab, const unsigned* ecnt_words) {
    if (threadIdx.x < 32) tab[33 + threadIdx.x] = (int)ecnt_words[32 * threadIdx.x];
    __syncthreads();
    if (threadIdx.x == 0) { int s = 0; for (int e = 0; e < 32; ++e) { tab[e] = s; s += (tab[33 + e] + 255) >> 8; } tab[32] = s; }
    __syncthreads();
}

using pg8::Unit; using pg8::cvt_pk_bf16;
struct EpiQKV {
    static constexpr bool PERM = true;
    bf16* O; int ldc; bool qscale; float* kmean;
    __device__ __forceinline__ void operator()(const f32x4 (&acc)[2][2][4][2], const Unit& u, int wr, int wc, int fr, int fq) const {
        asm volatile("" : "+v"(fr), "+v"(fq));
        const int row0 = u.pm * 256 + wr * 64 + fr, col0 = u.pn * 256 + wc * 32 + 8 * fq;
        const float sc = (qscale && (u.pn < 4 || (u.pn >= 12 && u.pn < 16))) ? QSCALE : 1.f;
#pragma unroll
        for (int ai = 0; ai < 2; ++ai)
#pragma unroll
            for (int m = 0; m < 4; ++m) { bf16* rowp = O + (size_t)(row0 + ai * 128 + m * 16) * ldc + col0;
#pragma unroll
                for (int bj = 0; bj < 2; ++bj) { const f32x4 v0 = acc[ai][bj][m][0] * sc, v1 = acc[ai][bj][m][1] * sc;
                    u32x4 w; w.x = cvt_pk_bf16(v0[0], v0[1]); w.y = cvt_pk_bf16(v0[2], v0[3]); w.z = cvt_pk_bf16(v1[0], v1[1]); w.w = cvt_pk_bf16(v1[2], v1[3]);
                    *(u32x4*)(rowp + bj * 128) = w; } }
        if (qscale && u.pn >= 16 && u.pn < 20) {
#pragma unroll
            for (int bj = 0; bj < 2; ++bj)
#pragma unroll
                for (int n = 0; n < 2; ++n) { f32x4 cs = {0.f, 0.f, 0.f, 0.f};
#pragma unroll
                    for (int ai = 0; ai < 2; ++ai)
#pragma unroll
                        for (int m = 0; m < 4; ++m) cs += acc[ai][bj][m][n];
#pragma unroll
                    for (int j = 0; j < 4; ++j) { const float t = reduce16(cs[j]) * (1.f / 256.f);
                        if (fr == 0) { const int kc = (u.pn - 16) * 256 + bj * 128 + wc * 32 + 8 * fq + 4 * n + j;
                            const int bb = u.pm >> 5, blk = u.pm & 31;
                            atomicAdd(kmean + ((size_t)((bb * 8 + (kc >> 7)) * 32 + blk)) * 128 + (kc & 127), t); } } }
        }
    }
};
struct EpiH {
    static constexpr bool PERM = true;
    const bf16* XB; bf16* Hh;
    __device__ __forceinline__ void operator()(const f32x4 (&acc)[2][2][4][2], const Unit& u, int wr, int wc, int fr, int fq) const {
        asm volatile("" : "+v"(fr), "+v"(fq));
        const int row0 = u.pm * 256 + wr * 64 + fr, col0 = u.pn * 256 + wc * 32 + 8 * fq;
        u32x4 xw[2][4][2];
#pragma unroll
        for (int ai = 0; ai < 2; ++ai)
#pragma unroll
            for (int m = 0; m < 4; ++m)
#pragma unroll
                for (int bj = 0; bj < 2; ++bj) xw[ai][m][bj] = *(const u32x4*)(XB + (size_t)(row0 + ai * 128 + m * 16) * D + col0 + bj * 128);
        asm volatile("" : "+v"(xw[0][0][0]), "+v"(xw[0][0][1]), "+v"(xw[0][1][0]), "+v"(xw[0][1][1]), "+v"(xw[0][2][0]), "+v"(xw[0][2][1]), "+v"(xw[0][3][0]), "+v"(xw[0][3][1]),
                          "+v"(xw[1][0][0]), "+v"(xw[1][0][1]), "+v"(xw[1][1][0]), "+v"(xw[1][1][1]), "+v"(xw[1][2][0]), "+v"(xw[1][2][1]), "+v"(xw[1][3][0]), "+v"(xw[1][3][1]));
#pragma unroll
        for (int ai = 0; ai < 2; ++ai)
#pragma unroll
            for (int m = 0; m < 4; ++m) { const size_t ro = (size_t)(row0 + ai * 128 + m * 16) * D + col0;
#pragma unroll
                for (int bj = 0; bj < 2; ++bj) { const u32x4 x4 = xw[ai][m][bj];
                    const f32x4 a0 = acc[ai][bj][m][0], a1 = acc[ai][bj][m][1]; u32x4 w;
                    w.x = cvt_pk_bf16(fmaf(bf_lo(x4.x), DN_ALPHA, a0[0]), fmaf(bf_hi(x4.x), DN_ALPHA, a0[1])); w.y = cvt_pk_bf16(fmaf(bf_lo(x4.y), DN_ALPHA, a0[2]), fmaf(bf_hi(x4.y), DN_ALPHA, a0[3]));
                    w.z = cvt_pk_bf16(fmaf(bf_lo(x4.z), DN_ALPHA, a1[0]), fmaf(bf_hi(x4.z), DN_ALPHA, a1[1])); w.w = cvt_pk_bf16(fmaf(bf_lo(x4.w), DN_ALPHA, a1[2]), fmaf(bf_hi(x4.w), DN_ALPHA, a1[3]));
                    *(u32x4*)(Hh + ro + bj * 128) = w; } }
    }
};
struct EpiUp {
    static constexpr bool PERM = true;
    unsigned char* ACT; const float* biasp;
    __device__ __forceinline__ void operator()(const f32x4 (&acc)[2][2][4][2], const Unit& u, int wr, int wc, int fr, int fq) const {
        asm volatile("" : "+v"(fr), "+v"(fq));
        const int row0 = u.pm * 256 + wr * 64 + fr, cw = wc * 32 + 8 * fq;
        const float* bp = biasp + (size_t)u.e * 4096 + u.pn * 256 + cw;
        f32x4 bg[2], bl[2];
#pragma unroll
        for (int n = 0; n < 2; ++n) { bg[n] = *(const f32x4*)(bp + 4 * n); bl[n] = *(const f32x4*)(bp + 128 + 4 * n); }
#pragma unroll
        for (int ai = 0; ai < 2; ++ai)
#pragma unroll
            for (int m = 0; m < 4; ++m) {
                float a[8];
#pragma unroll
                for (int n = 0; n < 2; ++n)
#pragma unroll
                    for (int j = 0; j < 4; ++j) {
                        const float g8 = fminf(fmaf(acc[ai][0][m][n][j], 8.f * UP_DESCALE, bg[n][j]), 8.f * SWIGLU_LIMIT);
                        const float l1 = __builtin_amdgcn_fmed3f(fmaf(acc[ai][1][m][n][j], UP_DESCALE, bl[n][j]), 1.f - SWIGLU_LIMIT, 1.f + SWIGLU_LIMIT);
                        const float sg = __builtin_amdgcn_rcpf(1.f + __builtin_amdgcn_exp2f(g8 * (-SWIGLU_ALPHA * LOG2E / 8.f)));
                        a[n * 4 + j] = g8 * sg * l1;
                    }
                u32x2 w; w.x = pack_fp8x4_nc(a[0], a[1], a[2], a[3]); w.y = pack_fp8x4_nc(a[4], a[5], a[6], a[7]);
                *(u32x2*)(ACT + (size_t)(row0 + ai * 128 + m * 16) * DFF + u.pn * 128 + cw) = w;
            }
    }
};
struct EpiDown {
    static constexpr bool PERM = true;
    unsigned char* Y; const float* bias; const float* rowg;
    __device__ __forceinline__ void operator()(const f32x4 (&acc)[2][2][4][2], const Unit& u, int wr, int wc, int fr, int fq) const {
        asm volatile("" : "+v"(fr), "+v"(fq));
        const int rl0 = wr * 64 + fr, col0 = u.pn * 256 + wc * 32 + 8 * fq;
        const float* bp = bias + (size_t)u.e * D + col0;
        f32x4 bv[2][2];
#pragma unroll
        for (int bj = 0; bj < 2; ++bj)
#pragma unroll
            for (int n = 0; n < 2; ++n) bv[bj][n] = *(const f32x4*)(bp + bj * 128 + 4 * n);
        float gtv[2][4];
#pragma unroll
        for (int ai = 0; ai < 2; ++ai)
#pragma unroll
            for (int m = 0; m < 4; ++m) { const int rl = rl0 + ai * 128 + m * 16; gtv[ai][m] = (rl < u.cnt) ? rowg[u.tab + rl] : 0.f; }
        asm volatile("" : "+v"(gtv[0][0]), "+v"(gtv[0][1]), "+v"(gtv[0][2]), "+v"(gtv[0][3]), "+v"(gtv[1][0]), "+v"(gtv[1][1]), "+v"(gtv[1][2]), "+v"(gtv[1][3]));
#pragma unroll
        for (int ai = 0; ai < 2; ++ai)
#pragma unroll
            for (int m = 0; m < 4; ++m) { const int rl = rl0 + ai * 128 + m * 16; const float gt = gtv[ai][m] * YSCALE;
                unsigned char* rowp = Y + (size_t)(u.pm * 256 + rl) * D + col0;
#pragma unroll
                for (int bj = 0; bj < 2; ++bj) { const f32x4 v0 = (acc[ai][bj][m][0] * DN_DESCALE + bv[bj][0]) * gt, v1 = (acc[ai][bj][m][1] * DN_DESCALE + bv[bj][1]) * gt;
                    u32x2 w; w.x = pack_fp8x4(v0[0], v0[1], v0[2], v0[3]); w.y = pack_fp8x4(v1[0], v1[1], v1[2], v1[3]);
                    *(u32x2*)(rowp + bj * 128) = w; } }
    }
};
struct EpiOut {
    static constexpr bool PERM = true;
    float* OUT; const float* bias; const bf16* PLEB; const bf16* X2B;
    __device__ __forceinline__ void operator()(const f32x4 (&acc)[2][2][4][2], const Unit& u, int wr, int wc, int fr, int fq) const {
        asm volatile("" : "+v"(fr), "+v"(fq));
        const int row0 = u.pm * 256 + wr * 64 + fr, col0 = u.pn * 256 + wc * 32 + 8 * fq;
        f32x4 bv[2][2];
#pragma unroll
        for (int bj = 0; bj < 2; ++bj)
#pragma unroll
            for (int n = 0; n < 2; ++n) bv[bj][n] = *(const f32x4*)(bias + col0 + bj * 128 + 4 * n);
#pragma unroll
        for (int ai = 0; ai < 2; ++ai) {
            u32x4 xw[4][2], pw[4][2];
#pragma unroll
            for (int m = 0; m < 4; ++m)
#pragma unroll
                for (int bj = 0; bj < 2; ++bj) { const size_t o = (size_t)(row0 + ai * 128 + m * 16) * D + col0 + bj * 128; xw[m][bj] = *(const u32x4*)(X2B + o); pw[m][bj] = *(const u32x4*)(PLEB + o); }
            asm volatile("" : "+v"(xw[0][0]), "+v"(xw[0][1]), "+v"(xw[1][0]), "+v"(xw[1][1]), "+v"(xw[2][0]), "+v"(xw[2][1]), "+v"(xw[3][0]), "+v"(xw[3][1]),
                              "+v"(pw[0][0]), "+v"(pw[0][1]), "+v"(pw[1][0]), "+v"(pw[1][1]), "+v"(pw[2][0]), "+v"(pw[2][1]), "+v"(pw[3][0]), "+v"(pw[3][1]));
#pragma unroll
            for (int m = 0; m < 4; ++m) { const size_t ro = (size_t)(row0 + ai * 128 + m * 16) * D + col0;
#pragma unroll
                for (int bj = 0; bj < 2; ++bj) { const size_t o = ro + bj * 128; const u32x4 x4 = xw[m][bj], p4 = pw[m][bj];
                    const float xv[8] = {bf_lo(x4.x), bf_hi(x4.x), bf_lo(x4.y), bf_hi(x4.y), bf_lo(x4.z), bf_hi(x4.z), bf_lo(x4.w), bf_hi(x4.w)};
                    const float pl[8] = {bf_lo(p4.x), bf_hi(p4.x), bf_lo(p4.y), bf_hi(p4.y), bf_lo(p4.z), bf_hi(p4.z), bf_lo(p4.w), bf_hi(p4.w)};
#pragma unroll
                    for (int n = 0; n < 2; ++n) { const f32x4 g = acc[ai][bj][m][n] * UP_DESCALE + bv[bj][n]; f32x4 r;
#pragma unroll
                        for (int j = 0; j < 4; ++j) r[j] = xv[4 * n + j] + __builtin_amdgcn_rcpf(1.f + __builtin_amdgcn_exp2f(-LOG2E * g[j])) * pl[4 * n + j];
                        *(f32x4*)(OUT + o + 4 * n) = r; } } }
        }
    }
};

struct P0Job { const float* W; void* WT; int K, N, mode; };
__device__ __forceinline__ void cv_load(const P0Job& j, int blk, int lane, f32x4 (&v)[16]) {
    const int nb64 = j.N >> 6, kb = blk / nb64, nbp = blk - kb * nb64;
    const float* p = j.W + (size_t)(64 * kb + 16 * (lane >> 4)) * j.N + 64 * nbp + 4 * (lane & 15);
#pragma unroll
    for (int i = 0; i < 16; ++i) v[i] = __builtin_nontemporal_load((const GAS f32x4*)(p + (size_t)i * j.N));
}
__device__ __forceinline__ void cv_store(const P0Job& j, int blk, int lane, const f32x4 (&v)[16]) {
    const int nb64 = j.N >> 6, kb = blk / nb64, nbp = blk - kb * nb64, K = j.K;
    const int kk = 64 * kb + 16 * (lane >> 4), nc = 64 * nbp + 4 * (lane & 15);
#pragma unroll
    for (int jj = 0; jj < 4; ++jj) {
        int nn = nc + jj; if (j.mode & 1) { const int a2 = nn >> 1, bj = nn & 1; nn = 256 * (a2 >> 7) + 128 * bj + (a2 & 127); }
        if (j.mode < 2) {
            u32x4 o0, o1;
            o0.x = pk2(v[0][jj], v[1][jj]); o0.y = pk2(v[2][jj], v[3][jj]); o0.z = pk2(v[4][jj], v[5][jj]); o0.w = pk2(v[6][jj], v[7][jj]);
            o1.x = pk2(v[8][jj], v[9][jj]); o1.y = pk2(v[10][jj], v[11][jj]); o1.z = pk2(v[12][jj], v[13][jj]); o1.w = pk2(v[14][jj], v[15][jj]);
            GAS u32x4* d = (GAS u32x4*)((bf16*)j.WT + (size_t)nn * K + kk);
            __builtin_nontemporal_store(o0, d); __builtin_nontemporal_store(o1, d + 1);
        } else {
            u32x4 o;
            o.x = pack_fp8x4(v[0][jj] * WSCALE, v[1][jj] * WSCALE, v[2][jj] * WSCALE, v[3][jj] * WSCALE);
            o.y = pack_fp8x4(v[4][jj] * WSCALE, v[5][jj] * WSCALE, v[6][jj] * WSCALE, v[7][jj] * WSCALE);
            o.z = pack_fp8x4(v[8][jj] * WSCALE, v[9][jj] * WSCALE, v[10][jj] * WSCALE, v[11][jj] * WSCALE);
            o.w = pack_fp8x4(v[12][jj] * WSCALE, v[13][jj] * WSCALE, v[14][jj] * WSCALE, v[15][jj] * WSCALE);
            __builtin_nontemporal_store(o, (GAS u32x4*)((unsigned char*)j.WT + (size_t)nn * K + kk));
        }
    }
}
constexpr int P0_I_IN = (D / 64) * (NQKV / 32), P0_I_OUT = (D / 64) * (D / 32), P0_I_G = P0_I_OUT, P0_I_PLE = (PLE / 64) * (D / 32), P0_I_UP1 = (D / 64) * (2 * DFF / 32), P0_I_DN1 = (DFF / 64) * (D / 32);
constexpr int P0_NA = P0_I_IN + P0_I_OUT + P0_I_PLE, P0_NB = P0_I_G + NE * P0_I_UP1 + NE * P0_I_DN1;
constexpr int CV_LISTS = 2048, CV_BLOCKS = P0_NB / 2;
constexpr int CV_UP_END = (P0_I_G + NE * P0_I_UP1) / 2;
static_assert(P0_NA % 2 == 0 && P0_NB % 2 == 0, "item pairs");
__device__ __forceinline__ int cv_list_len(int l, int nblocks) { return l < nblocks ? (nblocks - l + CV_LISTS - 1) / CV_LISTS : 0; }
__device__ __forceinline__ void p0_locate_a(const Args& a, int it, P0Job& j, int& item) {
    unsigned char* ws = a.ws; int r = it;
    if (r < P0_I_IN) { j = P0Job{a.w_in, ws + WS_WINT, D, NQKV, 0}; item = r; return; } r -= P0_I_IN;
    if (r < P0_I_OUT) { j = P0Job{a.w_out, ws + WS_WOUTT, D, D, 0}; item = r; return; } r -= P0_I_OUT;
    j = P0Job{a.w_ple, ws + WS_WPLET, PLE, D, 0}; item = r;
}
__device__ __forceinline__ void p0_locate_b(const Args& a, int it, P0Job& j, int& item) {
    unsigned char* ws = a.ws; int r = it;
    if (r < P0_I_G) { j = P0Job{a.w_ple_gate, ws + WS_WGT, D, D, 2}; item = r; return; } r -= P0_I_G;
    if (r < NE * P0_I_UP1) { const int e = r / P0_I_UP1; item = r - e * P0_I_UP1; j = P0Job{a.w_up + (size_t)e * D * 2 * DFF, ws + WS_WUPT + (size_t)e * 2 * DFF * D, D, 2 * DFF, 3}; return; } r -= NE * P0_I_UP1;
    { const int e = r / P0_I_DN1; item = r - e * P0_I_DN1; j = P0Job{a.w_down + (size_t)e * DFF * D, ws + WS_WDNT + (size_t)e * D * DFF, DFF, D, 2}; }
}
__device__ __forceinline__ void cv_range(const Args& a, int l, int i0, int i1, int lane) {
    if (i0 >= i1) return;
    P0Job j0; int it0; f32x4 v0[16];
    { p0_locate_b(a, 2 * (l + CV_LISTS * i0), j0, it0); cv_load(j0, it0 >> 1, lane, v0); }
    for (int i = i0;;) {
        const int in = i + 1; const bool hn = in < i1;
        P0Job n0 = j0; int nit = it0; f32x4 w0[16];
        if (hn) { p0_locate_b(a, 2 * (l + CV_LISTS * in), n0, nit); cv_load(n0, nit >> 1, lane, w0); }
        cv_store(j0, it0 >> 1, lane, v0);
        if (!hn) break;
#pragma unroll
        for (int k = 0; k < 16; ++k) v0[k] = w0[k];
        j0 = n0; it0 = nit; i = in;
    }
}
__device__ __forceinline__ void p0_prologue(const Args& a, LAS unsigned char* lds, int gw, int NGW, int wave, int lane) {
    unsigned char* ws = a.ws;
    { int pr = gw; P0Job j0; int it0 = 0; f32x4 v0[16];
      if (pr < P0_NA / 2) { p0_locate_a(a, 2 * pr, j0, it0); cv_load(j0, it0 >> 1, lane, v0);
        for (;;) {
            const int pn = pr + NGW; const bool hn = pn < P0_NA / 2;
            P0Job n0 = j0; int nit = it0; f32x4 w0[16];
            if (hn) { p0_locate_a(a, 2 * pn, n0, nit); cv_load(n0, nit >> 1, lane, w0); }
            cv_store(j0, it0 >> 1, lane, v0);
            if (!hn) break;
#pragma unroll
            for (int k = 0; k < 16; ++k) v0[k] = w0[k];
            j0 = n0; it0 = nit; pr = pn;
        } } }
    { const GAS f32x4* src = (const GAS f32x4*)a.x; GAS u32x2* dst = (GAS u32x2*)(ws + WS_XB); const size_t n4 = (size_t)M * D / 4, stride = (size_t)NGW * 64;
      size_t i = (size_t)gw * 64 + lane; f32x4 v[8];
      if (i < n4) {
#pragma unroll
          for (int u = 0; u < 8; ++u) if (i + u * stride < n4) v[u] = __builtin_nontemporal_load(src + i + u * stride);
          for (;;) {
              const size_t in = i + 8 * stride; const bool hn = in < n4; f32x4 w[8];
              if (hn) {
#pragma unroll
                  for (int u = 0; u < 8; ++u) if (in + u * stride < n4) w[u] = __builtin_nontemporal_load(src + in + u * stride); }
#pragma unroll
              for (int u = 0; u < 8; ++u) if (i + u * stride < n4) { u32x2 o; o.x = pk2(v[u].x, v[u].y); o.y = pk2(v[u].z, v[u].w); dst[i + u * stride] = o; }
              if (!hn) break;
#pragma unroll
              for (int u = 0; u < 8; ++u) v[u] = w[u];
              i = in;
          } } }
    { const GAS f32x4* src = (const GAS f32x4*)a.p; GAS u32x2* dst = (GAS u32x2*)(ws + WS_PB); const size_t n4 = (size_t)M * PLE / 4, stride = (size_t)NGW * 64;
      for (size_t i = (size_t)gw * 64 + lane; i < n4; i += 8 * stride) { f32x4 v[8];
#pragma unroll
          for (int u = 0; u < 8; ++u) if (i + u * stride < n4) v[u] = __builtin_nontemporal_load(src + i + u * stride);
#pragma unroll
          for (int u = 0; u < 8; ++u) if (i + u * stride < n4) { u32x2 o; o.x = pk2(v[u].x, v[u].y); o.y = pk2(v[u].z, v[u].w); dst[i + u * stride] = o; } } }
    { float* km = (float*)(ws + WS_KMEAN); for (int i = gw * 64 + lane; i < 16 * 32 * 128; i += NGW * 64) km[i] = 0.f; }
    { float* bp = (float*)(ws + WS_BUPP);
      for (int i = gw * 64 + lane; i < NE * 2 * DFF; i += NGW * 64) { const int e = i >> 12, nn = i & 4095; const int a2 = nn >> 1, bj = nn & 1; bp[e * 4096 + 256 * (a2 >> 7) + 128 * bj + (a2 & 127)] = bj ? a.b_up[i] + 1.f : 8.f * a.b_up[i]; } }
}

__device__ __forceinline__ void p2_kmean(const Args& a, LAS unsigned char* lds, int G) {
    const bf16* qkv = (const bf16*)(a.ws + WS_QKV); float* km = (float*)(a.ws + WS_KMEAN);
    LAS float* red = (LAS float*)(lds + RING_OFF);
    const int tid = threadIdx.x, c = tid & 15, rg = tid >> 4;
    for (int it = blockIdx.x; it < 16 * 32; it += G) {
        const int bh = it >> 5, blk = it & 31, b = bh >> 3, h = bh & 7;
        float s[8] = {0, 0, 0, 0, 0, 0, 0, 0};
#pragma unroll
        for (int i = 0; i < 8; ++i) { const int row = b * SEQ + blk * 256 + rg + 32 * i; const u32x4 w = *(const u32x4*)(qkv + (size_t)row * NQKV + 4096 + h * 128 + 8 * c);
            s[0] += bf_lo(w.x); s[1] += bf_hi(w.x); s[2] += bf_lo(w.y); s[3] += bf_hi(w.y); s[4] += bf_lo(w.z); s[5] += bf_hi(w.z); s[6] += bf_lo(w.w); s[7] += bf_hi(w.w); }
#pragma unroll
        for (int j = 0; j < 8; ++j) red[rg * 128 + 8 * c + j] = s[j];
        __syncthreads();
        if (tid < 128) { float t = 0.f; for (int r = 0; r < 32; ++r) t += red[r * 128 + tid]; km[(size_t)it * 128 + tid] = t * (1.f / 256.f); }
        __syncthreads();
    }
}

namespace mix {
typedef short s16x4 __attribute__((ext_vector_type(4)));
#define KSWZ(row, colB) ((row) * 256 + ((colB) ^ (((row) & 7) << 4)))
constexpr int L_V = 0, L_K = 16384, L_WS = 32768, L_FLAG = 36864, L_PRE = 40960;
constexpr float THR2 = 11.5f;
__device__ __forceinline__ int crow(int r, int hi) { return (r & 3) + 8 * (r >> 2) + 4 * hi; }
__device__ __forceinline__ unsigned cvtpk(float lo, float hi) { unsigned r; asm volatile("v_cvt_pk_bf16_f32 %0, %1, %2" : "=v"(r) : "v"(lo), "v"(hi)); return r; }
__device__ __forceinline__ int v_st(int k, int c) { const int kk = (k & ~0xC) | ((k & 4) << 1) | ((k & 8) >> 1); return ((kk >> 3) * 4 + (c >> 5)) * 512 + ((kk & 7) * 32 + (c & 31)) * 2; }
__device__ __forceinline__ int v_rd_base(int lane) { return ((lane & 3) << 3) | (((lane >> 2) & 3) << 6) | (((lane >> 4) & 1) << 5) | (((lane >> 5) & 1) << 8); }
constexpr int v_rd_off(int d0, int ks, int half) { return d0 * 512 + ks * 4096 + half * 2048; }
template <int OFF> __device__ __forceinline__ s16x4 tr_read(int vb) { s16x4 r; asm volatile("ds_read_b64_tr_b16 %0, %1 offset:%2" : "=&v"(r) : "v"(vb), "i"(OFF) : "memory"); return r; }
template <int D0> __device__ __forceinline__ void pv_one(f32x16& od, int vb, bf16x8 pa0, bf16x8 pa1, bf16x8 pa2, bf16x8 pa3) {
    const s16x4 l0 = tr_read<v_rd_off(D0, 0, 0)>(vb), h0 = tr_read<v_rd_off(D0, 0, 1)>(vb), l1 = tr_read<v_rd_off(D0, 1, 0)>(vb), h1 = tr_read<v_rd_off(D0, 1, 1)>(vb);
    const s16x4 l2 = tr_read<v_rd_off(D0, 2, 0)>(vb), h2 = tr_read<v_rd_off(D0, 2, 1)>(vb), l3 = tr_read<v_rd_off(D0, 3, 0)>(vb), h3 = tr_read<v_rd_off(D0, 3, 1)>(vb);
    asm volatile("s_waitcnt lgkmcnt(0)" ::: "memory"); __builtin_amdgcn_sched_barrier(0);
#define PK(L, H) (bf16x8){L[0], L[1], L[2], L[3], H[0], H[1], H[2], H[3]}
    od = __builtin_amdgcn_mfma_f32_32x32x16_bf16(pa0, PK(l0, h0), od, 0, 0, 0);
    od = __builtin_amdgcn_mfma_f32_32x32x16_bf16(pa1, PK(l1, h1), od, 0, 0, 0);
    od = __builtin_amdgcn_mfma_f32_32x32x16_bf16(pa2, PK(l2, h2), od, 0, 0, 0);
    od = __builtin_amdgcn_mfma_f32_32x32x16_bf16(pa3, PK(l3, h3), od, 0, 0, 0);
#undef PK
}
__device__ __forceinline__ void pv_d0(f32x16 (&o)[4], int vb, bf16x8 pa0, bf16x8 pa1, bf16x8 pa2, bf16x8 pa3) {
    pv_one<0>(o[0], vb, pa0, pa1, pa2, pa3); pv_one<1>(o[1], vb, pa0, pa1, pa2, pa3); pv_one<2>(o[2], vb, pa0, pa1, pa2, pa3); pv_one<3>(o[3], vb, pa0, pa1, pa2, pa3);
}
__device__ __forceinline__ void qkt(f32x16& p0, f32x16& p1, const LAS unsigned char* Ks, const bf16x8 (&qr)[8], int r32, int hi) {
#pragma unroll
    for (int i = 0; i < 16; ++i) { p0[i] = 0.f; p1[i] = 0.f; }
#pragma unroll
    for (int d0 = 0; d0 < 8; ++d0) { const int cb = (d0 * 16 + hi * 8) * 2;
        const bf16x8 b0 = *(const LAS bf16x8*)(Ks + KSWZ(r32, cb));
        const bf16x8 b1 = *(const LAS bf16x8*)(Ks + KSWZ(32 + r32, cb));
        p0 = __builtin_amdgcn_mfma_f32_32x32x16_bf16(b0, qr[d0], p0, 0, 0, 0);
        p1 = __builtin_amdgcn_mfma_f32_32x32x16_bf16(b1, qr[d0], p1, 0, 0, 0); }
}
__device__ __forceinline__ void pack_p(const f32x16& p0, const f32x16& p1, bf16x8& pa0, bf16x8& pa1, bf16x8& pa2, bf16x8& pa3) {
#define PK4(P, BASE, OUT) do { unsigned a0 = cvtpk(P[BASE + 0], P[BASE + 1]), a1 = cvtpk(P[BASE + 2], P[BASE + 3]);   \
    unsigned b0 = cvtpk(P[BASE + 4], P[BASE + 5]), b1 = cvtpk(P[BASE + 6], P[BASE + 7]);                              \
    auto r0 = __builtin_amdgcn_permlane32_swap(a0, b0, false, false); auto r1 = __builtin_amdgcn_permlane32_swap(a1, b1, false, false); \
    u32x4 w = {r0[0], r1[0], r0[1], r1[1]}; OUT = __builtin_bit_cast(bf16x8, w); } while (0)
    PK4(p0, 0, pa0); PK4(p0, 8, pa1); PK4(p1, 0, pa2); PK4(p1, 8, pa3);
#undef PK4
}
__device__ __forceinline__ float pair_other(float x, int hi) {
    auto rr = __builtin_amdgcn_permlane32_swap(__builtin_bit_cast(unsigned, x), __builtin_bit_cast(unsigned, x), false, false);
    return __builtin_bit_cast(float, hi ? rr[0] : rr[1]);
}
struct TileRegs { u32x4 k0, k1, v0, v1; };
__device__ __forceinline__ void stage_load(TileRegs& r, const bf16* kg, const bf16* vg, int tid) {
    const int sr = tid >> 4, sc = (tid & 15) * 8;
    r.k0 = *(const u32x4*)(kg + (size_t)sr * NQKV + sc); r.k1 = *(const u32x4*)(kg + (size_t)(32 + sr) * NQKV + sc);
    r.v0 = *(const u32x4*)(vg + (size_t)sr * NQKV + sc); r.v1 = *(const u32x4*)(vg + (size_t)(32 + sr) * NQKV + sc);
}
__device__ __forceinline__ void stage_write(LAS unsigned char* lds, const TileRegs& r, int tid) {
    const int sr = tid >> 4, sc = (tid & 15) * 8;
    *(LAS u32x4*)(lds + L_V + v_st(sr, sc)) = r.v0; *(LAS u32x4*)(lds + L_V + v_st(32 + sr, sc)) = r.v1;
    *(LAS u32x4*)(lds + L_K + KSWZ(sr, sc * 2)) = r.k0; *(LAS u32x4*)(lds + L_K + KSWZ(32 + sr, sc * 2)) = r.k1;
}
__device__ __forceinline__ float reduce32(float v) { v = reduce16(v); v += __shfl_xor(v, 16); return v; }

__device__ __forceinline__ void sb_unit(const Args& a, LAS unsigned char* lds, int bh, int qb) {
    const bf16* qkv = (const bf16*)(a.ws + WS_QKV); bf16* mixed = (bf16*)(a.ws + WS_MIXED);
    const int tid = threadIdx.x, wid = __builtin_amdgcn_readfirstlane(tid >> 6), lane = tid & 63, r32 = lane & 31, hi = lane >> 5;
    const int b = bh >> 3, h = bh & 7, q0 = qb * 256, qpos = q0 + wid * 32 + r32;
    const bf16* base = qkv + (size_t)b * SEQ * NQKV + h * 128;
    volatile LAS int* flags = (volatile LAS int*)(lds + L_FLAG);
    bf16x8 qr[8];
#pragma unroll
    for (int d0 = 0; d0 < 8; ++d0) qr[d0] = *(const bf16x8*)(base + (size_t)qpos * NQKV + d0 * 16 + hi * 8);
    f32x16 o[4];
#pragma unroll
    for (int d = 0; d < 4; ++d)
#pragma unroll
        for (int i = 0; i < 16; ++i) o[d][i] = 0.f;
    float P = 1.f; bool wdone = false;
    const int vb0 = (int)(uintptr_t)(lds + L_V) + v_rd_base(lane);
    __syncthreads();
    if (tid < 8) flags[tid] = 0;
    TileRegs tr; stage_load(tr, base + (size_t)((qb * 4 + 3) * 64) * NQKV + 1024, base + (size_t)((qb * 4 + 3) * 64) * NQKV + 2048, tid);
    for (int kt = qb * 4 + 3; kt >= 0; --kt) {
        __syncthreads();
        { int alld = 1;
#pragma unroll
          for (int w = 0; w < 8; ++w) alld &= flags[w];
          if (alld) break; }
        stage_write(lds, tr, tid);
        if (kt > 0) stage_load(tr, base + (size_t)((kt - 1) * 64) * NQKV + 1024, base + (size_t)((kt - 1) * 64) * NQKV + 2048, tid);
        __syncthreads();
        const int kbase = kt * 64;
        if (!wdone && kbase < q0 + wid * 32 + 31) {
            f32x16 p0, p1; qkt(p0, p1, lds + L_K, qr, r32, hi);
            const int d0i = kbase + 4 * hi - qpos;
            f32x16 m0, m1;
#pragma unroll
            for (int r = 0; r < 16; ++r) {
                const int c = (r & 3) + 8 * (r >> 2);
                { const float z = fminf(fmaxf(p0[r], -120.f), 120.f); const float e = __builtin_amdgcn_exp2f(-z), be = __builtin_amdgcn_rcpf(1.f + e); const bool ok = (d0i + c) < 0;
                  p0[r] = ok ? be : 0.f; m0[r] = ok ? e * be : 1.f; }
                { const float z = fminf(fmaxf(p1[r], -120.f), 120.f); const float e = __builtin_amdgcn_exp2f(-z), be = __builtin_amdgcn_rcpf(1.f + e); const bool ok = (d0i + 32 + c) < 0;
                  p1[r] = ok ? be : 0.f; m1[r] = ok ? e * be : 1.f; }
            }
            float Go[2][4], Gp[2][4];
#pragma unroll
            for (int g = 0; g < 4; ++g) { Go[0][g] = (m0[4 * g] * m0[4 * g + 1]) * (m0[4 * g + 2] * m0[4 * g + 3]); Go[1][g] = (m1[4 * g] * m1[4 * g + 1]) * (m1[4 * g + 2] * m1[4 * g + 3]); }
#pragma unroll
            for (int ph = 0; ph < 2; ++ph)
#pragma unroll
                for (int g = 0; g < 4; ++g) Gp[ph][g] = pair_other(Go[ph][g], hi);
            float R = P;
#pragma unroll
            for (int ph = 1; ph >= 0; --ph)
#pragma unroll
                for (int g = 3; g >= 0; --g) {
                    const float Gf = hi ? Go[ph][g] : Gp[ph][g], Gs = hi ? Gp[ph][g] : Go[ph][g];
                    const float sA = R; R *= Gf; const float sB = R; R *= Gs;
                    float S = hi ? sA : sB;
                    if (ph == 1) { p1[4 * g + 3] *= S; S *= m1[4 * g + 3]; p1[4 * g + 2] *= S; S *= m1[4 * g + 2]; p1[4 * g + 1] *= S; S *= m1[4 * g + 1]; p1[4 * g] *= S; }
                    else         { p0[4 * g + 3] *= S; S *= m0[4 * g + 3]; p0[4 * g + 2] *= S; S *= m0[4 * g + 2]; p0[4 * g + 1] *= S; S *= m0[4 * g + 1]; p0[4 * g] *= S; }
                }
            P = R;
            bf16x8 pa0, pa1, pa2, pa3; pack_p(p0, p1, pa0, pa1, pa2, pa3);
            pv_d0(o, vb0, pa0, pa1, pa2, pa3);
            wdone = __builtin_amdgcn_ballot_w64(P >= 1e-30f) == 0ull;
        }
        if (lane == 0) flags[wid] = (wdone || kt == 0) ? 1 : 0;
    }
    f32x4 gn; gn.x = a.norm_sb[h * 128 + r32]; gn.y = a.norm_sb[h * 128 + 32 + r32]; gn.z = a.norm_sb[h * 128 + 64 + r32]; gn.w = a.norm_sb[h * 128 + 96 + r32];
#pragma unroll
    for (int r = 0; r < 16; ++r) {
        float ss = (o[0][r] * o[0][r] + o[1][r] * o[1][r]) + (o[2][r] * o[2][r] + o[3][r] * o[3][r]);
        ss = reduce32(ss) * (1.f / 128.f);
        const float rn = 1.f / sqrtf(ss + RMS_EPS);
        bf16* orow = mixed + (size_t)(b * SEQ + q0 + wid * 32 + crow(r, hi)) * D + h * 128 + r32;
        orow[0] = (bf16)f2bf(o[0][r] * rn * gn.x); orow[32] = (bf16)f2bf(o[1][r] * rn * gn.y); orow[64] = (bf16)f2bf(o[2][r] * rn * gn.z); orow[96] = (bf16)f2bf(o[3][r] * rn * gn.w);
    }
}

__device__ __forceinline__ int moba_entry(const int* list, int n, bool own_unit, int j, int ei) { return own_unit ? ((j * 256 + ei) | (3 << 16)) : list[ei < n ? ei : 0]; }
__device__ __forceinline__ void moba_unit(const Args& a, LAS unsigned char* lds, int bh, int j, int ent, int n, bool own_unit, bool hn, const int* nlist, int nn, bool nown, int nj, int& ent_next) {
    const bf16* qkv = (const bf16*)(a.ws + WS_QKV); bf16* po = (bf16*)(a.ws + WS_MPO); float* pml = (float*)(a.ws + WS_MPML);
    const int tid = threadIdx.x, wid = __builtin_amdgcn_readfirstlane(tid >> 6), lane = tid & 63, r32 = lane & 31, hi = lane >> 5;
    const int b = bh >> 3, h = bh & 7;
    const bf16* base = qkv + (size_t)b * SEQ * NQKV + h * 128;
    LAS float* wsf = (LAS float*)(lds + L_WS + wid * 512); LAS float* al_l = wsf; LAS float* li_l = wsf + 32; LAS int* tb = (LAS int*)(wsf + 64);
    const int ei = wid * 32 + r32;
    const bool evalid = own_unit || (ei < n);
    const int qpos = ent & 0xffff, slot = ent >> 16;
    const int pslot = evalid ? (((bh * SEQ + qpos) << 2) + slot) : -1;
    __syncthreads();
    if (hi == 0) tb[r32] = pslot;
    bf16x8 qr[8];
#pragma unroll
    for (int d0 = 0; d0 < 8; ++d0) qr[d0] = *(const bf16x8*)(base + (size_t)qpos * NQKV + 3072 + d0 * 16 + hi * 8);
    f32x16 o[4];
#pragma unroll
    for (int d = 0; d < 4; ++d)
#pragma unroll
        for (int i = 0; i < 16; ++i) o[d][i] = 0.f;
    float m_reg = -1e30f, l_reg = 0.f;
    const float slope2 = __builtin_amdgcn_exp2f(-(float)(h + 1)) * LOG2E;
    const int vb0 = (int)(uintptr_t)(lds + L_V) + v_rd_base(lane);
    TileRegs tr; stage_load(tr, base + (size_t)(j * 256) * NQKV + 4096, base + (size_t)(j * 256) * NQKV + 5120, tid);
    if (hn) ent_next = moba_entry(nlist, nn, nown, nj, ei);
    for (int jt = 0; jt < 4; ++jt) {
        if (jt) __syncthreads();
        const int kbase = j * 256 + jt * 64;
        stage_write(lds, tr, tid);
        if (jt < 3) stage_load(tr, base + (size_t)(kbase + 64) * NQKV + 4096, base + (size_t)(kbase + 64) * NQKV + 5120, tid);
        __syncthreads();
        if (own_unit && jt * 64 > wid * 32 + 31) continue;
        f32x16 p0, p1; qkt(p0, p1, lds + L_K, qr, r32, hi);
        const int d0i = kbase + 4 * hi - qpos;
        float pmax = -1e30f;
#pragma unroll
        for (int r = 0; r < 16; ++r) {
            const int c = (r & 3) + 8 * (r >> 2);
            { const int x = d0i + c; const float s = fmaf(slope2, (float)x, p0[r]); p0[r] = (x <= 0) ? s : -1e30f; pmax = fmaxf(pmax, p0[r]); }
            { const int x = d0i + 32 + c; const float s = fmaf(slope2, (float)x, p1[r]); p1[r] = (x <= 0) ? s : -1e30f; pmax = fmaxf(pmax, p1[r]); }
        }
        pmax = fmaxf(pmax, pair_other(pmax, hi));
        float mn, alpha;
        if (__builtin_amdgcn_ballot_w64(pmax - m_reg > THR2) == 0ull) { mn = m_reg; alpha = 1.f; }
        else { mn = fmaxf(m_reg, pmax); alpha = __builtin_amdgcn_exp2f(m_reg - mn); m_reg = mn; }
        float ps = 0.f;
#pragma unroll
        for (int r = 0; r < 16; ++r) { p0[r] = __builtin_amdgcn_exp2f(p0[r] - mn); p1[r] = __builtin_amdgcn_exp2f(p1[r] - mn); ps += p0[r] + p1[r]; }
        ps += pair_other(ps, hi);
        l_reg = l_reg * alpha + ps;
        if (__builtin_amdgcn_ballot_w64(alpha < 1.f) != 0ull) {
            if (hi == 0) al_l[r32] = alpha;
            asm volatile("s_waitcnt lgkmcnt(0)" ::: "memory");
#pragma unroll
            for (int r = 0; r < 16; ++r) { const float al = al_l[crow(r, hi)];
#pragma unroll
                for (int d = 0; d < 4; ++d) o[d][r] *= al; }
        }
        bf16x8 pa0, pa1, pa2, pa3; pack_p(p0, p1, pa0, pa1, pa2, pa3);
        pv_d0(o, vb0, pa0, pa1, pa2, pa3);
    }
    if (hi == 0) { li_l[r32] = l_reg; if (evalid) { f32x2 ml; ml.x = m_reg; ml.y = l_reg; *(f32x2*)(pml + 2 * (size_t)pslot) = ml; } }
    asm volatile("s_waitcnt lgkmcnt(0)" ::: "memory");
#pragma unroll
    for (int r = 0; r < 16; ++r) {
        const int rw = crow(r, hi); const int ps_ = tb[rw]; const float rl = __builtin_amdgcn_rcpf(li_l[rw]);
        if (ps_ >= 0) { bf16* orow = po + (size_t)ps_ * 128 + r32;
            orow[0] = (bf16)f2bf(o[0][r] * rl); orow[32] = (bf16)f2bf(o[1][r] * rl); orow[64] = (bf16)f2bf(o[2][r] * rl); orow[96] = (bf16)f2bf(o[3][r] * rl); }
    }
}
}

__device__ __forceinline__ void unpack8(const u32x4 w, float (&f)[8]) { f[0] = bf_lo(w.x); f[1] = bf_hi(w.x); f[2] = bf_lo(w.y); f[3] = bf_hi(w.y); f[4] = bf_lo(w.z); f[5] = bf_hi(w.z); f[6] = bf_lo(w.w); f[7] = bf_hi(w.w); }
__device__ __forceinline__ float dot8(const float (&q)[8], const float (&k)[8]) { float s = q[0] * k[0];
#pragma unroll
    for (int j = 1; j < 8; ++j) s = fmaf(q[j], k[j], s); return s; }
__device__ __forceinline__ bool gate_better(float v, int i, float w, int j) { return (v > w) || (v == w && i < j); }
#define TOP3_INSERT(ok, g, n) do { const float g_ = (g); const int n_ = (n); const bool ok_ = (ok); \
    const bool b0_ = ok_ && gate_better(g_, n_, v0, i0), b1_ = ok_ && gate_better(g_, n_, v1, i1), b2_ = ok_ && gate_better(g_, n_, v2, i2); \
    v2 = b1_ ? v1 : (b2_ ? g_ : v2); i2 = b1_ ? i1 : (b2_ ? n_ : i2); \
    v1 = b0_ ? v0 : (b1_ ? g_ : v1); i1 = b0_ ? i0 : (b1_ ? n_ : i1); \
    v0 = b0_ ? g_ : v0; i0 = b0_ ? n_ : i0; } while (0)
__device__ __forceinline__ void p3_gate_tile(const Args& a, int bh, int qt, int lane) {
    const bf16* qkv = (const bf16*)(a.ws + WS_QKV); const float* km = (const float*)(a.ws + WS_KMEAN);
    unsigned* mcnt = (unsigned*)(a.ws + WS_CTL) + CW_MCNT; int* mlist = (int*)(a.ws + WS_MLIST);
    const int b = bh >> 3, h = bh & 7, r32 = lane & 31, hi = lane >> 5, t0 = 32 * qt, own = t0 >> 8, t = t0 + r32;
    if (own == 0) return;
    f32x16 p;
#pragma unroll
    for (int i = 0; i < 16; ++i) p[i] = 0.f;
    const float* kp = km + ((size_t)bh * 32 + r32) * 128 + hi * 8;
    const bf16* qp = qkv + (size_t)(b * SEQ + t) * NQKV + 3072 + h * 128 + hi * 8;
#pragma unroll
    for (int d0 = 0; d0 < 8; ++d0) {
        const f32x4 k0 = *(const f32x4*)(kp + d0 * 16), k1 = *(const f32x4*)(kp + d0 * 16 + 4);
        u32x4 kw; kw.x = pk2(k0.x, k0.y); kw.y = pk2(k0.z, k0.w); kw.z = pk2(k1.x, k1.y); kw.w = pk2(k1.z, k1.w);
        const bf16x8 qf = *(const bf16x8*)(qp + d0 * 16);
        p = __builtin_amdgcn_mfma_f32_32x32x16_bf16(__builtin_bit_cast(bf16x8, kw), qf, p, 0, 0, 0);
    }
    float v0 = -INFINITY, v1 = -INFINITY, v2 = -INFINITY; int i0 = 64, i1 = 64, i2 = 64;
#pragma unroll
    for (int r = 0; r < 16; ++r) { const int n = (r & 3) + 8 * (r >> 2) + 4 * hi; TOP3_INSERT(n < own, p[r], n); }
    { const float w0 = mix::pair_other(v0, hi), w1 = mix::pair_other(v1, hi), w2 = mix::pair_other(v2, hi);
      const int j0 = __builtin_bit_cast(int, mix::pair_other(__builtin_bit_cast(float, i0), hi)), j1 = __builtin_bit_cast(int, mix::pair_other(__builtin_bit_cast(float, i1), hi)), j2 = __builtin_bit_cast(int, mix::pair_other(__builtin_bit_cast(float, i2), hi));
      TOP3_INSERT(j0 < 64, w0, j0); TOP3_INSERT(j1 < 64, w1, j1); TOP3_INSERT(j2 < 64, w2, j2); }
    const int nsel = own < 3 ? own : 3;
    const bool ql = hi == 0;
    const bool s1 = nsel > 1, s2 = nsel > 2;
    const unsigned long long ltmask = (1ull << lane) - 1ull;
    int mycount = 0, r0 = 0, r1 = 0, r2 = 0;
    for (int n = 0; n < own; ++n) {
        const unsigned long long mk = __builtin_amdgcn_ballot_w64(ql && (i0 == n || (s1 && i1 == n) || (s2 && i2 == n)));
        const int c = __builtin_popcountll(mk), rk = __builtin_popcountll(mk & ltmask);
        if (lane == n) mycount = c;
        if (i0 == n) r0 = rk; if (i1 == n) r1 = rk; if (i2 == n) r2 = rk;
    }
    int basev = 0;
    if (lane < own && mycount > 0) basev = (int)__hip_atomic_fetch_add(mcnt + 16 * (bh * 32 + lane), (unsigned)mycount, RLX_AGENT);
    const int q0 = __shfl(basev, i0 & 31) + r0, q1 = __shfl(basev, i1 & 31) + r1, q2 = __shfl(basev, i2 & 31) + r2;
    if (ql) {
        mlist[(size_t)(bh * 32 + i0) * SEQ + q0] = t | (0 << 16);
        if (s1) mlist[(size_t)(bh * 32 + i1) * SEQ + q1] = t | (1 << 16);
        if (s2) mlist[(size_t)(bh * 32 + i2) * SEQ + q2] = t | (2 << 16);
    }
}
__device__ __forceinline__ void p3_sb_and_gate(const Args& a, LAS unsigned char* lds, int G, int wg, int gw, int NGW, int lane) {
    for (int it = gw; it < 16 * (SEQ / 32); it += NGW) p3_gate_tile(a, it >> 8, it & 255, lane);
}
__device__ __forceinline__ void p4_moba(const Args& a, LAS unsigned char* lds, int G, int wg) {
    const unsigned* mcnt = (const unsigned*)(a.ws + WS_CTL) + CW_MCNT; const int* mlist = (const int*)(a.ws + WS_MLIST);
    LAS int* pre = (LAS int*)(lds + mix::L_PRE);
    const int tid = threadIdx.x;
    __syncthreads();
    if (tid < 64) {
        int c[8], s = 0;
#pragma unroll
        for (int i = 0; i < 8; ++i) { c[i] = ((int)mcnt[16 * (tid * 8 + i)] + 255) >> 8; s += c[i]; }
        int inc = s;
#pragma unroll
        for (int o = 1; o < 64; o <<= 1) { const int v = __shfl_up(inc, o); if (tid >= o) inc += v; }
        int run = inc - s;
#pragma unroll
        for (int i = 0; i < 8; ++i) { pre[tid * 8 + i] = run; run += c[i]; }
        if (tid == 63) pre[512] = run;
    }
    __syncthreads();
    const int usel = pre[512], total = usel + 512;
#define P4_DECODE(uu_, k_, n_, own_, lp_) do { const int u_ = (uu_) - 16 * 32; \
        if (u_ < usel) { int lo_ = 0, hi_ = 511; while (lo_ < hi_) { const int mid_ = (lo_ + hi_ + 1) >> 1; if (pre[mid_] <= u_) lo_ = mid_; else hi_ = mid_ - 1; } \
            k_ = __builtin_amdgcn_readfirstlane(lo_); const int c_ = u_ - pre[k_]; const int cnt_ = (int)mcnt[16 * k_]; \
            lp_ = mlist + (size_t)k_ * SEQ + c_ * 256; n_ = (cnt_ - c_ * 256) < 256 ? (cnt_ - c_ * 256) : 256; own_ = false; } \
        else { k_ = u_ - usel; lp_ = nullptr; n_ = 256; own_ = true; } } while (0)
    const int ei = (tid >> 6) * 32 + (tid & 31);
    int ent = 0; bool have = false;
    int k = 0, n = 0; bool own = false; const int* lp = nullptr;
    for (int uu = wg; uu < total + 16 * 32; uu += G) {
        if (uu < 16 * 32) { const unsigned pb41 = pb_begin(41); mix::sb_unit(a, lds, uu >> 5, uu & 31); pb_end(41, pb41); continue; }
        if (!have) { P4_DECODE(uu, k, n, own, lp); ent = mix::moba_entry(lp, n, own, k & 31, ei); }
        const bool hn = uu + G < total + 16 * 32;
        int nk = 0, nn = 0; bool nown = false; const int* nlp = nullptr; if (hn) P4_DECODE(uu + G, nk, nn, nown, nlp);
        int ent_next = 0;
        const unsigned pb42 = pb_begin(42); mix::moba_unit(a, lds, k >> 5, k & 31, ent, n, own, hn, nlp, nn, nown, nk & 31, ent_next); pb_end(42, pb42);
        ent = ent_next; have = hn; k = nk; n = nn; own = nown; lp = nlp;
    }
#undef P4_DECODE
}
__device__ __forceinline__ void p5_combine(const Args& a, int gw, int NGW, int lane) {
    const bf16* po = (const bf16*)(a.ws + WS_MPO); const float* pml = (const float*)(a.ws + WS_MPML); bf16* mixed = (bf16*)(a.ws + WS_MIXED);
    const int sub = lane >> 4, dl = lane & 15;
    const int total = 16 * (SEQ / 4);
    const bool ginv = (NGW & 15) == 0;
    f32x4 g0 = {0.f, 0.f, 0.f, 0.f}, g1 = g0;
    if (ginv) { const float* gain = a.norm_moba + (gw & 7) * 128 + 8 * dl; g0 = *(const f32x4*)gain; g1 = *(const f32x4*)(gain + 4); }
    f32x2 ml[4]; u32x4 pw[4];
#pragma unroll
    for (int s = 0; s < 4; ++s) { ml[s] = (f32x2){-1e30f, 0.f}; pw[s] = (u32x4){0u, 0u, 0u, 0u}; }
#define P5_ISSUE(it_) do { const int bh_ = (it_) & 15, t_ = 4 * ((it_) >> 4) + sub, own_ = t_ >> 8, nsel_ = own_ < 3 ? own_ : 3; const size_t ps_ = ((size_t)(bh_ * SEQ + t_)) << 2; \
        _Pragma("unroll") for (int s = 0; s < 4; ++s) { const bool ok_ = (s == 3) || (s < nsel_); ml[s] = ok_ ? *(const f32x2*)(pml + 2 * (ps_ + s)) : (f32x2){-1e30f, 0.f}; \
            if (ok_) pw[s] = *(const u32x4*)(po + (ps_ + s) * 128 + 8 * dl); } } while (0)
    if (gw < total) P5_ISSUE(gw);
    for (int it = gw; it < total; it += NGW) {
        const int bh = it & 15, t = 4 * (it >> 4) + sub, b = bh >> 3, h = bh & 7, own = t >> 8, nsel = own < 3 ? own : 3;
        float M = -1e30f;
#pragma unroll
        for (int s = 0; s < 4; ++s) M = fmaxf(M, ml[s].x);
        float w[4], W = 0.f;
#pragma unroll
        for (int s = 0; s < 4; ++s) { w[s] = ml[s].y * __builtin_amdgcn_exp2f(ml[s].x - M); W += w[s]; }
        const float iw = 1.f / W;
        float o[8] = {0, 0, 0, 0, 0, 0, 0, 0};
#pragma unroll
        for (int s = 0; s < 4; ++s) { const bool ok = (s == 3) || (s < nsel);
            if (ok) { float f[8]; unpack8(pw[s], f); const float ws_ = w[s] * iw;
#pragma unroll
                for (int jj = 0; jj < 8; ++jj) o[jj] = fmaf(ws_, f[jj], o[jj]); } }
        if (it + NGW < total) P5_ISSUE(it + NGW);
        float ss = 0.f;
#pragma unroll
        for (int jj = 0; jj < 8; ++jj) ss = fmaf(o[jj], o[jj], ss);
        ss = reduce16(ss) * (1.f / 128.f);
        const float r = 1.f / sqrtf(ss + RMS_EPS);
        if (!ginv) { const float* gain = a.norm_moba + h * 128 + 8 * dl; g0 = *(const f32x4*)gain; g1 = *(const f32x4*)(gain + 4); }
        u32x4 wv; wv.x = pk2(o[0] * r * g0.x, o[1] * r * g0.y); wv.y = pk2(o[2] * r * g0.z, o[3] * r * g0.w); wv.z = pk2(o[4] * r * g1.x, o[5] * r * g1.y); wv.w = pk2(o[6] * r * g1.z, o[7] * r * g1.w);
        *(u32x4*)(mixed + (size_t)(b * SEQ + t) * D + 1024 + h * 128 + 8 * dl) = wv;
    }
#undef P5_ISSUE
}

constexpr int LNT_STRIDE = 2052;
__device__ __forceinline__ void ln1_load(const bf16* src, int lane, u32x2 (&w)[8]) {
    const GAS u32x2* xr = (const GAS u32x2*)src + lane;
#pragma unroll
    for (int j = 0; j < 8; ++j) w[j] = xr[64 * j];
}
#define LN1_OPAQUE(w) do { _Pragma("unroll") for (int j_ = 0; j_ < 8; ++j_) asm volatile("" : "+v"(w[j_].x), "+v"(w[j_].y)); } while (0)
__device__ __forceinline__ void ln1_row(u32x2 (&w)[8], const LAS float* gb, bf16* dst_bf16, unsigned char* dst_q, LAS float* trow, int lane) {
    float s = 0.f;
#pragma unroll
    for (int j = 0; j < 8; ++j) s += (bf_lo(w[j].x) + bf_hi(w[j].x)) + (bf_lo(w[j].y) + bf_hi(w[j].y));
    const float mean = wave_sum(s) * (1.f / D); float s2 = 0.f;
    LN1_OPAQUE(w);
#pragma unroll
    for (int j = 0; j < 8; ++j) { const float x0 = bf_lo(w[j].x) - mean, x1 = bf_hi(w[j].x) - mean, x2 = bf_lo(w[j].y) - mean, x3 = bf_hi(w[j].y) - mean; s2 += (x0 * x0 + x1 * x1) + (x2 * x2 + x3 * x3); }
    const float rstd = 1.f / sqrtf(wave_sum(s2) * (1.f / D) + LN_EPS);
    LN1_OPAQUE(w);
#pragma unroll
    for (int j = 0; j < 8; ++j) {
        const f32x4 gg = *(const LAS f32x4*)(gb + 4 * (lane + 64 * j)), bb = *(const LAS f32x4*)(gb + D + 4 * (lane + 64 * j));
        f32x4 y; y.x = (bf_lo(w[j].x) - mean) * rstd * gg.x + bb.x; y.y = (bf_hi(w[j].x) - mean) * rstd * gg.y + bb.y; y.z = (bf_lo(w[j].y) - mean) * rstd * gg.z + bb.z; y.w = (bf_hi(w[j].y) - mean) * rstd * gg.w + bb.w;
        *(LAS f32x4*)(trow + 4 * (lane + 64 * j)) = y; u32x2 o; o.x = pk2(y.x, y.y); o.y = pk2(y.z, y.w); ((GAS u32x2*)dst_bf16)[lane + 64 * j] = o;
        ((GAS unsigned*)dst_q)[lane + 64 * j] = pack_fp8x4(y.x * XSCALE, y.y * XSCALE, y.z * XSCALE, y.w * XSCALE); }
}
constexpr int LNP_OFF = 136192;
constexpr int LSUM_OFF = LNP_OFF + 8192;
constexpr int LBR_OFF = LSUM_OFF + 16 * 36 * 4;
constexpr int LGB1_OFF = LBR_OFF + 128;
static_assert(LGB1_OFF + 16384 <= LDS_BYTES, "gamma | beta");
__device__ __forceinline__ void router_top4(const Args& a, LAS unsigned char* lds, int r0, int lane) {
    int* rowtok = (int*)(a.ws + WS_ROWTOK); float* rowg = (float*)(a.ws + WS_ROWG); int* toksl = (int*)(a.ws + WS_TOKSL);
    unsigned* ecnt = (unsigned*)(a.ws + WS_CTL) + CW_ECNT;
    const LAS float* Pp = (const LAS float*)(lds + LNP_OFF); LAS float* Ls = (LAS float*)(lds + LSUM_OFF); const LAS float* Lb = (const LAS float*)(lds + LBR_OFF);
    const int row = lane & 15; const bool tl = lane < 16;
    { const int q = lane >> 4;
      f32x4 s0 = *(const LAS f32x4*)(Lb + 8 * q), s1 = *(const LAS f32x4*)(Lb + 8 * q + 4);
#pragma unroll
      for (int w = 0; w < 4; ++w) { if (w == 2) __builtin_amdgcn_sched_barrier(0); s0 += *(const LAS f32x4*)(Pp + (w * 16 + row) * 32 + 8 * q); s1 += *(const LAS f32x4*)(Pp + (w * 16 + row) * 32 + 8 * q + 4); }
      *(LAS f32x4*)(Ls + row * 36 + 8 * q) = s0; *(LAS f32x4*)(Ls + row * 36 + 8 * q + 4) = s1; }
    asm volatile("s_waitcnt lgkmcnt(0)" ::: "memory");
    float v0 = -INFINITY, v1 = -INFINITY, v2 = -INFINITY, v3 = -INFINITY; int e0 = 0, e1 = 0, e2 = 0, e3 = 0;
#pragma unroll
    for (int k = 0; k < 8; ++k) { if ((k & 3) == 0) __builtin_amdgcn_sched_barrier(0); const f32x4 gv = *(const LAS f32x4*)(Ls + row * 36 + 4 * k);
#pragma unroll
        for (int i = 0; i < 4; ++i) { const float g = gv[i]; const int e = 4 * k + i;
            const bool c0 = g > v0, c1 = g > v1, c2 = g > v2, c3 = g > v3;
            v3 = c2 ? v2 : (c3 ? g : v3); e3 = c2 ? e2 : (c3 ? e : e3);
            v2 = c1 ? v1 : (c2 ? g : v2); e2 = c1 ? e1 : (c2 ? e : e2);
            v1 = c0 ? v0 : (c1 ? g : v1); e1 = c0 ? e0 : (c1 ? e : e1);
            v0 = c0 ? g : v0; e0 = c0 ? e : e0; } }
    const float p1 = __expf(v1 - v0), p2 = __expf(v2 - v0), p3 = __expf(v3 - v0), inv = 1.f / (1.f + p1 + p2 + p3);
    const unsigned long long ltmask = (1ull << lane) - 1ull;
    int mycount = 0, r0k = 0, r1k = 0, r2k = 0, r3k = 0;
    for (int e = 0; e < 32; ++e) {
        const unsigned long long mk = __builtin_amdgcn_ballot_w64(tl && (e0 == e || e1 == e || e2 == e || e3 == e));
        const int c = __builtin_popcountll(mk), rk = __builtin_popcountll(mk & ltmask);
        if (lane == e) mycount = c;
        if (e0 == e) r0k = rk; if (e1 == e) r1k = rk; if (e2 == e) r2k = rk; if (e3 == e) r3k = rk;
    }
    int basev = 0;
    { int ln = lane; asm volatile("" : "+v"(ln));
      if (ln < 32 && mycount > 0) basev = (int)__hip_atomic_fetch_add(ecnt + 32 * ln, (unsigned)mycount, RLX_AGENT); }
    const int q0 = __shfl(basev, e0) + r0k, q1 = __shfl(basev, e1) + r1k, q2 = __shfl(basev, e2) + r2k, q3 = __shfl(basev, e3) + r3k;
    if (tl) {
        const int tok = r0 + lane;
        rowtok[e0 * ECAP + q0] = tok; rowg[e0 * ECAP + q0] = inv;
        rowtok[e1 * ECAP + q1] = tok; rowg[e1 * ECAP + q1] = p1 * inv;
        rowtok[e2 * ECAP + q2] = tok; rowg[e2 * ECAP + q2] = p2 * inv;
        rowtok[e3 * ECAP + q3] = tok; rowg[e3 * ECAP + q3] = p3 * inv;
        int4 sl; sl.x = (e0 << 16) | q0; sl.y = (e1 << 16) | q1; sl.z = (e2 << 16) | q2; sl.w = (e3 << 16) | q3;
        *(int4*)(toksl + 4 * tok) = sl;
    }
}
__device__ __forceinline__ void p7_ln1_router(const Args& a, LAS unsigned char* lds, int vcu, int G, int wave, int lane_) {
    const int lane = lane_;
    const bf16* hh = (const bf16*)(a.ws + WS_H); bf16* x1b = (bf16*)(a.ws + WS_X1B); unsigned char* x1q = (unsigned char*)(a.ws + WS_X1Q);
    LAS float* T = (LAS float*)(lds + RING_OFF); LAS float* Pp = (LAS float*)(lds + LNP_OFF);
    const int n16 = lane & 15, kq = lane >> 4;
    LAS float* gb = (LAS float*)(lds + LGB1_OFF);
    { const int tid = wave * 64 + lane;
      for (int i = tid; i < D / 4; i += 512) { *(LAS f32x4*)(gb + 4 * i) = ((const GAS f32x4*)a.ln1_g)[i]; *(LAS f32x4*)(gb + D + 4 * i) = ((const GAS f32x4*)a.ln1_b)[i]; }
      if (tid < 8) *(LAS f32x4*)(lds + LBR_OFF + 16 * tid) = ((const GAS f32x4*)a.b_router)[tid]; }
    constexpr int NRR = 4;
    float breg[64 - NRR][2];
#pragma unroll
    for (int sI = NRR; sI < 64; ++sI) { const float* bp = a.w_router + (size_t)(256 * wave + 4 * sI + kq) * NE + n16; breg[sI - NRR][0] = bp[0]; breg[sI - NRR][1] = bp[16]; }
    const bool has3 = wave == 4;
    const int rl0 = 2 * (wave - 1), rl2 = 14;
    u32x2 raw[2][8]; unsigned touch = 0u;
    if (wave != 0 && vcu < M / 16) {
        ln1_load(hh + (size_t)(vcu * 16 + rl0) * D, lane, raw[0]); ln1_load(hh + (size_t)(vcu * 16 + rl0 + 1) * D, lane, raw[1]);
        if (has3) touch = *(const GAS unsigned*)((const unsigned char*)(hh + (size_t)(vcu * 16 + 14) * D) + 128 * lane); }
    __syncthreads();
    int prev_r0 = -1;
    for (int tile = vcu;; tile += G) {
        const bool has = tile < M / 16;
        const int r0 = tile * 16;
        if (wave == 0) { const unsigned pb72 = pb_begin(72); int lane = lane_; asm volatile("" : "+v"(lane)); if (prev_r0 >= 0) router_top4(a, lds, prev_r0, lane); pb_end(72, pb72); }
        else if (has) { const unsigned pb73 = pb_begin(73);
            asm volatile("" :: "v"(touch));
            int lane = lane_; asm volatile("" : "+v"(lane));
            ln1_row(raw[0], gb, x1b + (size_t)(r0 + rl0) * D, x1q + (size_t)(r0 + rl0) * D, T + rl0 * LNT_STRIDE, lane);
            if (has3) ln1_load(hh + (size_t)(r0 + rl2) * D, lane, raw[0]);
            ln1_row(raw[1], gb, x1b + (size_t)(r0 + rl0 + 1) * D, x1q + (size_t)(r0 + rl0 + 1) * D, T + (rl0 + 1) * LNT_STRIDE, lane);
            if (has3) { ln1_load(hh + (size_t)(r0 + rl2 + 1) * D, lane, raw[1]);
                ln1_row(raw[0], gb, x1b + (size_t)(r0 + rl2) * D, x1q + (size_t)(r0 + rl2) * D, T + rl2 * LNT_STRIDE, lane);
                ln1_row(raw[1], gb, x1b + (size_t)(r0 + rl2 + 1) * D, x1q + (size_t)(r0 + rl2 + 1) * D, T + (rl2 + 1) * LNT_STRIDE, lane); }
            pb_end(73, pb73); }
        if (!has) break;
        asm volatile("s_waitcnt lgkmcnt(0)\n\ts_barrier" ::: "memory");
        const unsigned pb74 = pb_begin(74);
        float bt[NRR][2];
        { int kqo = kq; asm volatile("" : "+v"(kqo)); const float* bp = a.w_router + (size_t)(256 * wave + kqo) * NE + n16;
#pragma unroll
          for (int sI = 0; sI < NRR; ++sI) { bt[sI][0] = bp[4 * sI * NE]; bt[sI][1] = bp[4 * sI * NE + 16]; } }
        __builtin_amdgcn_sched_barrier(0);
        if (wave != 0 && tile + G < M / 16) { const bf16* nx = hh + (size_t)(r0 + 16 * G) * D;
            ln1_load(nx + (size_t)rl0 * D, lane, raw[0]); ln1_load(nx + (size_t)(rl0 + 1) * D, lane, raw[1]);
            if (has3) { int lo = lane_; asm volatile("" : "+v"(lo)); touch = *(const GAS unsigned*)((const unsigned char*)(nx + (size_t)14 * D) + 128 * lo); } }
        __builtin_amdgcn_sched_barrier(0);
        f32x4 acc0 = {0.f, 0.f, 0.f, 0.f}, acc1 = {0.f, 0.f, 0.f, 0.f};
        const LAS float* ap = T + n16 * LNT_STRIDE + 256 * wave + kq;
#pragma unroll
        for (int sI = NRR; sI < 64; ++sI) { if ((sI & 7) == (NRR & 7)) __builtin_amdgcn_sched_barrier(0);
            const float av = ap[4 * sI];
            acc0 = __builtin_amdgcn_mfma_f32_16x16x4f32(av, breg[sI - NRR][0], acc0, 0, 0, 0);
            acc1 = __builtin_amdgcn_mfma_f32_16x16x4f32(av, breg[sI - NRR][1], acc1, 0, 0, 0); }
        __builtin_amdgcn_sched_barrier(0);
#pragma unroll
        for (int sI = 0; sI < NRR; ++sI) { const float av = ap[4 * sI];
            acc0 = __builtin_amdgcn_mfma_f32_16x16x4f32(av, bt[sI][0], acc0, 0, 0, 0);
            acc1 = __builtin_amdgcn_mfma_f32_16x16x4f32(av, bt[sI][1], acc1, 0, 0, 0); }
        { LAS float* pw = Pp + ((wave & 3) * 16 + 4 * kq) * 32 + n16;
          if (wave >= 4) {
#pragma unroll
              for (int i = 0; i < 4; ++i) { pw[i * 32] = acc0[i]; pw[i * 32 + 16] = acc1[i]; } }
          asm volatile("s_waitcnt lgkmcnt(0)\n\ts_barrier" ::: "memory");
          if (wave < 4) {
#pragma unroll
              for (int i = 0; i < 4; ++i) { pw[i * 32] = acc0[i] + pw[i * 32]; pw[i * 32 + 16] = acc1[i] + pw[i * 32 + 16]; } } }
        pb_end(74, pb74);
        asm volatile("s_waitcnt lgkmcnt(0)\n\ts_barrier" ::: "memory");
        prev_r0 = r0;
    }
    __syncthreads();
}

__device__ __forceinline__ void p9_ln2(const Args& a, LAS unsigned char* lds, const LAS int* tab, int gw, int NGW, int lane) {
    const bf16* x1b = (const bf16*)(a.ws + WS_X1B); const unsigned char* Y = (const unsigned char*)(a.ws + WS_Y); const int* toksl = (const int*)(a.ws + WS_TOKSL);
    bf16* x2b = (bf16*)(a.ws + WS_X2B); unsigned char* x2q = (unsigned char*)(a.ws + WS_X2Q);
    LAS float* gb = (LAS float*)(lds + RING_OFF);
    for (int i = threadIdx.x; i < D / 4; i += 512) { *(LAS f32x4*)(gb + 4 * i) = ((const GAS f32x4*)a.ln2_g)[i]; *(LAS f32x4*)(gb + D + 4 * i) = ((const GAS f32x4*)a.ln2_b)[i]; }
    __syncthreads();
    u32x2 xw[8]; unsigned yw[4][8]; int4 sln = {0, 0, 0, 0};
#define LN2_ISSUE(mm, sl_) do { const int4 s_ = (sl_); const size_t r0_ = (size_t)(tab[s_.x >> 16] * 256 + (s_.x & 0xffff)), r1_ = (size_t)(tab[s_.y >> 16] * 256 + (s_.y & 0xffff)), \
        r2_ = (size_t)(tab[s_.z >> 16] * 256 + (s_.z & 0xffff)), r3_ = (size_t)(tab[s_.w >> 16] * 256 + (s_.w & 0xffff)); \
        const GAS u32x2* xr_ = (const GAS u32x2*)(x1b + (size_t)(mm) * D) + lane; \
        _Pragma("unroll") for (int j = 0; j < 8; ++j) { xw[j] = xr_[64 * j]; \
            yw[0][j] = ((const GAS unsigned*)(Y + r0_ * D))[lane + 64 * j]; yw[1][j] = ((const GAS unsigned*)(Y + r1_ * D))[lane + 64 * j]; \
            yw[2][j] = ((const GAS unsigned*)(Y + r2_ * D))[lane + 64 * j]; yw[3][j] = ((const GAS unsigned*)(Y + r3_ * D))[lane + 64 * j]; } } while (0)
    if (gw < M) { const int4 sl0 = *(const int4*)(toksl + 4 * gw); LN2_ISSUE(gw, sl0); if (gw + NGW < M) sln = *(const int4*)(toksl + 4 * (gw + NGW)); }
    for (int m = gw; m < M; m += NGW) {
        f32x4 v[8]; float s = 0.f;
#pragma unroll
        for (int j = 0; j < 8; ++j) { f32x4 t; t.x = bf_lo(xw[j].x) * DN_ALPHA; t.y = bf_hi(xw[j].x) * DN_ALPHA; t.z = bf_lo(xw[j].y) * DN_ALPHA; t.w = bf_hi(xw[j].y) * DN_ALPHA;
#pragma unroll
            for (int k = 0; k < 4; ++k) { const unsigned w = yw[k][j]; const f32x2 lo = __builtin_amdgcn_cvt_pk_f32_fp8(w, false), hi = __builtin_amdgcn_cvt_pk_f32_fp8(w, true);
                t.x = fmaf(lo.x, 1.f / YSCALE, t.x); t.y = fmaf(lo.y, 1.f / YSCALE, t.y); t.z = fmaf(hi.x, 1.f / YSCALE, t.z); t.w = fmaf(hi.y, 1.f / YSCALE, t.w); }
            v[j] = t; s += (t.x + t.y) + (t.z + t.w); }
        if (m + NGW < M) { LN2_ISSUE(m + NGW, sln); if (m + 2 * NGW < M) sln = *(const int4*)(toksl + 4 * (m + 2 * NGW)); }
        const float mean = wave_sum(s) * (1.f / D); float s2 = 0.f;
#pragma unroll
        for (int j = 0; j < 8; ++j) { v[j] = v[j] - mean; s2 += (v[j].x * v[j].x + v[j].y * v[j].y) + (v[j].z * v[j].z + v[j].w * v[j].w); }
        const float rstd = 1.f / sqrtf(wave_sum(s2) * (1.f / D) + LN_EPS);
#pragma unroll
        for (int j = 0; j < 8; ++j) { const f32x4 gg = *(const LAS f32x4*)(gb + 4 * (lane + 64 * j)), bb = *(const LAS f32x4*)(gb + D + 4 * (lane + 64 * j)); const f32x4 y = v[j] * rstd * gg + bb;
            u32x2 o; o.x = pk2(y.x, y.y); o.y = pk2(y.z, y.w); ((GAS u32x2*)(x2b + (size_t)m * D))[lane + 64 * j] = o;
            ((GAS unsigned*)(x2q + (size_t)m * D))[lane + 64 * j] = pack_fp8x4(y.x * XSCALE, y.y * XSCALE, y.z * XSCALE, y.w * XSCALE); }
    }
#undef LN2_ISSUE
    __syncthreads();
}

#ifndef REP_PHASE
#define REP_PHASE (-1)
#endif
constexpr int NPHASE = 13;
__global__ void __launch_bounds__(512, 2) fwd_kernel(Args args) {
    extern __shared__ __attribute__((aligned(16))) unsigned char lds_raw[];
    LAS unsigned char* lds = (LAS unsigned char*)lds_raw;
    volatile LAS unsigned* MISC = (volatile LAS unsigned*)(lds + MISC_OFF);
    const int tid = threadIdx.x, lane = tid & 63, wave = __builtin_amdgcn_readfirstlane(tid >> 6);
    const int G = gridDim.x; const int bx = blockIdx.x;
    const int vcu = (G % 8 == 0) ? (bx % 8) * (G / 8) + bx / 8 : bx;
    const int gw = vcu * 8 + wave, NGW = G * 8;
    unsigned char* ws = args.ws;
    unsigned* ctl = (unsigned*)(ws + WS_CTL);
    for (int u = tid; u < (LDS_BYTES - LDSCTL_OFF) / 4; u += 512) ((LAS unsigned*)(lds + LDSCTL_OFF))[u] = 0u;
    __syncthreads();
    const int lo = args.ph_lo, hi = args.ph_hi;
    const bool use_bar = (hi - lo) > 1;
    XcdBarrier bar; bar.bar = ctl + CW_BAR; bar.x = 0; bar.st = nullptr;
    if (use_bar) bar = xcd_barrier_post(ctl + CW_BAR, MISC + 8);
#ifdef ONLY_PHASE
#define IN(k) ((k) == ONLY_PHASE)
#else
#define IN(k) (lo <= (k) && (k) < hi)
#endif
#define SEAM(k) do { if (IN(k) && IN((k) + 1)) xcd_barrier(bar); } while (0)
    LAS int* moetab = (LAS int*)(lds + MOE_OFF);
    const bool cvon = (NGW == CV_LISTS);
    const bool cvfirst = ((bx >> 3) & 1) == 0;
    const int len_up = cvon ? cv_list_len(gw, CV_UP_END) : 0, len_all = cvon ? cv_list_len(gw, CV_BLOCKS) : 0;

    if (IN(0)) { const unsigned pbp_ = pb_begin(100); p0_prologue(args, lds, gw, NGW, wave, lane); pb_end(100, pbp_); SEAM(0); }
    if (IN(1)) { const unsigned pbp_ = pb_begin(101);
        if (cvon && cvfirst) cv_range(args, gw, 0, len_up, lane);
        { pg8::Gemm g{(const bf16*)(ws + WS_XB), (const bf16*)(ws + WS_WINT), D, 0, nullptr}; DenseSched S; S.init(M, NQKV, G, bx);
          EpiQKV E{(bf16*)(ws + WS_QKV), NQKV, true, (float*)(ws + WS_KMEAN)};
          pg8::gemm_phase<EpiQKV, DenseSched, false, true>(lds + RING_OFF, g, S, E); }
        { pg8::Gemm g{(const bf16*)(ws + WS_PB), (const bf16*)(ws + WS_WPLET), PLE, 0, nullptr}; DenseSched S; S.init(M, D, G, bx);
          EpiQKV E{(bf16*)(ws + WS_PLEB), D, false, nullptr};
          pg8::gemm_phase<EpiQKV, DenseSched, false, true>(lds + RING_OFF, g, S, E); }
        if (cvon && !cvfirst) cv_range(args, gw, 0, len_up, lane);
        pb_end(101, pbp_); SEAM(1);
    }
    if (IN(3)) { const unsigned pbp_ = pb_begin(103); p3_sb_and_gate(args, lds, G, bx, gw, NGW, lane); pb_end(103, pbp_); SEAM(3); }
    if (IN(4)) { const unsigned pbp_ = pb_begin(104); p4_moba(args, lds, G, bx); pb_end(104, pbp_); SEAM(4); }
    if (IN(5)) { const unsigned pbp_ = pb_begin(105); p5_combine(args, gw, NGW, lane); pb_end(105, pbp_); SEAM(5); }
    if (IN(6)) { const unsigned pbp_ = pb_begin(106);
        pg8::Gemm g{(const bf16*)(ws + WS_MIXED), (const bf16*)(ws + WS_WOUTT), D, 0, nullptr}; DenseSched S; S.init(M, D, G, bx);
        EpiH E{(const bf16*)(ws + WS_XB), (bf16*)(ws + WS_H)};
        pg8::gemm_phase<EpiH, DenseSched, false, true>(lds + RING_OFF, g, S, E);
        pb_end(106, pbp_); SEAM(6);
    }
    if (IN(7)) { const unsigned pbp_ = pb_begin(107); p7_ln1_router(args, lds, vcu, G, wave, lane); pb_end(107, pbp_); SEAM(7); }
    if (IN(8)) {
        if (!cvon) { for (int blk = gw; blk < CV_BLOCKS; blk += NGW) { P0Job j0; int it0; p0_locate_b(args, 2 * blk, j0, it0); f32x4 v0[16]; cv_load(j0, it0 >> 1, lane, v0); cv_store(j0, it0 >> 1, lane, v0); } SEAM(8); }
    }
    if (IN(9)) { const unsigned pbp_ = pb_begin(109);
        if (cvon && !cvfirst) cv_range(args, gw, len_up, len_all, lane);
        moe_table(moetab, ctl + CW_ECNT);
        pg8::Gemm g{(const bf16*)(ws + WS_X1Q), (const bf16*)(ws + WS_WUPT), D / 2, (size_t)2 * DFF * D / 2, (const int*)(ws + WS_ROWTOK)};
        MoeSched S{moetab, 2 * DFF / 256, G, bx};
        EpiUp E{(unsigned char*)(ws + WS_ACT), (const float*)(ws + WS_BUPP)};
        pg8::gemm_phase<EpiUp, MoeSched, true, true, true>(lds + RING_OFF, g, S, E);
        if (cvon && cvfirst) cv_range(args, gw, len_up, len_all, lane);
        pb_end(109, pbp_); SEAM(9);
    }
    if (IN(10)) { const unsigned pbp_ = pb_begin(110);
        moe_table(moetab, ctl + CW_ECNT);
        pg8::Gemm g{(const bf16*)(ws + WS_ACT), (const bf16*)(ws + WS_WDNT), DFF / 2, (size_t)D * DFF / 2, nullptr};
        MoeSched S{moetab, D / 256, G, bx};
        EpiDown E{(unsigned char*)(ws + WS_Y), args.b_down, (const float*)(ws + WS_ROWG)};
        pg8::gemm_phase<EpiDown, MoeSched, false, true, true>(lds + RING_OFF, g, S, E);
        pb_end(110, pbp_); SEAM(10);
    }
    if (IN(11)) { const unsigned pbp_ = pb_begin(111); moe_table(moetab, ctl + CW_ECNT); p9_ln2(args, lds, moetab, gw, NGW, lane); pb_end(111, pbp_); SEAM(11); }
    if (IN(12)) { const unsigned pbp_ = pb_begin(112);
        pg8::Gemm g{(const bf16*)(ws + WS_X2Q), (const bf16*)(ws + WS_WGT), D / 2, 0, nullptr}; DenseSched S; S.init(M, D, G, bx);
        EpiOut E{args.out, args.b_ple_gate, (const bf16*)(ws + WS_PLEB), (const bf16*)(ws + WS_X2B)};
        pg8::gemm_phase<EpiOut, DenseSched, false, true, true>(lds + RING_OFF, g, S, E);
        pb_end(112, pbp_);
    }
#undef IN
#undef SEAM
}

#ifndef N_LAUNCHES
#define N_LAUNCHES 1
#endif
extern "C" void kernel_launch(void* const* d_in, const int* in_sizes, int n_in, void* d_out, int out_size, void* d_ws, size_t ws_size, hipStream_t stream) {
    static int grid = 0;
    if (grid == 0) {
        if (n_in != 19 || in_sizes[0] != M * D || out_size != M * D || ws_size < WS_END) { fprintf(stderr, "kernel_launch: unexpected shapes: n_in %d in0 %d out %d ws %zu (need %zu)\n", n_in, n_in > 0 ? in_sizes[0] : -1, out_size, ws_size, (size_t)WS_END); grid = -1; return; }
        int dev = 0, cus = 0, per_cu = 0;
        if (hipGetDevice(&dev) != hipSuccess || hipDeviceGetAttribute(&cus, hipDeviceAttributeMultiprocessorCount, dev) != hipSuccess) { grid = -1; return; }
        if (hipFuncSetAttribute((const void*)fwd_kernel, hipFuncAttributeMaxDynamicSharedMemorySize, LDS_BYTES) != hipSuccess) { fprintf(stderr, "kernel_launch: hipFuncSetAttribute failed\n"); grid = -1; return; }
        if (hipOccupancyMaxActiveBlocksPerMultiprocessor(&per_cu, (const void*)fwd_kernel, 512, LDS_BYTES) != hipSuccess || per_cu < 1) fprintf(stderr, "kernel_launch: occupancy query says %d\n", per_cu);
        (void)hipGetLastError();
        grid = cus;
    }
    if (grid < 0) return;
    if (hipMemsetAsync((char*)d_ws + WS_CTL, 0, CTL_ZERO_BYTES, stream) != hipSuccess) { fprintf(stderr, "kernel_launch: memset failed\n"); return; }
    Args a{};
    a.x = (const float*)d_in[0]; a.p = (const float*)d_in[1]; a.w_in = (const float*)d_in[2]; a.norm_sb = (const float*)d_in[3]; a.norm_moba = (const float*)d_in[4];
    a.w_out = (const float*)d_in[5]; a.ln1_g = (const float*)d_in[6]; a.ln1_b = (const float*)d_in[7]; a.w_router = (const float*)d_in[8]; a.b_router = (const float*)d_in[9];
    a.w_up = (const float*)d_in[10]; a.b_up = (const float*)d_in[11]; a.w_down = (const float*)d_in[12]; a.b_down = (const float*)d_in[13]; a.ln2_g = (const float*)d_in[14]; a.ln2_b = (const float*)d_in[15];
    a.w_ple = (const float*)d_in[16]; a.w_ple_gate = (const float*)d_in[17]; a.b_ple_gate = (const float*)d_in[18];
    a.out = (float*)d_out; a.ws = (unsigned char*)d_ws;
    if (N_LAUNCHES == 1) { a.ph_lo = 0; a.ph_hi = NPHASE; hipLaunchKernelGGL(fwd_kernel, dim3(grid), dim3(512), LDS_BYTES, stream, a); }
    else for (int li = 0; li < NPHASE; ++li) { a.ph_lo = li; a.ph_hi = li + 1; hipLaunchKernelGGL(fwd_kernel, dim3(grid), dim3(512), LDS_BYTES, stream, a); }
    const hipError_t le = hipPeekAtLastError();
    if (le != hipSuccess) fprintf(stderr, "kernel_launch: launch failed: %s\n", hipGetErrorName(le));
}
```

```cpp
#include <hip/hip_runtime.h>
#include <cstdio>
#include <cstdint>
#include <cmath>

#define GAS __attribute__((address_space(1)))
#define LAS __attribute__((address_space(3)))
typedef unsigned short bf16;
typedef unsigned short bf16_t;
typedef short bf16x8 __attribute__((ext_vector_type(8)));
typedef float f32x4 __attribute__((ext_vector_type(4)));
typedef float f32x2 __attribute__((ext_vector_type(2)));
typedef float f32x16 __attribute__((ext_vector_type(16)));
typedef unsigned u32x4 __attribute__((ext_vector_type(4)));
typedef unsigned u32x2 __attribute__((ext_vector_type(2)));
typedef GAS unsigned gu32;
#define RLX_AGENT __ATOMIC_RELAXED, __HIP_MEMORY_SCOPE_AGENT
#define LDS_WAIT() asm volatile("s_waitcnt lgkmcnt(0)" ::: "memory")
#define VM_WAIT() asm volatile("s_waitcnt vmcnt(0)" ::: "memory")

#ifndef PROBE_ID
#define PROBE_ID 0
#endif
__device__ __forceinline__ unsigned pb_begin(int id) { return (PROBE_ID == id) ? (unsigned)__builtin_amdgcn_readfirstlane((int)(unsigned)__builtin_amdgcn_s_memrealtime()) : 0u; }
__device__ __forceinline__ void pb_end(int id, unsigned t0) {
    if (PROBE_ID == id) { const unsigned t1 = (unsigned)__builtin_amdgcn_s_memrealtime(), dt = t1 - t0; while ((unsigned)__builtin_amdgcn_s_memrealtime() - t1 < dt) __builtin_amdgcn_s_sleep(8); }
}
constexpr int BATCH = 2, SEQ = 8192, M = BATCH * SEQ, D = 2048, NQKV = 6144, HD = 128, NH = 8, NE = 32, TOPK = 4, DFF = 2048, PLE = 256;
constexpr int ECAP = 16384;
constexpr int ACT_ROWS = M * TOPK + NE * 256;
constexpr float LN_EPS = 1e-5f, RMS_EPS = 1e-6f;
constexpr float DN_ALPHA = 1.189207115002721f;
constexpr float LOG2E = 1.4426950408889634f;
constexpr float QSCALE = 0.08838834764831845f * LOG2E;
constexpr float SWIGLU_LIMIT = 7.0f, SWIGLU_ALPHA = 1.702f;
constexpr float YSCALE = 64.f;
constexpr float WSCALE = 512.f, XSCALE = 16.f, ASCALE = 8.f, UP_DESCALE = 1.f / (512.f * 16.f), DN_DESCALE = 1.f / (512.f * 8.f);

constexpr size_t MiB = 1u << 20;
constexpr size_t WS_CTL = 0, CTL_ZERO_BYTES = 1 * MiB;
constexpr size_t WS_WINT = 2 * MiB, WS_WOUTT = 26 * MiB, WS_WGT = 34 * MiB, WS_WPLET = 42 * MiB, WS_BUPP = 43 * MiB, WS_KMEAN = 44 * MiB;
constexpr size_t WS_XB = 48 * MiB, WS_PB = 112 * MiB, WS_QKV = 128 * MiB, WS_MIXED = 320 * MiB, WS_H = 384 * MiB, WS_X1 = 512 * MiB, WS_X1B = 640 * MiB;
constexpr size_t WS_PLEB = 704 * MiB, WS_ROWTOK = 768 * MiB, WS_ROWG = 770 * MiB, WS_TOKSL = 772 * MiB, WS_X2B = 776 * MiB;
constexpr size_t WS_ACT = 840 * MiB, WS_Y = 1128 * MiB, WS_WUPT = 1416 * MiB, WS_WDNT = 1928 * MiB;
constexpr size_t WS_MLIST = 2184 * MiB, WS_MPO = 2200 * MiB, WS_MPML = 2328 * MiB, WS_X1Q = 2336 * MiB, WS_X2Q = 2368 * MiB, WS_END = 2400 * MiB;
static_assert((size_t)ACT_ROWS * DFF * 2 <= 288 * MiB, "act rows");
constexpr int CW_TMO = 0, CW_CODE = 1;
constexpr int CW_BAR = 4096;
constexpr int CW_MCNT = 32768;
constexpr int CW_DONE = 49152;
constexpr int CW_CUR = 53248;
constexpr int CW_ECNT = 16384;

constexpr int RING_OFF = 0, RING_BYTES = 131072;
constexpr int LDSCTL_OFF = 135168;
constexpr int MISC_OFF = LDSCTL_OFF;
constexpr int MOE_OFF = LDSCTL_OFF + 256;
constexpr int LDS_BYTES = 163840;

__device__ __forceinline__ unsigned f2bf(float f) { unsigned u = __builtin_bit_cast(unsigned, f); return (u + 0x7fffu + ((u >> 16) & 1u)) >> 16; }
__device__ __forceinline__ unsigned pk2(float lo, float hi) { unsigned r; asm("v_cvt_pk_bf16_f32 %0, %1, %2" : "=v"(r) : "v"(lo), "v"(hi)); return r; }
__device__ __forceinline__ float bf_lo(unsigned w) { return __builtin_bit_cast(float, w << 16); }
__device__ __forceinline__ float bf_hi(unsigned w) { return __builtin_bit_cast(float, w & 0xffff0000u); }

__device__ __forceinline__ float clamp448(float v) { return __builtin_amdgcn_fmed3f(v, -448.f, 448.f); }
__device__ __forceinline__ unsigned pack_fp8x4(float a, float b, float c, float d) {
    unsigned w = 0; w = __builtin_amdgcn_cvt_pk_fp8_f32(clamp448(a), clamp448(b), w, false); w = __builtin_amdgcn_cvt_pk_fp8_f32(clamp448(c), clamp448(d), w, true); return w;
}

__device__ __forceinline__ unsigned pack_fp8x4_nc(float a, float b, float c, float d) {
    unsigned w = 0; w = __builtin_amdgcn_cvt_pk_fp8_f32(a, b, w, false); w = __builtin_amdgcn_cvt_pk_fp8_f32(c, d, w, true); return w;
}

namespace pg8 {
constexpr bool DMA_IN_MMA = false;
constexpr bool BAL_DMA = true;
constexpr int BM = 256, BK = 64, HALF = 128, HTB = HALF * BK * 2, STAGE_BYTES = 8 * HTB;
__host__ __device__ __forceinline__ int lds_byte(int r, int c) { const int st = (r >> 4) * 2 + (c >> 5), rr = r & 15, cc = c & 31, ob = rr * 64 + cc * 2; return st * 1024 + (ob ^ (((ob >> 9) & 1) << 5)); }
__host__ __device__ __forceinline__ void stage_rc(int b, int& R, int& C) { const int st = b / 1024, sb = b % 1024, swz = sb ^ (((sb >> 9) & 1) << 5); R = (st >> 1) * 16 + swz / 64; C = (st & 1) * 32 + (swz % 64) / 2; }
__host__ __device__ __forceinline__ int q_f(int r) { return ((r >> 1) & 1) | (((r >> 3) & 1) << 2); }
__host__ __device__ __forceinline__ int lds_byte_q(int r, int c16) { return r * 128 + 16 * (c16 ^ q_f(r & 15)); }
__host__ __device__ __forceinline__ void stage_rc_q(int b, int& R, int& C) { const int s = b >> 4; R = s >> 3; C = 8 * ((s & 7) ^ q_f(R & 15)); }
__host__ __device__ __forceinline__ int perm32(int rho) { const int n = rho >> 4, i = rho & 15; return 8 * (i >> 2) + 4 * n + (i & 3); }

struct Unit { int pm, pn, e, tab, cnt; };
struct Gemm { const bf16_t* A; const bf16_t* Bt; int K; size_t bstride; const int* rowtab; };

__device__ __forceinline__ unsigned cvt_pk_bf16(float lo, float hi) { unsigned r; asm volatile("v_cvt_pk_bf16_f32 %0, %1, %2" : "=v"(r) : "v"(lo), "v"(hi)); return r; }

typedef int v8i __attribute__((ext_vector_type(8)));
typedef int v8i_u __attribute__((ext_vector_type(8), aligned(16)));
template <class Epi, class Sched, bool GATHER, bool ALIGN_EPI, bool FP8 = false>
__device__ __forceinline__ void gemm_phase(LAS unsigned char* lds, const Gemm g, const Sched& S, const Epi& E) {
    const int tid = threadIdx.x, wid = __builtin_amdgcn_readfirstlane(tid >> 6), lane = tid & 63, wr = wid >> 2, wc = wid & 3, fr = lane & 15, fq = lane >> 4;
    const int K = g.K, nt = K / BK;
    unsigned voffA[2], voffB[2]; int RA[2], CA[2];
#pragma unroll
    for (int i = 0; i < 2; ++i) { int R, C; if constexpr (FP8) stage_rc_q(tid * 16 + i * 8192, R, C); else stage_rc(tid * 16 + i * 8192, R, C); const int Rb = Epi::PERM ? ((R & ~31) + perm32(R & 31)) : R;
        voffA[i] = (unsigned)(R * K + C) * 2u; voffB[i] = (unsigned)(Rb * K + C) * 2u; RA[i] = R; CA[i] = C; }
    const size_t kstep = (size_t)(BK * 2);
    const size_t hstep = (size_t)HALF * K * 2;
    const size_t tstep = 2 * hstep;
    const unsigned ldsw = (unsigned)wid * 1024u;
    const int aoff = lds_byte(wr * 64 + fr, fq * 8), boff = lds_byte(wc * 32 + fr, fq * 8);
    const int aoq0 = lds_byte_q(wr * 64 + fr, 2 * fq), aoq1 = lds_byte_q(wr * 64 + fr, 2 * fq + 1), boq0 = lds_byte_q(wc * 32 + fr, 2 * fq), boq1 = lds_byte_q(wc * 32 + fr, 2 * fq + 1);
#define PG8_SA(b, h) (((b) * 2 + (h)) * HTB)
#define PG8_SB(b, h) ((4 + (b) * 2 + (h)) * HTB)
#define PG8_STAGE(bufoff, gbase, voff) do { _Pragma("unroll") for (int _i = 0; _i < 2; ++_i) { unsigned keep_; \
        asm volatile("s_mov_b32 %0, m0\n\ts_mov_b32 m0, %3\n\ts_nop 0\n\tglobal_load_lds_dwordx4 %1, %2\n\ts_mov_b32 m0, %0" \
            : "=&s"(keep_) : "v"((voff)[_i]), "s"((const char*)(gbase)), "s"((unsigned)(uintptr_t)(lds + (bufoff) + _i * 8192) + ldsw) : "memory"); } } while (0)
#define PG8_LDQ(dst, base, o0, o1) do { const u32x4 lo_ = *(const LAS u32x4*)(lds + (base) + (o0)), hi_ = *(const LAS u32x4*)(lds + (base) + (o1)); \
        dst = (v8i){(int)lo_.x, (int)lo_.y, (int)lo_.z, (int)lo_.w, (int)hi_.x, (int)hi_.y, (int)hi_.z, (int)hi_.w}; } while (0)
#define PG8_LDA(dst, b, h) do { if constexpr (FP8) { _Pragma("unroll") for (int m = 0; m < 4; ++m) PG8_LDQ(dst##q[m], PG8_SA(b, h) + m * 2048, aoq0, aoq1); } \
        else { _Pragma("unroll") for (int m = 0; m < 4; ++m) _Pragma("unroll") for (int k = 0; k < 2; ++k) dst[m][k] = *(const LAS bf16x8*)(lds + PG8_SA(b, h) + aoff + m * 2048 + k * 1024); } } while (0)
#define PG8_LDB(dst, b, h) do { if constexpr (FP8) { _Pragma("unroll") for (int n = 0; n < 2; ++n) PG8_LDQ(dst##q[n], PG8_SB(b, h) + n * 2048, boq0, boq1); } \
        else { _Pragma("unroll") for (int n = 0; n < 2; ++n) _Pragma("unroll") for (int k = 0; k < 2; ++k) dst[n][k] = *(const LAS bf16x8*)(lds + PG8_SB(b, h) + boff + n * 2048 + k * 1024); } } while (0)
#define PG8_MMA(ai, bj, At, Bt) do { __builtin_amdgcn_s_setprio(1); if constexpr (FP8) { _Pragma("unroll") for (int m = 0; m < 4; ++m) _Pragma("unroll") for (int n = 0; n < 2; ++n) \
            asm volatile("v_mfma_scale_f32_16x16x128_f8f6f4 %0, %1, %2, %0, %3, %3 op_sel_hi:[0,0,0]" : "+v"(acc[ai][bj][m][n]) : "v"(Bt##q[n]), "v"(At##q[m]), "v"(one_scale)); } \
        else { _Pragma("unroll") for (int m = 0; m < 4; ++m) _Pragma("unroll") for (int n = 0; n < 2; ++n) _Pragma("unroll") for (int k = 0; k < 2; ++k) \
            acc[ai][bj][m][n] = __builtin_amdgcn_mfma_f32_16x16x32_bf16(Bt[n][k], At[m][k], acc[ai][bj][m][n], 0, 0, 0); } __builtin_amdgcn_s_setprio(0); } while (0)
#define PG8_WAIT_V(n) asm volatile("s_waitcnt vmcnt(" #n ")" ::: "memory")
#define PG8_WAIT_L(n) asm volatile("s_waitcnt lgkmcnt(" #n ")" ::: "memory")
#define PG8_BAR __builtin_amdgcn_s_barrier()
#define PG8_SCHED __builtin_amdgcn_sched_barrier(0)
    const int one_scale = 0x7f7f7f7f;
    Unit cur, nxt; int ui = 0;
    if (!S.next(0, cur)) return;
    f32x4 acc[2][2][4][2];
#pragma unroll
    for (int a = 0; a < 2; ++a)
#pragma unroll
        for (int b = 0; b < 2; ++b)
#pragma unroll
            for (int m = 0; m < 4; ++m)
#pragma unroll
                for (int n = 0; n < 2; ++n) acc[a][b][m][n] = (f32x4){0.f, 0.f, 0.f, 0.f};
    bf16x8 At[4][2], B0[2][2], B1[2][2]; v8i Atq[4], B0q[2], B1q[2];
    unsigned voA[2][2], voN[2][2];
    const char* cA; const char* cB;
#define PG8_UNIT_PTRS(u, pa, pb, vo) do { \
        pb = (const char*)g.Bt + ((size_t)(u).e * g.bstride) * 2 + (size_t)(u).pn * tstep; \
        if constexpr (GATHER) { pa = (const char*)g.A; \
            _Pragma("unroll") for (int h = 0; h < 2; ++h) _Pragma("unroll") for (int i = 0; i < 2; ++i) { const int r = h * HALF + RA[i]; int tok = 0; if (r < (u).cnt) tok = g.rowtab[(u).tab + r]; \
                vo[h][i] = (unsigned)tok * (unsigned)(K * 2) + (unsigned)(CA[i] * 2); } \
        } else { pa = (const char*)g.A + (size_t)(u).pm * tstep; \
            _Pragma("unroll") for (int h = 0; h < 2; ++h) _Pragma("unroll") for (int i = 0; i < 2; ++i) vo[h][i] = voffA[i] + (unsigned)(h * hstep); } } while (0)
    PG8_UNIT_PTRS(cur, cA, cB, voA);
    PG8_STAGE(PG8_SB(0, 0), cB, voffB); PG8_STAGE(PG8_SB(0, 1), cB + hstep, voffB); PG8_STAGE(PG8_SA(0, 0), cA, voA[0]); PG8_STAGE(PG8_SA(0, 1), cA, voA[1]);
    if (wr == 1) PG8_BAR;
    PG8_WAIT_V(2); PG8_BAR;
    if constexpr (BAL_DMA) { PG8_STAGE(PG8_SB(1, 0), cB + kstep, voffB); PG8_STAGE(PG8_SB(1, 1), cB + hstep + kstep, voffB); PG8_WAIT_V(4); PG8_BAR; }
    else { PG8_STAGE(PG8_SB(1, 0), cB + kstep, voffB); PG8_STAGE(PG8_SA(1, 0), cA + kstep, voA[0]); PG8_STAGE(PG8_SB(1, 1), cB + hstep + kstep, voffB); PG8_WAIT_V(6); PG8_BAR; }
    for (;;) {
        const bool has_next = S.next(ui + 1, nxt);
        const char* nA = cA; const char* nB = cB;
#pragma unroll
        for (int h = 0; h < 2; ++h)
#pragma unroll
            for (int i = 0; i < 2; ++i) voN[h][i] = voA[h][i];
        if (has_next) PG8_UNIT_PTRS(nxt, nA, nB, voN);
        for (int t = 0; t < nt; t += 2) {
            const bool last = (t == nt - 2);
            const char* a1 = cA + (size_t)(t + 1) * kstep;
            const char* a2 = last ? nA : cA + (size_t)(t + 2) * kstep; const char* b2 = last ? nB : cB + (size_t)(t + 2) * kstep;
            const char* a3 = a2 + kstep; const char* b3 = b2 + kstep;
            unsigned vo2[2][2];
#pragma unroll
            for (int h = 0; h < 2; ++h)
#pragma unroll
                for (int i = 0; i < 2; ++i) vo2[h][i] = last ? voN[h][i] : voA[h][i];
            if constexpr (BAL_DMA) {
            PG8_LDB(B0, 0, 0); PG8_LDB(B1, 0, 1); PG8_SCHED; PG8_LDA(At, 0, 0); PG8_STAGE(PG8_SA(1, 0), a1, voA[0]); PG8_STAGE(PG8_SA(1, 1), a1, voA[1]);
            PG8_WAIT_V(8); PG8_WAIT_L(0); PG8_BAR; PG8_MMA(0, 0, At, B0); PG8_MMA(0, 1, At, B1); PG8_BAR; PG8_SCHED;
            PG8_LDA(At, 0, 1); PG8_STAGE(PG8_SB(0, 0), b2, voffB); PG8_STAGE(PG8_SB(0, 1), b2 + hstep, voffB);
            PG8_WAIT_V(6); PG8_WAIT_L(0); PG8_BAR; PG8_MMA(1, 0, At, B0); PG8_MMA(1, 1, At, B1); PG8_BAR; PG8_SCHED;
            PG8_LDB(B0, 1, 0); PG8_LDB(B1, 1, 1); PG8_SCHED; PG8_LDA(At, 1, 0); PG8_STAGE(PG8_SA(0, 0), a2, vo2[0]); PG8_STAGE(PG8_SA(0, 1), a2, vo2[1]);
            PG8_WAIT_V(8); PG8_WAIT_L(0); PG8_BAR; PG8_MMA(0, 0, At, B0); PG8_MMA(0, 1, At, B1); PG8_BAR; PG8_SCHED;
            PG8_LDA(At, 1, 1); PG8_STAGE(PG8_SB(1, 0), b3, voffB); PG8_STAGE(PG8_SB(1, 1), b3 + hstep, voffB);
            PG8_WAIT_V(6); PG8_WAIT_L(0); PG8_BAR; PG8_MMA(1, 0, At, B0); PG8_MMA(1, 1, At, B1); PG8_BAR; PG8_SCHED;
            } else if constexpr (DMA_IN_MMA) {
            PG8_LDB(B0, 0, 0); PG8_LDB(B1, 0, 1); PG8_SCHED; PG8_LDA(At, 0, 0);
            PG8_WAIT_V(6); PG8_WAIT_L(0); PG8_BAR; PG8_MMA(0, 0, At, B0); PG8_SCHED; PG8_STAGE(PG8_SA(1, 1), a1, voA[1]); PG8_SCHED; PG8_MMA(0, 1, At, B1); PG8_BAR; PG8_SCHED;
            PG8_LDA(At, 0, 1);
            PG8_WAIT_V(2); PG8_WAIT_L(0); PG8_BAR; PG8_MMA(1, 0, At, B0); PG8_SCHED; PG8_STAGE(PG8_SB(0, 0), b2, voffB); PG8_STAGE(PG8_SB(0, 1), b2 + hstep, voffB); PG8_SCHED;
            PG8_MMA(1, 1, At, B1); PG8_SCHED; PG8_STAGE(PG8_SA(0, 0), a2, vo2[0]); PG8_BAR; PG8_SCHED;
            PG8_LDB(B0, 1, 0); PG8_LDB(B1, 1, 1); PG8_SCHED; PG8_LDA(At, 1, 0);
            PG8_WAIT_V(6); PG8_WAIT_L(0); PG8_BAR; PG8_MMA(0, 0, At, B0); PG8_SCHED; PG8_STAGE(PG8_SA(0, 1), a2, vo2[1]); PG8_SCHED; PG8_MMA(0, 1, At, B1); PG8_BAR; PG8_SCHED;
            PG8_LDA(At, 1, 1);
            PG8_WAIT_V(2); PG8_WAIT_L(0); PG8_BAR; PG8_MMA(1, 0, At, B0); PG8_SCHED; PG8_STAGE(PG8_SB(1, 0), b3, voffB); PG8_STAGE(PG8_SB(1, 1), b3 + hstep, voffB); PG8_SCHED;
            PG8_MMA(1, 1, At, B1); PG8_SCHED; PG8_STAGE(PG8_SA(1, 0), a3, vo2[0]); PG8_BAR; PG8_SCHED;
            } else {
            PG8_LDB(B0, 0, 0); PG8_LDB(B1, 0, 1); PG8_SCHED; PG8_LDA(At, 0, 0); PG8_STAGE(PG8_SA(1, 1), a1, voA[1]);
            PG8_WAIT_V(8); PG8_WAIT_L(0); PG8_BAR; PG8_MMA(0, 0, At, B0); PG8_MMA(0, 1, At, B1); PG8_BAR; PG8_SCHED;
            PG8_LDA(At, 0, 1); PG8_STAGE(PG8_SB(0, 0), b2, voffB); PG8_STAGE(PG8_SB(0, 1), b2 + hstep, voffB); PG8_STAGE(PG8_SA(0, 0), a2, vo2[0]);
            PG8_WAIT_V(8); PG8_WAIT_L(0); PG8_BAR; PG8_MMA(1, 0, At, B0); PG8_MMA(1, 1, At, B1); PG8_BAR; PG8_SCHED;
            PG8_LDB(B0, 1, 0); PG8_LDB(B1, 1, 1); PG8_SCHED; PG8_LDA(At, 1, 0); PG8_STAGE(PG8_SA(0, 1), a2, vo2[1]);
            PG8_WAIT_V(8); PG8_WAIT_L(0); PG8_BAR; PG8_MMA(0, 0, At, B0); PG8_MMA(0, 1, At, B1); PG8_BAR; PG8_SCHED;
            PG8_LDA(At, 1, 1); PG8_STAGE(PG8_SB(1, 0), b3, voffB); PG8_STAGE(PG8_SB(1, 1), b3 + hstep, voffB); PG8_STAGE(PG8_SA(1, 0), a3, vo2[0]);
            PG8_WAIT_V(8); PG8_WAIT_L(0); PG8_BAR; PG8_MMA(1, 0, At, B0); PG8_MMA(1, 1, At, B1); PG8_BAR; PG8_SCHED;
            }
        }
        if constexpr (FP8) asm volatile("s_nop 15\n\ts_nop 15" ::: "memory");
        if constexpr (ALIGN_EPI) { if (wr == 0) PG8_BAR; }
        E(acc, cur, wr, wc, fr, fq);
        if (!has_next) break;
#pragma unroll
        for (int a = 0; a < 2; ++a)
#pragma unroll
            for (int b = 0; b < 2; ++b)
#pragma unroll
                for (int m = 0; m < 4; ++m)
#pragma unroll
                    for (int n = 0; n < 2; ++n) acc[a][b][m][n] = (f32x4){0.f, 0.f, 0.f, 0.f};
        cur = nxt; cA = nA; cB = nB; ++ui;
#pragma unroll
        for (int h = 0; h < 2; ++h)
#pragma unroll
            for (int i = 0; i < 2; ++i) voA[h][i] = voN[h][i];
        if constexpr (ALIGN_EPI) { if (wr == 1) PG8_BAR; }
    }
    PG8_WAIT_V(0);
    if constexpr (!ALIGN_EPI) { if (wr == 0) PG8_BAR; }
    PG8_BAR;
#undef PG8_UNIT_PTRS
#undef PG8_SA
#undef PG8_SB
#undef PG8_STAGE
#undef PG8_LDA
#undef PG8_LDQ
#undef PG8_LDB
#undef PG8_MMA
#undef PG8_WAIT_V
#undef PG8_WAIT_L
#undef PG8_BAR
#undef PG8_SCHED
}
}

#define XB_TMO      128
#define XB_XCNT(j)  (256  + 64 * (j))
#define XB_XSUB(j)  (1280 + 64 * (j))
#define XB_XGEN(j)  (2304 + 64 * (j))
#define XB_TOP      3328
#define XB_TOPGEN   3392
#define XCD_BAR_WORDS 3456
#define XB_SPIN_CAP (1u << 18)

__device__ __forceinline__ unsigned xb_ld(unsigned* p)              { return __hip_atomic_load(p, __ATOMIC_RELAXED, __HIP_MEMORY_SCOPE_AGENT); }
__device__ __forceinline__ unsigned xb_add(unsigned* p, unsigned v) { return __hip_atomic_fetch_add(p, v, __ATOMIC_RELAXED, __HIP_MEMORY_SCOPE_AGENT); }
__device__ __forceinline__ unsigned xb_xcc_id() { return (unsigned)__builtin_amdgcn_s_getreg((3 << 11) | 20) & 0xFu; }
#define XB_SPIN(cond, bar) do { unsigned _sp = 0; while (cond) { __builtin_amdgcn_s_sleep(1); \
    if ((++_sp & 255u) == 0u) { if (xb_ld(&(bar)[XB_TMO])) break; if (_sp > XB_SPIN_CAP) { atomicAdd(&(bar)[XB_TMO], 1u); break; } } } } while (0)

struct XcdBarrier {
    unsigned* bar; unsigned x;
    volatile LAS unsigned* st;
};

__device__ __forceinline__ XcdBarrier xcd_barrier_post(unsigned* bar, volatile LAS unsigned* st) {
    XcdBarrier b; b.bar = bar; b.x = xb_xcc_id(); b.st = st;
    if (threadIdx.x == 0) (void)xb_add(&bar[XB_XCNT(b.x)], 1u);
    return b;
}
__device__ __forceinline__ void xcd_barrier_complete(unsigned* bar, unsigned x, unsigned& nloc, unsigned& nx) {
    const unsigned G = gridDim.x * gridDim.y * gridDim.z;
    unsigned sum, cnt, mine, sp = 0u;
    for (;;) {
        sum = 0u; cnt = 0u; mine = 0u;
#pragma unroll
        for (unsigned j = 0; j < 16; ++j) { const unsigned c = xb_ld(&bar[XB_XCNT(j)]); sum += c; cnt += (c > 0u) ? 1u : 0u; mine = (j == x) ? c : mine; }
        if (sum == G) break;
        __builtin_amdgcn_s_sleep(1);
        if ((++sp & 255u) == 0u) { if (xb_ld(&bar[XB_TMO])) break; if (sp > XB_SPIN_CAP) { atomicAdd(&bar[XB_TMO], 1u); break; } }
    }
    nloc = mine > 0u ? mine : 1u; nx = cnt > 0u ? cnt : 1u;
}

__device__ __forceinline__ void xcd_barrier(const XcdBarrier& b) {
    asm volatile("s_waitcnt vmcnt(0)" ::: "memory");
    __syncthreads();
    if (threadIdx.x == 0) {
        unsigned* bar = b.bar;
        __builtin_amdgcn_s_waitcnt(0);
        unsigned nloc = b.st[0], nx = b.st[1];
        if (nloc == 0u) { xcd_barrier_complete(bar, b.x, nloc, nx); b.st[0] = nloc; b.st[1] = nx; }
        const unsigned old = xb_add(&bar[XB_XSUB(b.x)], 1u);
        const unsigned gen = old / nloc;
        if (old + 1u == (gen + 1u) * nloc) {
            __builtin_amdgcn_fence(__ATOMIC_RELEASE, "agent");
            asm volatile("s_waitcnt vmcnt(0)" ::: "memory");
            const unsigned og = xb_add(&bar[XB_TOP], 1u);
            const unsigned tg = og / nx;
            if (og + 1u == (tg + 1u) * nx) xb_add(&bar[XB_TOPGEN], 1u);
            else XB_SPIN(xb_ld(&bar[XB_TOPGEN]) == tg, bar);
            __builtin_amdgcn_fence(__ATOMIC_ACQUIRE, "agent");
            xb_add(&bar[XB_XGEN(b.x)], 1u);
            asm volatile("s_waitcnt vmcnt(0)" ::: "memory");
        } else {
            XB_SPIN(xb_ld(&bar[XB_XGEN(b.x)]) == gen, bar);
            __builtin_amdgcn_fence(__ATOMIC_ACQUIRE, "agent");
            asm volatile("s_waitcnt vmcnt(0)" ::: "memory");
        }
    }
    __syncthreads();
}

struct Args {
    const float* x; const float* p; const float* w_in; const float* norm_sb; const float* norm_moba; const float* w_out; const float* ln1_g; const float* ln1_b;
    const float* w_router; const float* b_router; const float* w_up; const float* b_up; const float* w_down; const float* b_down; const float* ln2_g; const float* ln2_b;
    const float* w_ple; const float* w_ple_gate; const float* b_ple_gate;
    float* out; unsigned char* ws; int ph_lo, ph_hi;
};

__device__ __forceinline__ float wave_sum(float v) {
#pragma unroll
    for (int o = 1; o < 64; o <<= 1) v += __shfl_xor(v, o);
    return v;
}
template <int CTRL> __device__ __forceinline__ float dppmov(float v) { return __builtin_bit_cast(float, __builtin_amdgcn_update_dpp(0, __builtin_bit_cast(int, v), CTRL, 0xF, 0xF, true)); }
__device__ __forceinline__ float reduce16(float v) { v += dppmov<0xB1>(v); v += dppmov<0x4E>(v); v += dppmov<0x141>(v); v += dppmov<0x140>(v); return v; }

struct DenseSched {
    int nM, nN, nwg, G, c;
    __device__ void init(int Mrows, int N, int G_, int c_) { nM = Mrows / 256; nN = N / 256; nwg = nM * nN; G = G_; c = c_; }
    __device__ __forceinline__ bool next(int i, pg8::Unit& u) const {
        const long L = (long)i * G + c; if (L >= nwg) return false;
        int wgid = (int)L; { const int q = nwg / 8, r = nwg % 8, xcd = wgid % 8, off = wgid / 8; wgid = (xcd < r ? xcd * (q + 1) : r * (q + 1) + (xcd - r) * q) + off; }
        const int nig = 8 * nN, gid = wgid / nig, fm = gid * 8, gsz = (nM - fm) < 8 ? (nM - fm) : 8;
        u.pm = fm + ((wgid % nig) % gsz); u.pn = (wgid % nig) / gsz; u.e = 0; u.tab = 0; u.cnt = 256; return true;
    }
};
struct MoeSched {
    const LAS int* tab; int NPN, G, c;
    __device__ __forceinline__ bool next(int i, pg8::Unit& u) const {
        int tt, pn;
        if (G == 256 && (NPN == 8 || NPN == 16)) {
            const int x = c & 7, s = c >> 3;
            if (NPN == 8) { tt = 32 * i + 8 * (x >> 1) + (s >> 2); pn = 4 * (x & 1) + (s & 3); }
            else { tt = 16 * i + 8 * (x >> 2) + (s >> 2); pn = 4 * (x & 3) + (s & 3); }
            if (tt >= tab[32]) return false;
        } else {
            const int total = tab[32] * NPN; const int L = i * G + c; if (L >= total) return false;
            tt = L / NPN; pn = L - tt * NPN;
        }
        int e = 0;
        for (int k = 1; k < 32; ++k) e += (tab[k] <= tt) ? 1 : 0;
        e = __builtin_amdgcn_readfirstlane(e);
        const int mt = tt - tab[e]; const int cnt = tab[33 + e] - mt * 256;
        u.pm = __builtin_amdgcn_readfirstlane(tt); u.pn = __builtin_amdgcn_readfirstlane(pn); u.e = e; u.tab = __builtin_amdgcn_readfirstlane(e * ECAP + mt * 256); u.cnt = __builtin_amdgcn_readfirstlane(cnt < 256 ? cnt : 256); return true;
    }
};
__device__ __forceinline__ void moe_table(LAS int* tab, const unsigned* ecnt_words) {
    if (threadIdx.x < 32) tab[33 + threadIdx.x] = (int)ecnt_words[32 * threadIdx.x];
    __syncthreads();
    if (threadIdx.x == 0) { int s = 0; for (int e = 0; e < 32; ++e) { tab[e] = s; s += (tab[33 + e] + 255) >> 8; } tab[32] = s; }
    __syncthreads();
}

using pg8::Unit; using pg8::cvt_pk_bf16;
struct EpiQKV {
    static constexpr bool PERM = true;
    bf16* O; int ldc; bool qscale; float* kmean;
    __device__ __forceinline__ void operator()(const f32x4 (&acc)[2][2][4][2], const Unit& u, int wr, int wc, int fr, int fq) const {
        asm volatile("" : "+v"(fr), "+v"(fq));
        const int row0 = u.pm * 256 + wr * 64 + fr, col0 = u.pn * 256 + wc * 32 + 8 * fq;
        const float sc = (qscale && (u.pn < 4 || (u.pn >= 12 && u.pn < 16))) ? QSCALE : 1.f;
#pragma unroll
        for (int ai = 0; ai < 2; ++ai)
#pragma unroll
            for (int m = 0; m < 4; ++m) { bf16* rowp = O + (size_t)(row0 + ai * 128 + m * 16) * ldc + col0;
#pragma unroll
                for (int bj = 0; bj < 2; ++bj) { const f32x4 v0 = acc[ai][bj][m][0] * sc, v1 = acc[ai][bj][m][1] * sc;
                    u32x4 w; w.x = cvt_pk_bf16(v0[0], v0[1]); w.y = cvt_pk_bf16(v0[2], v0[3]); w.z = cvt_pk_bf16(v1[0], v1[1]); w.w = cvt_pk_bf16(v1[2], v1[3]);
                    *(u32x4*)(rowp + bj * 128) = w; } }
        if (qscale && u.pn >= 16 && u.pn < 20) {
#pragma unroll
            for (int bj = 0; bj < 2; ++bj)
#pragma unroll
                for (int n = 0; n < 2; ++n) { f32x4 cs = {0.f, 0.f, 0.f, 0.f};
#pragma unroll
                    for (int ai = 0; ai < 2; ++ai)
#pragma unroll
                        for (int m = 0; m < 4; ++m) cs += acc[ai][bj][m][n];
#pragma unroll
                    for (int j = 0; j < 4; ++j) { const float t = reduce16(cs[j]) * (1.f / 256.f);
                        if (fr == 0) { const int kc = (u.pn - 16) * 256 + bj * 128 + wc * 32 + 8 * fq + 4 * n + j;
                            const int bb = u.pm >> 5, blk = u.pm & 31;
                            atomicAdd(kmean + ((size_t)((bb * 8 + (kc >> 7)) * 32 + blk)) * 128 + (kc & 127), t); } } }
        }
    }
};
struct EpiH {
    static constexpr bool PERM = true;
    const bf16* XB; bf16* Hh;
    __device__ __forceinline__ void operator()(const f32x4 (&acc)[2][2][4][2], const Unit& u, int wr, int wc, int fr, int fq) const {
        asm volatile("" : "+v"(fr), "+v"(fq));
        const int row0 = u.pm * 256 + wr * 64 + fr, col0 = u.pn * 256 + wc * 32 + 8 * fq;
        u32x4 xw[2][4][2];
#pragma unroll
        for (int ai = 0; ai < 2; ++ai)
#pragma unroll
            for (int m = 0; m < 4; ++m)
#pragma unroll
                for (int bj = 0; bj < 2; ++bj) xw[ai][m][bj] = *(const u32x4*)(XB + (size_t)(row0 + ai * 128 + m * 16) * D + col0 + bj * 128);
        asm volatile("" : "+v"(xw[0][0][0]), "+v"(xw[0][0][1]), "+v"(xw[0][1][0]), "+v"(xw[0][1][1]), "+v"(xw[0][2][0]), "+v"(xw[0][2][1]), "+v"(xw[0][3][0]), "+v"(xw[0][3][1]),
                          "+v"(xw[1][0][0]), "+v"(xw[1][0][1]), "+v"(xw[1][1][0]), "+v"(xw[1][1][1]), "+v"(xw[1][2][0]), "+v"(xw[1][2][1]), "+v"(xw[1][3][0]), "+v"(xw[1][3][1]));
#pragma unroll
        for (int ai = 0; ai < 2; ++ai)
#pragma unroll
            for (int m = 0; m < 4; ++m) { const size_t ro = (size_t)(row0 + ai * 128 + m * 16) * D + col0;
#pragma unroll
                for (int bj = 0; bj < 2; ++bj) { const u32x4 x4 = xw[ai][m][bj];
                    const f32x4 a0 = acc[ai][bj][m][0], a1 = acc[ai][bj][m][1]; u32x4 w;
                    w.x = cvt_pk_bf16(fmaf(bf_lo(x4.x), DN_ALPHA, a0[0]), fmaf(bf_hi(x4.x), DN_ALPHA, a0[1])); w.y = cvt_pk_bf16(fmaf(bf_lo(x4.y), DN_ALPHA, a0[2]), fmaf(bf_hi(x4.y), DN_ALPHA, a0[3]));
                    w.z = cvt_pk_bf16(fmaf(bf_lo(x4.z), DN_ALPHA, a1[0]), fmaf(bf_hi(x4.z), DN_ALPHA, a1[1])); w.w = cvt_pk_bf16(fmaf(bf_lo(x4.w), DN_ALPHA, a1[2]), fmaf(bf_hi(x4.w), DN_ALPHA, a1[3]));
                    *(u32x4*)(Hh + ro + bj * 128) = w; } }
    }
};
struct EpiUp {
    static constexpr bool PERM = true;
    unsigned char* ACT; const float* biasp;
    __device__ __forceinline__ void operator()(const f32x4 (&acc)[2][2][4][2], const Unit& u, int wr, int wc, int fr, int fq) const {
        asm volatile("" : "+v"(fr), "+v"(fq));
        const int row0 = u.pm * 256 + wr * 64 + fr, cw = wc * 32 + 8 * fq;
        const float* bp = biasp + (size_t)u.e * 4096 + u.pn * 256 + cw;
        f32x4 bg[2], bl[2];
#pragma unroll
        for (int n = 0; n < 2; ++n) { bg[n] = *(const f32x4*)(bp + 4 * n); bl[n] = *(const f32x4*)(bp + 128 + 4 * n); }
#pragma unroll
        for (int ai = 0; ai < 2; ++ai)
#pragma unroll
            for (int m = 0; m < 4; ++m) {
                float a[8];
#pragma unroll
                for (int n = 0; n < 2; ++n)
#pragma unroll
                    for (int j = 0; j < 4; ++j) {
                        const float g8 = fminf(fmaf(acc[ai][0][m][n][j], 8.f * UP_DESCALE, bg[n][j]), 8.f * SWIGLU_LIMIT);
                        const float l1 = __builtin_amdgcn_fmed3f(fmaf(acc[ai][1][m][n][j], UP_DESCALE, bl[n][j]), 1.f - SWIGLU_LIMIT, 1.f + SWIGLU_LIMIT);
                        const float sg = __builtin_amdgcn_rcpf(1.f + __builtin_amdgcn_exp2f(g8 * (-SWIGLU_ALPHA * LOG2E / 8.f)));
                        a[n * 4 + j] = g8 * sg * l1;
                    }
                u32x2 w; w.x = pack_fp8x4_nc(a[0], a[1], a[2], a[3]); w.y = pack_fp8x4_nc(a[4], a[5], a[6], a[7]);
                *(u32x2*)(ACT + (size_t)(row0 + ai * 128 + m * 16) * DFF + u.pn * 128 + cw) = w;
            }
    }
};
struct EpiDown {
    static constexpr bool PERM = true;
    unsigned char* Y; const float* bias; const float* rowg;
    __device__ __forceinline__ void operator()(const f32x4 (&acc)[2][2][4][2], const Unit& u, int wr, int wc, int fr, int fq) const {
        asm volatile("" : "+v"(fr), "+v"(fq));
        const int rl0 = wr * 64 + fr, col0 = u.pn * 256 + wc * 32 + 8 * fq;
        const float* bp = bias + (size_t)u.e * D + col0;
        f32x4 bv[2][2];
#pragma unroll
        for (int bj = 0; bj < 2; ++bj)
#pragma unroll
            for (int n = 0; n < 2; ++n) bv[bj][n] = *(const f32x4*)(bp + bj * 128 + 4 * n);
        float gtv[2][4];
#pragma unroll
        for (int ai = 0; ai < 2; ++ai)
#pragma unroll
            for (int m = 0; m < 4; ++m) { const int rl = rl0 + ai * 128 + m * 16; gtv[ai][m] = (rl < u.cnt) ? rowg[u.tab + rl] : 0.f; }
        asm volatile("" : "+v"(gtv[0][0]), "+v"(gtv[0][1]), "+v"(gtv[0][2]), "+v"(gtv[0][3]), "+v"(gtv[1][0]), "+v"(gtv[1][1]), "+v"(gtv[1][2]), "+v"(gtv[1][3]));
#pragma unroll
        for (int ai = 0; ai < 2; ++ai)
#pragma unroll
            for (int m = 0; m < 4; ++m) { const int rl = rl0 + ai * 128 + m * 16; const float gt = gtv[ai][m] * YSCALE;
                unsigned char* rowp = Y + (size_t)(u.pm * 256 + rl) * D + col0;
#pragma unroll
                for (int bj = 0; bj < 2; ++bj) { const f32x4 v0 = (acc[ai][bj][m][0] * DN_DESCALE + bv[bj][0]) * gt, v1 = (acc[ai][bj][m][1] * DN_DESCALE + bv[bj][1]) * gt;
                    u32x2 w; w.x = pack_fp8x4(v0[0], v0[1], v0[2], v0[3]); w.y = pack_fp8x4(v1[0], v1[1], v1[2], v1[3]);
                    *(u32x2*)(rowp + bj * 128) = w; } }
    }
};
struct EpiOut {
    static constexpr bool PERM = true;
    float* OUT; const float* bias; const bf16* PLEB; const bf16* X2B;
    __device__ __forceinline__ void operator()(const f32x4 (&acc)[2][2][4][2], const Unit& u, int wr, int wc, int fr, int fq) const {
        asm volatile("" : "+v"(fr), "+v"(fq));
        const int row0 = u.pm * 256 + wr * 64 + fr, col0 = u.pn * 256 + wc * 32 + 8 * fq;
        f32x4 bv[2][2];
#pragma unroll
        for (int bj = 0; bj < 2; ++bj)
#pragma unroll
            for (int n = 0; n < 2; ++n) bv[bj][n] = *(const f32x4*)(bias + col0 + bj * 128 + 4 * n);
#pragma unroll
        for (int ai = 0; ai < 2; ++ai) {
            u32x4 xw[4][2], pw[4][2];
#pragma unroll
            for (int m = 0; m < 4; ++m)
#pragma unroll
                for (int bj = 0; bj < 2; ++bj) { const size_t o = (size_t)(row0 + ai * 128 + m * 16) * D + col0 + bj * 128; xw[m][bj] = *(const u32x4*)(X2B + o); pw[m][bj] = *(const u32x4*)(PLEB + o); }
            asm volatile("" : "+v"(xw[0][0]), "+v"(xw[0][1]), "+v"(xw[1][0]), "+v"(xw[1][1]), "+v"(xw[2][0]), "+v"(xw[2][1]), "+v"(xw[3][0]), "+v"(xw[3][1]),
                              "+v"(pw[0][0]), "+v"(pw[0][1]), "+v"(pw[1][0]), "+v"(pw[1][1]), "+v"(pw[2][0]), "+v"(pw[2][1]), "+v"(pw[3][0]), "+v"(pw[3][1]));
#pragma unroll
            for (int m = 0; m < 4; ++m) { const size_t ro = (size_t)(row0 + ai * 128 + m * 16) * D + col0;
#pragma unroll
                for (int bj = 0; bj < 2; ++bj) { const size_t o = ro + bj * 128; const u32x4 x4 = xw[m][bj], p4 = pw[m][bj];
                    const float xv[8] = {bf_lo(x4.x), bf_hi(x4.x), bf_lo(x4.y), bf_hi(x4.y), bf_lo(x4.z), bf_hi(x4.z), bf_lo(x4.w), bf_hi(x4.w)};
                    const float pl[8] = {bf_lo(p4.x), bf_hi(p4.x), bf_lo(p4.y), bf_hi(p4.y), bf_lo(p4.z), bf_hi(p4.z), bf_lo(p4.w), bf_hi(p4.w)};
#pragma unroll
                    for (int n = 0; n < 2; ++n) { const f32x4 g = acc[ai][bj][m][n] * UP_DESCALE + bv[bj][n]; f32x4 r;
#pragma unroll
                        for (int j = 0; j < 4; ++j) r[j] = xv[4 * n + j] + __builtin_amdgcn_rcpf(1.f + __builtin_amdgcn_exp2f(-LOG2E * g[j])) * pl[4 * n + j];
                        *(f32x4*)(OUT + o + 4 * n) = r; } } }
        }
    }
};

struct P0Job { const float* W; void* WT; int K, N, mode; };
__device__ __forceinline__ void cv_load(const P0Job& j, int blk, int lane, f32x4 (&v)[16]) {
    const int nb64 = j.N >> 6, kb = blk / nb64, nbp = blk - kb * nb64;
    const float* p = j.W + (size_t)(64 * kb + 16 * (lane >> 4)) * j.N + 64 * nbp + 4 * (lane & 15);
#pragma unroll
    for (int i = 0; i < 16; ++i) v[i] = __builtin_nontemporal_load((const GAS f32x4*)(p + (size_t)i * j.N));
}
__device__ __forceinline__ void cv_store(const P0Job& j, int blk, int lane, const f32x4 (&v)[16]) {
    const int nb64 = j.N >> 6, kb = blk / nb64, nbp = blk - kb * nb64, K = j.K;
    const int kk = 64 * kb + 16 * (lane >> 4), nc = 64 * nbp + 4 * (lane & 15);
#pragma unroll
    for (int jj = 0; jj < 4; ++jj) {
        int nn = nc + jj; if (j.mode & 1) { const int a2 = nn >> 1, bj = nn & 1; nn = 256 * (a2 >> 7) + 128 * bj + (a2 & 127); }
        if (j.mode < 2) {
            u32x4 o0, o1;
            o0.x = pk2(v[0][jj], v[1][jj]); o0.y = pk2(v[2][jj], v[3][jj]); o0.z = pk2(v[4][jj], v[5][jj]); o0.w = pk2(v[6][jj], v[7][jj]);
            o1.x = pk2(v[8][jj], v[9][jj]); o1.y = pk2(v[10][jj], v[11][jj]); o1.z = pk2(v[12][jj], v[13][jj]); o1.w = pk2(v[14][jj], v[15][jj]);
            GAS u32x4* d = (GAS u32x4*)((bf16*)j.WT + (size_t)nn * K + kk);
            __builtin_nontemporal_store(o0, d); __builtin_nontemporal_store(o1, d + 1);
        } else {
            u32x4 o;
            o.x = pack_fp8x4(v[0][jj] * WSCALE, v[1][jj] * WSCALE, v[2][jj] * WSCALE, v[3][jj] * WSCALE);
            o.y = pack_fp8x4(v[4][jj] * WSCALE, v[5][jj] * WSCALE, v[6][jj] * WSCALE, v[7][jj] * WSCALE);
            o.z = pack_fp8x4(v[8][jj] * WSCALE, v[9][jj] * WSCALE, v[10][jj] * WSCALE, v[11][jj] * WSCALE);
            o.w = pack_fp8x4(v[12][jj] * WSCALE, v[13][jj] * WSCALE, v[14][jj] * WSCALE, v[15][jj] * WSCALE);
            __builtin_nontemporal_store(o, (GAS u32x4*)((unsigned char*)j.WT + (size_t)nn * K + kk));
        }
    }
}
constexpr int P0_I_IN = (D / 64) * (NQKV / 32), P0_I_OUT = (D / 64) * (D / 32), P0_I_G = P0_I_OUT, P0_I_PLE = (PLE / 64) * (D / 32), P0_I_UP1 = (D / 64) * (2 * DFF / 32), P0_I_DN1 = (DFF / 64) * (D / 32);
constexpr int P0_NA = P0_I_IN + P0_I_OUT + P0_I_PLE, P0_NB = P0_I_G + NE * P0_I_UP1 + NE * P0_I_DN1;
constexpr int CV_LISTS = 2048, CV_BLOCKS = P0_NB / 2;
constexpr int CV_UP_END = (P0_I_G + NE * P0_I_UP1) / 2;
static_assert(P0_NA % 2 == 0 && P0_NB % 2 == 0, "item pairs");
__device__ __forceinline__ int cv_list_len(int l, int nblocks) { return l < nblocks ? (nblocks - l + CV_LISTS - 1) / CV_LISTS : 0; }
__device__ __forceinline__ void p0_locate_a(const Args& a, int it, P0Job& j, int& item) {
    unsigned char* ws = a.ws; int r = it;
    if (r < P0_I_IN) { j = P0Job{a.w_in, ws + WS_WINT, D, NQKV, 0}; item = r; return; } r -= P0_I_IN;
    if (r < P0_I_OUT) { j = P0Job{a.w_out, ws + WS_WOUTT, D, D, 0}; item = r; return; } r -= P0_I_OUT;
    j = P0Job{a.w_ple, ws + WS_WPLET, PLE, D, 0}; item = r;
}
__device__ __forceinline__ void p0_locate_b(const Args& a, int it, P0Job& j, int& item) {
    unsigned char* ws = a.ws; int r = it;
    if (r < P0_I_G) { j = P0Job{a.w_ple_gate, ws + WS_WGT, D, D, 2}; item = r; return; } r -= P0_I_G;
    if (r < NE * P0_I_UP1) { const int e = r / P0_I_UP1; item = r - e * P0_I_UP1; j = P0Job{a.w_up + (size_t)e * D * 2 * DFF, ws + WS_WUPT + (size_t)e * 2 * DFF * D, D, 2 * DFF, 3}; return; } r -= NE * P0_I_UP1;
    { const int e = r / P0_I_DN1; item = r - e * P0_I_DN1; j = P0Job{a.w_down + (size_t)e * DFF * D, ws + WS_WDNT + (size_t)e * D * DFF, DFF, D, 2}; }
}
__device__ __forceinline__ void cv_range(const Args& a, int l, int i0, int i1, int lane) {
    if (i0 >= i1) return;
    P0Job j0; int it0; f32x4 v0[16];
    { p0_locate_b(a, 2 * (l + CV_LISTS * i0), j0, it0); cv_load(j0, it0 >> 1, lane, v0); }
    for (int i = i0;;) {
        const int in = i + 1; const bool hn = in < i1;
        P0Job n0 = j0; int nit = it0; f32x4 w0[16];
        if (hn) { p0_locate_b(a, 2 * (l + CV_LISTS * in), n0, nit); cv_load(n0, nit >> 1, lane, w0); }
        cv_store(j0, it0 >> 1, lane, v0);
        if (!hn) break;
#pragma unroll
        for (int k = 0; k < 16; ++k) v0[k] = w0[k];
        j0 = n0; it0 = nit; i = in;
    }
}
__device__ __forceinline__ void p0_prologue(const Args& a, LAS unsigned char* lds, int gw, int NGW, int wave, int lane) {
    unsigned char* ws = a.ws;
    { int pr = gw; P0Job j0; int it0 = 0; f32x4 v0[16];
      if (pr < P0_NA / 2) { p0_locate_a(a, 2 * pr, j0, it0); cv_load(j0, it0 >> 1, lane, v0);
        for (;;) {
            const int pn = pr + NGW; const bool hn = pn < P0_NA / 2;
            P0Job n0 = j0; int nit = it0; f32x4 w0[16];
            if (hn) { p0_locate_a(a, 2 * pn, n0, nit); cv_load(n0, nit >> 1, lane, w0); }
            cv_store(j0, it0 >> 1, lane, v0);
            if (!hn) break;
#pragma unroll
            for (int k = 0; k < 16; ++k) v0[k] = w0[k];
            j0 = n0; it0 = nit; pr = pn;
        } } }
    { const GAS f32x4* src = (const GAS f32x4*)a.x; GAS u32x2* dst = (GAS u32x2*)(ws + WS_XB); const size_t n4 = (size_t)M * D / 4, stride = (size_t)NGW * 64;
      size_t i = (size_t)gw * 64 + lane; f32x4 v[8];
      if (i < n4) {
#pragma unroll
          for (int u = 0; u < 8; ++u) if (i + u * stride < n4) v[u] = __builtin_nontemporal_load(src + i + u * stride);
          for (;;) {
              const size_t in = i + 8 * stride; const bool hn = in < n4; f32x4 w[8];
              if (hn) {
#pragma unroll
                  for (int u = 0; u < 8; ++u) if (in + u * stride < n4) w[u] = __builtin_nontemporal_load(src + in + u * stride); }
#pragma unroll
              for (int u = 0; u < 8; ++u) if (i + u * stride < n4) { u32x2 o; o.x = pk2(v[u].x, v[u].y); o.y = pk2(v[u].z, v[u].w); dst[i + u * stride] = o; }
              if (!hn) break;
#pragma unroll
              for (int u = 0; u < 8; ++u) v[u] = w[u];
              i = in;
          } } }
    { const GAS f32x4* src = (const GAS f32x4*)a.p; GAS u32x2* dst = (GAS u32x2*)(ws + WS_PB); const size_t n4 = (size_t)M * PLE / 4, stride = (size_t)NGW * 64;
      for (size_t i = (size_t)gw * 64 + lane; i < n4; i += 8 * stride) { f32x4 v[8];
#pragma unroll
          for (int u = 0; u < 8; ++u) if (i + u * stride < n4) v[u] = __builtin_nontemporal_load(src + i + u * stride);
#pragma unroll
          for (int u = 0; u < 8; ++u) if (i + u * stride < n4) { u32x2 o; o.x = pk2(v[u].x, v[u].y); o.y = pk2(v[u].z, v[u].w); dst[i + u * stride] = o; } } }
    { float* km = (float*)(ws + WS_KMEAN); for (int i = gw * 64 + lane; i < 16 * 32 * 128; i += NGW * 64) km[i] = 0.f; }
    { float* bp = (float*)(ws + WS_BUPP);
      for (int i = gw * 64 + lane; i < NE * 2 * DFF; i += NGW * 64) { const int e = i >> 12, nn = i & 4095; const int a2 = nn >> 1, bj = nn & 1; bp[e * 4096 + 256 * (a2 >> 7) + 128 * bj + (a2 & 127)] = bj ? a.b_up[i] + 1.f : 8.f * a.b_up[i]; } }
}

__device__ __forceinline__ void p2_kmean(const Args& a, LAS unsigned char* lds, int G) {
    const bf16* qkv = (const bf16*)(a.ws + WS_QKV); float* km = (float*)(a.ws + WS_KMEAN);
    LAS float* red = (LAS float*)(lds + RING_OFF);
    const int tid = threadIdx.x, c = tid & 15, rg = tid >> 4;
    for (int it = blockIdx.x; it < 16 * 32; it += G) {
        const int bh = it >> 5, blk = it & 31, b = bh >> 3, h = bh & 7;
        float s[8] = {0, 0, 0, 0, 0, 0, 0, 0};
#pragma unroll
        for (int i = 0; i < 8; ++i) { const int row = b * SEQ + blk * 256 + rg + 32 * i; const u32x4 w = *(const u32x4*)(qkv + (size_t)row * NQKV + 4096 + h * 128 + 8 * c);
            s[0] += bf_lo(w.x); s[1] += bf_hi(w.x); s[2] += bf_lo(w.y); s[3] += bf_hi(w.y); s[4] += bf_lo(w.z); s[5] += bf_hi(w.z); s[6] += bf_lo(w.w); s[7] += bf_hi(w.w); }
#pragma unroll
        for (int j = 0; j < 8; ++j) red[rg * 128 + 8 * c + j] = s[j];
        __syncthreads();
        if (tid < 128) { float t = 0.f; for (int r = 0; r < 32; ++r) t += red[r * 128 + tid]; km[(size_t)it * 128 + tid] = t * (1.f / 256.f); }
        __syncthreads();
    }
}

namespace mix {
typedef short s16x4 __attribute__((ext_vector_type(4)));
#define KSWZ(row, colB) ((row) * 256 + ((colB) ^ (((row) & 7) << 4)))
constexpr int L_V = 0, L_K = 16384, L_WS = 32768, L_FLAG = 36864, L_PRE = 40960;
constexpr float THR2 = 11.5f;
__device__ __forceinline__ int crow(int r, int hi) { return (r & 3) + 8 * (r >> 2) + 4 * hi; }
__device__ __forceinline__ unsigned cvtpk(float lo, float hi) { unsigned r; asm volatile("v_cvt_pk_bf16_f32 %0, %1, %2" : "=v"(r) : "v"(lo), "v"(hi)); return r; }
__device__ __forceinline__ int v_st(int k, int c) { const int kk = (k & ~0xC) | ((k & 4) << 1) | ((k & 8) >> 1); return ((kk >> 3) * 4 + (c >> 5)) * 512 + ((kk & 7) * 32 + (c & 31)) * 2; }
__device__ __forceinline__ int v_rd_base(int lane) { return ((lane & 3) << 3) | (((lane >> 2) & 3) << 6) | (((lane >> 4) & 1) << 5) | (((lane >> 5) & 1) << 8); }
constexpr int v_rd_off(int d0, int ks, int half) { return d0 * 512 + ks * 4096 + half * 2048; }
template <int OFF> __device__ __forceinline__ s16x4 tr_read(int vb) { s16x4 r; asm volatile("ds_read_b64_tr_b16 %0, %1 offset:%2" : "=&v"(r) : "v"(vb), "i"(OFF) : "memory"); return r; }
template <int D0> __device__ __forceinline__ void pv_one(f32x16& od, int vb, bf16x8 pa0, bf16x8 pa1, bf16x8 pa2, bf16x8 pa3) {
    const s16x4 l0 = tr_read<v_rd_off(D0, 0, 0)>(vb), h0 = tr_read<v_rd_off(D0, 0, 1)>(vb), l1 = tr_read<v_rd_off(D0, 1, 0)>(vb), h1 = tr_read<v_rd_off(D0, 1, 1)>(vb);
    const s16x4 l2 = tr_read<v_rd_off(D0, 2, 0)>(vb), h2 = tr_read<v_rd_off(D0, 2, 1)>(vb), l3 = tr_read<v_rd_off(D0, 3, 0)>(vb), h3 = tr_read<v_rd_off(D0, 3, 1)>(vb);
    asm volatile("s_waitcnt lgkmcnt(0)" ::: "memory"); __builtin_amdgcn_sched_barrier(0);
#define PK(L, H) (bf16x8){L[0], L[1], L[2], L[3], H[0], H[1], H[2], H[3]}
    od = __builtin_amdgcn_mfma_f32_32x32x16_bf16(pa0, PK(l0, h0), od, 0, 0, 0);
    od = __builtin_amdgcn_mfma_f32_32x32x16_bf16(pa1, PK(l1, h1), od, 0, 0, 0);
    od = __builtin_amdgcn_mfma_f32_32x32x16_bf16(pa2, PK(l2, h2), od, 0, 0, 0);
    od = __builtin_amdgcn_mfma_f32_32x32x16_bf16(pa3, PK(l3, h3), od, 0, 0, 0);
#undef PK
}
__device__ __forceinline__ void pv_d0(f32x16 (&o)[4], int vb, bf16x8 pa0, bf16x8 pa1, bf16x8 pa2, bf16x8 pa3) {
    pv_one<0>(o[0], vb, pa0, pa1, pa2, pa3); pv_one<1>(o[1], vb, pa0, pa1, pa2, pa3); pv_one<2>(o[2], vb, pa0, pa1, pa2, pa3); pv_one<3>(o[3], vb, pa0, pa1, pa2, pa3);
}
__device__ __forceinline__ void qkt(f32x16& p0, f32x16& p1, const LAS unsigned char* Ks, const bf16x8 (&qr)[8], int r32, int hi) {
#pragma unroll
    for (int i = 0; i < 16; ++i) { p0[i] = 0.f; p1[i] = 0.f; }
#pragma unroll
    for (int d0 = 0; d0 < 8; ++d0) { const int cb = (d0 * 16 + hi * 8) * 2;
        const bf16x8 b0 = *(const LAS bf16x8*)(Ks + KSWZ(r32, cb));
        const bf16x8 b1 = *(const LAS bf16x8*)(Ks + KSWZ(32 + r32, cb));
        p0 = __builtin_amdgcn_mfma_f32_32x32x16_bf16(b0, qr[d0], p0, 0, 0, 0);
        p1 = __builtin_amdgcn_mfma_f32_32x32x16_bf16(b1, qr[d0], p1, 0, 0, 0); }
}
__device__ __forceinline__ void pack_p(const f32x16& p0, const f32x16& p1, bf16x8& pa0, bf16x8& pa1, bf16x8& pa2, bf16x8& pa3) {
#define PK4(P, BASE, OUT) do { unsigned a0 = cvtpk(P[BASE + 0], P[BASE + 1]), a1 = cvtpk(P[BASE + 2], P[BASE + 3]);   \
    unsigned b0 = cvtpk(P[BASE + 4], P[BASE + 5]), b1 = cvtpk(P[BASE + 6], P[BASE + 7]);                              \
    auto r0 = __builtin_amdgcn_permlane32_swap(a0, b0, false, false); auto r1 = __builtin_amdgcn_permlane32_swap(a1, b1, false, false); \
    u32x4 w = {r0[0], r1[0], r0[1], r1[1]}; OUT = __builtin_bit_cast(bf16x8, w); } while (0)
    PK4(p0, 0, pa0); PK4(p0, 8, pa1); PK4(p1, 0, pa2); PK4(p1, 8, pa3);
#undef PK4
}
__device__ __forceinline__ float pair_other(float x, int hi) {
    auto rr = __builtin_amdgcn_permlane32_swap(__builtin_bit_cast(unsigned, x), __builtin_bit_cast(unsigned, x), false, false);
    return __builtin_bit_cast(float, hi ? rr[0] : rr[1]);
}
struct TileRegs { u32x4 k0, k1, v0, v1; };
__device__ __forceinline__ void stage_load(TileRegs& r, const bf16* kg, const bf16* vg, int tid) {
    const int sr = tid >> 4, sc = (tid & 15) * 8;
    r.k0 = *(const u32x4*)(kg + (size_t)sr * NQKV + sc); r.k1 = *(const u32x4*)(kg + (size_t)(32 + sr) * NQKV + sc);
    r.v0 = *(const u32x4*)(vg + (size_t)sr * NQKV + sc); r.v1 = *(const u32x4*)(vg + (size_t)(32 + sr) * NQKV + sc);
}
__device__ __forceinline__ void stage_write(LAS unsigned char* lds, const TileRegs& r, int tid) {
    const int sr = tid >> 4, sc = (tid & 15) * 8;
    *(LAS u32x4*)(lds + L_V + v_st(sr, sc)) = r.v0; *(LAS u32x4*)(lds + L_V + v_st(32 + sr, sc)) = r.v1;
    *(LAS u32x4*)(lds + L_K + KSWZ(sr, sc * 2)) = r.k0; *(LAS u32x4*)(lds + L_K + KSWZ(32 + sr, sc * 2)) = r.k1;
}
__device__ __forceinline__ float reduce32(float v) { v = reduce16(v); v += __shfl_xor(v, 16); return v; }

__device__ __forceinline__ void sb_unit(const Args& a, LAS unsigned char* lds, int bh, int qb) {
    const bf16* qkv = (const bf16*)(a.ws + WS_QKV); bf16* mixed = (bf16*)(a.ws + WS_MIXED);
    const int tid = threadIdx.x, wid = __builtin_amdgcn_readfirstlane(tid >> 6), lane = tid & 63, r32 = lane & 31, hi = lane >> 5;
    const int b = bh >> 3, h = bh & 7, q0 = qb * 256, qpos = q0 + wid * 32 + r32;
    const bf16* base = qkv + (size_t)b * SEQ * NQKV + h * 128;
    volatile LAS int* flags = (volatile LAS int*)(lds + L_FLAG);
    bf16x8 qr[8];
#pragma unroll
    for (int d0 = 0; d0 < 8; ++d0) qr[d0] = *(const bf16x8*)(base + (size_t)qpos * NQKV + d0 * 16 + hi * 8);
    f32x16 o[4];
#pragma unroll
    for (int d = 0; d < 4; ++d)
#pragma unroll
        for (int i = 0; i < 16; ++i) o[d][i] = 0.f;
    float P = 1.f; bool wdone = false;
    const int vb0 = (int)(uintptr_t)(lds + L_V) + v_rd_base(lane);
    __syncthreads();
    if (tid < 8) flags[tid] = 0;
    TileRegs tr; stage_load(tr, base + (size_t)((qb * 4 + 3) * 64) * NQKV + 1024, base + (size_t)((qb * 4 + 3) * 64) * NQKV + 2048, tid);
    for (int kt = qb * 4 + 3; kt >= 0; --kt) {
        __syncthreads();
        { int alld = 1;
#pragma unroll
          for (int w = 0; w < 8; ++w) alld &= flags[w];
          if (alld) break; }
        stage_write(lds, tr, tid);
        if (kt > 0) stage_load(tr, base + (size_t)((kt - 1) * 64) * NQKV + 1024, base + (size_t)((kt - 1) * 64) * NQKV + 2048, tid);
        __syncthreads();
        const int kbase = kt * 64;
        if (!wdone && kbase < q0 + wid * 32 + 31) {
            f32x16 p0, p1; qkt(p0, p1, lds + L_K, qr, r32, hi);
            const int d0i = kbase + 4 * hi - qpos;
            f32x16 m0, m1;
#pragma unroll
            for (int r = 0; r < 16; ++r) {
                const int c = (r & 3) + 8 * (r >> 2);
                { const float z = fminf(fmaxf(p0[r], -120.f), 120.f); const float e = __builtin_amdgcn_exp2f(-z), be = __builtin_amdgcn_rcpf(1.f + e); const bool ok = (d0i + c) < 0;
                  p0[r] = ok ? be : 0.f; m0[r] = ok ? e * be : 1.f; }
                { const float z = fminf(fmaxf(p1[r], -120.f), 120.f); const float e = __builtin_amdgcn_exp2f(-z), be = __builtin_amdgcn_rcpf(1.f + e); const bool ok = (d0i + 32 + c) < 0;
                  p1[r] = ok ? be : 0.f; m1[r] = ok ? e * be : 1.f; }
            }
            float Go[2][4], Gp[2][4];
#pragma unroll
            for (int g = 0; g < 4; ++g) { Go[0][g] = (m0[4 * g] * m0[4 * g + 1]) * (m0[4 * g + 2] * m0[4 * g + 3]); Go[1][g] = (m1[4 * g] * m1[4 * g + 1]) * (m1[4 * g + 2] * m1[4 * g + 3]); }
#pragma unroll
            for (int ph = 0; ph < 2; ++ph)
#pragma unroll
                for (int g = 0; g < 4; ++g) Gp[ph][g] = pair_other(Go[ph][g], hi);
            float R = P;
#pragma unroll
            for (int ph = 1; ph >= 0; --ph)
#pragma unroll
                for (int g = 3; g >= 0; --g) {
                    const float Gf = hi ? Go[ph][g] : Gp[ph][g], Gs = hi ? Gp[ph][g] : Go[ph][g];
                    const float sA = R; R *= Gf; const float sB = R; R *= Gs;
                    float S = hi ? sA : sB;
                    if (ph == 1) { p1[4 * g + 3] *= S; S *= m1[4 * g + 3]; p1[4 * g + 2] *= S; S *= m1[4 * g + 2]; p1[4 * g + 1] *= S; S *= m1[4 * g + 1]; p1[4 * g] *= S; }
                    else         { p0[4 * g + 3] *= S; S *= m0[4 * g + 3]; p0[4 * g + 2] *= S; S *= m0[4 * g + 2]; p0[4 * g + 1] *= S; S *= m0[4 * g + 1]; p0[4 * g] *= S; }
                }
            P = R;
            bf16x8 pa0, pa1, pa2, pa3; pack_p(p0, p1, pa0, pa1, pa2, pa3);
            pv_d0(o, vb0, pa0, pa1, pa2, pa3);
            wdone = __builtin_amdgcn_ballot_w64(P >= 1e-30f) == 0ull;
        }
        if (lane == 0) flags[wid] = (wdone || kt == 0) ? 1 : 0;
    }
    f32x4 gn; gn.x = a.norm_sb[h * 128 + r32]; gn.y = a.norm_sb[h * 128 + 32 + r32]; gn.z = a.norm_sb[h * 128 + 64 + r32]; gn.w = a.norm_sb[h * 128 + 96 + r32];
#pragma unroll
    for (int r = 0; r < 16; ++r) {
        float ss = (o[0][r] * o[0][r] + o[1][r] * o[1][r]) + (o[2][r] * o[2][r] + o[3][r] * o[3][r]);
        ss = reduce32(ss) * (1.f / 128.f);
        const float rn = 1.f / sqrtf(ss + RMS_EPS);
        bf16* orow = mixed + (size_t)(b * SEQ + q0 + wid * 32 + crow(r, hi)) * D + h * 128 + r32;
        orow[0] = (bf16)f2bf(o[0][r] * rn * gn.x); orow[32] = (bf16)f2bf(o[1][r] * rn * gn.y); orow[64] = (bf16)f2bf(o[2][r] * rn * gn.z); orow[96] = (bf16)f2bf(o[3][r] * rn * gn.w);
    }
}

__device__ __forceinline__ int moba_entry(const int* list, int n, bool own_unit, int j, int ei) { return own_unit ? ((j * 256 + ei) | (3 << 16)) : list[ei < n ? ei : 0]; }
__device__ __forceinline__ void moba_unit(const Args& a, LAS unsigned char* lds, int bh, int j, int ent, int n, bool own_unit, bf16x8 (&qr)[8], TileRegs& tr, bool pre,
                                          bool hn, const int* nlist, int nn, bool nown, int nbh, int nj, int& ent_next) {
    const bf16* qkv = (const bf16*)(a.ws + WS_QKV); bf16* po = (bf16*)(a.ws + WS_MPO); float* pml = (float*)(a.ws + WS_MPML);
    const int tid = threadIdx.x, wid = __builtin_amdgcn_readfirstlane(tid >> 6), lane = tid & 63, r32 = lane & 31, hi = lane >> 5;
    const int b = bh >> 3, h = bh & 7;
    const bf16* base = qkv + (size_t)b * SEQ * NQKV + h * 128;
    LAS float* wsf = (LAS float*)(lds + L_WS + wid * 512); LAS float* al_l = wsf; LAS float* li_l = wsf + 32; LAS int* tb = (LAS int*)(wsf + 64);
    const int ei = wid * 32 + r32;
    const bool evalid = own_unit || (ei < n);
    const int qpos = ent & 0xffff, slot = ent >> 16;
    const int pslot = evalid ? (((bh * SEQ + qpos) << 2) + slot) : -1;
    __syncthreads();
    if (hi == 0) tb[r32] = pslot;
    if (!pre) {
#pragma unroll
        for (int d0 = 0; d0 < 8; ++d0) qr[d0] = *(const bf16x8*)(base + (size_t)qpos * NQKV + 3072 + d0 * 16 + hi * 8); }
    f32x16 o[4];
#pragma unroll
    for (int d = 0; d < 4; ++d)
#pragma unroll
        for (int i = 0; i < 16; ++i) o[d][i] = 0.f;
    float m_reg = -1e30f, l_reg = 0.f;
    const float slope2 = __builtin_amdgcn_exp2f(-(float)(h + 1)) * LOG2E;
    const int vb0 = (int)(uintptr_t)(lds + L_V) + v_rd_base(lane);
    if (!pre) stage_load(tr, base + (size_t)(j * 256) * NQKV + 4096, base + (size_t)(j * 256) * NQKV + 5120, tid);
    if (hn) ent_next = moba_entry(nlist, nn, nown, nj, ei);
    for (int jt = 0; jt < 4; ++jt) {
        if (jt) __syncthreads();
        const int kbase = j * 256 + jt * 64;
        stage_write(lds, tr, tid);
        if (jt < 3) stage_load(tr, base + (size_t)(kbase + 64) * NQKV + 4096, base + (size_t)(kbase + 64) * NQKV + 5120, tid);
        __syncthreads();
        if (own_unit && jt * 64 > wid * 32 + 31) continue;
        f32x16 p0, p1; qkt(p0, p1, lds + L_K, qr, r32, hi);
        const int d0i = kbase + 4 * hi - qpos;
        float pmax = -1e30f;
#pragma unroll
        for (int r = 0; r < 16; ++r) {
            const int c = (r & 3) + 8 * (r >> 2);
            { const int x = d0i + c; const float s = fmaf(slope2, (float)x, p0[r]); p0[r] = (x <= 0) ? s : -1e30f; pmax = fmaxf(pmax, p0[r]); }
            { const int x = d0i + 32 + c; const float s = fmaf(slope2, (float)x, p1[r]); p1[r] = (x <= 0) ? s : -1e30f; pmax = fmaxf(pmax, p1[r]); }
        }
        pmax = fmaxf(pmax, pair_other(pmax, hi));
        float mn, alpha;
        if (__builtin_amdgcn_ballot_w64(pmax - m_reg > THR2) == 0ull) { mn = m_reg; alpha = 1.f; }
        else { mn = fmaxf(m_reg, pmax); alpha = __builtin_amdgcn_exp2f(m_reg - mn); m_reg = mn; }
        float ps = 0.f;
#pragma unroll
        for (int r = 0; r < 16; ++r) { p0[r] = __builtin_amdgcn_exp2f(p0[r] - mn); p1[r] = __builtin_amdgcn_exp2f(p1[r] - mn); ps += p0[r] + p1[r]; }
        ps += pair_other(ps, hi);
        l_reg = l_reg * alpha + ps;
        if (__builtin_amdgcn_ballot_w64(alpha < 1.f) != 0ull) {
            if (hi == 0) al_l[r32] = alpha;
            asm volatile("s_waitcnt lgkmcnt(0)" ::: "memory");
#pragma unroll
            for (int r = 0; r < 16; ++r) { const float al = al_l[crow(r, hi)];
#pragma unroll
                for (int d = 0; d < 4; ++d) o[d][r] *= al; }
        }
        bf16x8 pa0, pa1, pa2, pa3; pack_p(p0, p1, pa0, pa1, pa2, pa3);
        pv_d0(o, vb0, pa0, pa1, pa2, pa3);
    }
    if (hn) {
        const int nqpos = ent_next & 0xffff; const bf16* nbase = qkv + (size_t)(nbh >> 3) * SEQ * NQKV + (nbh & 7) * 128;
#pragma unroll
        for (int d0 = 0; d0 < 8; ++d0) qr[d0] = *(const bf16x8*)(nbase + (size_t)nqpos * NQKV + 3072 + d0 * 16 + hi * 8);
        stage_load(tr, nbase + (size_t)(nj * 256) * NQKV + 4096, nbase + (size_t)(nj * 256) * NQKV + 5120, tid);
    }
    if (hi == 0) { li_l[r32] = l_reg; if (evalid) { f32x2 ml; ml.x = m_reg; ml.y = l_reg; *(f32x2*)(pml + 2 * (size_t)pslot) = ml; } }
    asm volatile("s_waitcnt lgkmcnt(0)" ::: "memory");
#pragma unroll
    for (int r = 0; r < 16; ++r) {
        const int rw = crow(r, hi); const int ps_ = tb[rw]; const float rl = __builtin_amdgcn_rcpf(li_l[rw]);
        if (ps_ >= 0) { bf16* orow = po + (size_t)ps_ * 128 + r32;
            orow[0] = (bf16)f2bf(o[0][r] * rl); orow[32] = (bf16)f2bf(o[1][r] * rl); orow[64] = (bf16)f2bf(o[2][r] * rl); orow[96] = (bf16)f2bf(o[3][r] * rl); }
    }
}
}

__device__ __forceinline__ void unpack8(const u32x4 w, float (&f)[8]) { f[0] = bf_lo(w.x); f[1] = bf_hi(w.x); f[2] = bf_lo(w.y); f[3] = bf_hi(w.y); f[4] = bf_lo(w.z); f[5] = bf_hi(w.z); f[6] = bf_lo(w.w); f[7] = bf_hi(w.w); }
__device__ __forceinline__ float dot8(const float (&q)[8], const float (&k)[8]) { float s = q[0] * k[0];
#pragma unroll
    for (int j = 1; j < 8; ++j) s = fmaf(q[j], k[j], s); return s; }
__device__ __forceinline__ bool gate_better(float v, int i, float w, int j) { return (v > w) || (v == w && i < j); }
#define TOP3_INSERT(ok, g, n) do { const float g_ = (g); const int n_ = (n); const bool ok_ = (ok); \
    const bool b0_ = ok_ && gate_better(g_, n_, v0, i0), b1_ = ok_ && gate_better(g_, n_, v1, i1), b2_ = ok_ && gate_better(g_, n_, v2, i2); \
    v2 = b1_ ? v1 : (b2_ ? g_ : v2); i2 = b1_ ? i1 : (b2_ ? n_ : i2); \
    v1 = b0_ ? v0 : (b1_ ? g_ : v1); i1 = b0_ ? i0 : (b1_ ? n_ : i1); \
    v0 = b0_ ? g_ : v0; i0 = b0_ ? n_ : i0; } while (0)
__device__ __forceinline__ void p3_gate_tile(const Args& a, int bh, int qt, int lane) {
    const bf16* qkv = (const bf16*)(a.ws + WS_QKV); const float* km = (const float*)(a.ws + WS_KMEAN);
    unsigned* mcnt = (unsigned*)(a.ws + WS_CTL) + CW_MCNT; int* mlist = (int*)(a.ws + WS_MLIST);
    const int b = bh >> 3, h = bh & 7, r32 = lane & 31, hi = lane >> 5, t0 = 32 * qt, own = t0 >> 8, t = t0 + r32;
    if (own == 0) return;
    f32x16 p;
#pragma unroll
    for (int i = 0; i < 16; ++i) p[i] = 0.f;
    const float* kp = km + ((size_t)bh * 32 + r32) * 128 + hi * 8;
    const bf16* qp = qkv + (size_t)(b * SEQ + t) * NQKV + 3072 + h * 128 + hi * 8;
#pragma unroll
    for (int d0 = 0; d0 < 8; ++d0) {
        const f32x4 k0 = *(const f32x4*)(kp + d0 * 16), k1 = *(const f32x4*)(kp + d0 * 16 + 4);
        u32x4 kw; kw.x = pk2(k0.x, k0.y); kw.y = pk2(k0.z, k0.w); kw.z = pk2(k1.x, k1.y); kw.w = pk2(k1.z, k1.w);
        const bf16x8 qf = *(const bf16x8*)(qp + d0 * 16);
        p = __builtin_amdgcn_mfma_f32_32x32x16_bf16(__builtin_bit_cast(bf16x8, kw), qf, p, 0, 0, 0);
    }
    float v0 = -INFINITY, v1 = -INFINITY, v2 = -INFINITY; int i0 = 64, i1 = 64, i2 = 64;
#pragma unroll
    for (int r = 0; r < 16; ++r) { const int n = (r & 3) + 8 * (r >> 2) + 4 * hi; TOP3_INSERT(n < own, p[r], n); }
    { const float w0 = mix::pair_other(v0, hi), w1 = mix::pair_other(v1, hi), w2 = mix::pair_other(v2, hi);
      const int j0 = __builtin_bit_cast(int, mix::pair_other(__builtin_bit_cast(float, i0), hi)), j1 = __builtin_bit_cast(int, mix::pair_other(__builtin_bit_cast(float, i1), hi)), j2 = __builtin_bit_cast(int, mix::pair_other(__builtin_bit_cast(float, i2), hi));
      TOP3_INSERT(j0 < 64, w0, j0); TOP3_INSERT(j1 < 64, w1, j1); TOP3_INSERT(j2 < 64, w2, j2); }
    const int nsel = own < 3 ? own : 3;
    const bool ql = hi == 0;
    const bool s1 = nsel > 1, s2 = nsel > 2;
    const unsigned long long ltmask = (1ull << lane) - 1ull;
    int mycount = 0, r0 = 0, r1 = 0, r2 = 0;
    for (int n = 0; n < own; ++n) {
        const unsigned long long mk = __builtin_amdgcn_ballot_w64(ql && (i0 == n || (s1 && i1 == n) || (s2 && i2 == n)));
        const int c = __builtin_popcountll(mk), rk = __builtin_popcountll(mk & ltmask);
        if (lane == n) mycount = c;
        if (i0 == n) r0 = rk; if (i1 == n) r1 = rk; if (i2 == n) r2 = rk;
    }
    int basev = 0;
    if (lane < own && mycount > 0) basev = (int)__hip_atomic_fetch_add(mcnt + 16 * (bh * 32 + lane), (unsigned)mycount, RLX_AGENT);
    const int q0 = __shfl(basev, i0 & 31) + r0, q1 = __shfl(basev, i1 & 31) + r1, q2 = __shfl(basev, i2 & 31) + r2;
    if (ql) {
        mlist[(size_t)(bh * 32 + i0) * SEQ + q0] = t | (0 << 16);
        if (s1) mlist[(size_t)(bh * 32 + i1) * SEQ + q1] = t | (1 << 16);
        if (s2) mlist[(size_t)(bh * 32 + i2) * SEQ + q2] = t | (2 << 16);
    }
}
__device__ __forceinline__ void p3_sb_and_gate(const Args& a, LAS unsigned char* lds, int G, int wg, int gw, int NGW, int lane) {
    for (int it = gw; it < 16 * (SEQ / 32); it += NGW) p3_gate_tile(a, it >> 8, it & 255, lane);
}
__device__ __forceinline__ void p4_moba(const Args& a, LAS unsigned char* lds, int G, int wg) {
    const unsigned* mcnt = (const unsigned*)(a.ws + WS_CTL) + CW_MCNT; const int* mlist = (const int*)(a.ws + WS_MLIST);
    LAS int* pre = (LAS int*)(lds + mix::L_PRE);
    const int tid = threadIdx.x;
    __syncthreads();
    if (tid < 64) {
        int c[8], s = 0;
#pragma unroll
        for (int i = 0; i < 8; ++i) { c[i] = ((int)mcnt[16 * (tid * 8 + i)] + 255) >> 8; s += c[i]; }
        int inc = s;
#pragma unroll
        for (int o = 1; o < 64; o <<= 1) { const int v = __shfl_up(inc, o); if (tid >= o) inc += v; }
        int run = inc - s;
#pragma unroll
        for (int i = 0; i < 8; ++i) { pre[tid * 8 + i] = run; run += c[i]; }
        if (tid == 63) pre[512] = run;
    }
    __syncthreads();
    const int usel = pre[512], total = usel + 512;
#define P4_DECODE(uu_, k_, n_, own_, lp_) do { const int u_ = (uu_) - 16 * 32; \
        if (u_ < usel) { int lo_ = 0, hi_ = 511; while (lo_ < hi_) { const int mid_ = (lo_ + hi_ + 1) >> 1; if (pre[mid_] <= u_) lo_ = mid_; else hi_ = mid_ - 1; } \
            k_ = __builtin_amdgcn_readfirstlane(lo_); const int c_ = u_ - pre[k_]; const int cnt_ = (int)mcnt[16 * k_]; \
            lp_ = mlist + (size_t)k_ * SEQ + c_ * 256; n_ = (cnt_ - c_ * 256) < 256 ? (cnt_ - c_ * 256) : 256; own_ = false; } \
        else { k_ = u_ - usel; lp_ = nullptr; n_ = 256; own_ = true; } } while (0)
    int uu = wg;
    for (; uu < 16 * 32; uu += G) { const unsigned pb41 = pb_begin(41); mix::sb_unit(a, lds, uu >> 5, uu & 31); pb_end(41, pb41); }
    const int ei = (tid >> 6) * 32 + (tid & 31);
    int ent = 0; bool have = false;
    int k = 0, n = 0; bool own = false; const int* lp = nullptr;
    bf16x8 qr[8]; mix::TileRegs tr;
#pragma unroll
    for (int d0 = 0; d0 < 8; ++d0) qr[d0] = (bf16x8){0, 0, 0, 0, 0, 0, 0, 0};
    tr.k0 = tr.k1 = tr.v0 = tr.v1 = (u32x4){0u, 0u, 0u, 0u};
    for (; uu < total + 16 * 32; uu += G) {
        if (!have) { P4_DECODE(uu, k, n, own, lp); ent = mix::moba_entry(lp, n, own, k & 31, ei); }
        const bool hn = uu + G < total + 16 * 32;
        int nk = 0, nn = 0; bool nown = false; const int* nlp = nullptr; if (hn) P4_DECODE(uu + G, nk, nn, nown, nlp);
        int ent_next = 0;
        const unsigned pb42 = pb_begin(42); mix::moba_unit(a, lds, k >> 5, k & 31, ent, n, own, qr, tr, have, hn, nlp, nn, nown, nk >> 5, nk & 31, ent_next); pb_end(42, pb42);
        ent = ent_next; have = hn; k = nk; n = nn; own = nown; lp = nlp;
    }
#undef P4_DECODE
}
__device__ __forceinline__ void p5_combine(const Args& a, int gw, int NGW, int lane) {
    const bf16* po = (const bf16*)(a.ws + WS_MPO); const float* pml = (const float*)(a.ws + WS_MPML); bf16* mixed = (bf16*)(a.ws + WS_MIXED);
    const int sub = lane >> 4, dl = lane & 15;
    const int total = 16 * (SEQ / 4);
    const bool ginv = (NGW & 15) == 0;
    f32x4 g0 = {0.f, 0.f, 0.f, 0.f}, g1 = g0;
    if (ginv) { const float* gain = a.norm_moba + (gw & 7) * 128 + 8 * dl; g0 = *(const f32x4*)gain; g1 = *(const f32x4*)(gain + 4); }
    f32x2 ml[4]; u32x4 pw[4];
#pragma unroll
    for (int s = 0; s < 4; ++s) { ml[s] = (f32x2){-1e30f, 0.f}; pw[s] = (u32x4){0u, 0u, 0u, 0u}; }
#define P5_ISSUE(it_) do { const int bh_ = (it_) & 15, t_ = 4 * ((it_) >> 4) + sub, own_ = t_ >> 8, nsel_ = own_ < 3 ? own_ : 3; const size_t ps_ = ((size_t)(bh_ * SEQ + t_)) << 2; \
        _Pragma("unroll") for (int s = 0; s < 4; ++s) { const bool ok_ = (s == 3) || (s < nsel_); ml[s] = ok_ ? *(const f32x2*)(pml + 2 * (ps_ + s)) : (f32x2){-1e30f, 0.f}; \
            if (ok_) pw[s] = *(const u32x4*)(po + (ps_ + s) * 128 + 8 * dl); } } while (0)
    if (gw < total) P5_ISSUE(gw);
    for (int it = gw; it < total; it += NGW) {
        const int bh = it & 15, t = 4 * (it >> 4) + sub, b = bh >> 3, h = bh & 7, own = t >> 8, nsel = own < 3 ? own : 3;
        float M = -1e30f;
#pragma unroll
        for (int s = 0; s < 4; ++s) M = fmaxf(M, ml[s].x);
        float w[4], W = 0.f;
#pragma unroll
        for (int s = 0; s < 4; ++s) { w[s] = ml[s].y * __builtin_amdgcn_exp2f(ml[s].x - M); W += w[s]; }
        const float iw = 1.f / W;
        float o[8] = {0, 0, 0, 0, 0, 0, 0, 0};
#pragma unroll
        for (int s = 0; s < 4; ++s) { const bool ok = (s == 3) || (s < nsel);
            if (ok) { float f[8]; unpack8(pw[s], f); const float ws_ = w[s] * iw;
#pragma unroll
                for (int jj = 0; jj < 8; ++jj) o[jj] = fmaf(ws_, f[jj], o[jj]); } }
        if (it + NGW < total) P5_ISSUE(it + NGW);
        float ss = 0.f;
#pragma unroll
        for (int jj = 0; jj < 8; ++jj) ss = fmaf(o[jj], o[jj], ss);
        ss = reduce16(ss) * (1.f / 128.f);
        const float r = 1.f / sqrtf(ss + RMS_EPS);
        if (!ginv) { const float* gain = a.norm_moba + h * 128 + 8 * dl; g0 = *(const f32x4*)gain; g1 = *(const f32x4*)(gain + 4); }
        u32x4 wv; wv.x = pk2(o[0] * r * g0.x, o[1] * r * g0.y); wv.y = pk2(o[2] * r * g0.z, o[3] * r * g0.w); wv.z = pk2(o[4] * r * g1.x, o[5] * r * g1.y); wv.w = pk2(o[6] * r * g1.z, o[7] * r * g1.w);
        *(u32x4*)(mixed + (size_t)(b * SEQ + t) * D + 1024 + h * 128 + 8 * dl) = wv;
    }
#undef P5_ISSUE
}

constexpr int LNT_STRIDE = 2052;
__device__ __forceinline__ void ln1_load(const bf16* src, int lane, u32x2 (&w)[8]) {
    const GAS u32x2* xr = (const GAS u32x2*)src + lane;
#pragma unroll
    for (int j = 0; j < 8; ++j) w[j] = xr[64 * j];
}
#define LN1_OPAQUE(w) do { _Pragma("unroll") for (int j_ = 0; j_ < 8; ++j_) asm volatile("" : "+v"(w[j_].x), "+v"(w[j_].y)); } while (0)
__device__ __forceinline__ void ln1_row(u32x2 (&w)[8], const LAS float* gb, bf16* dst_bf16, unsigned char* dst_q, LAS float* trow, int lane) {
    float s = 0.f;
#pragma unroll
    for (int j = 0; j < 8; ++j) s += (bf_lo(w[j].x) + bf_hi(w[j].x)) + (bf_lo(w[j].y) + bf_hi(w[j].y));
    const float mean = wave_sum(s) * (1.f / D); float s2 = 0.f;
    LN1_OPAQUE(w);
#pragma unroll
    for (int j = 0; j < 8; ++j) { const float x0 = bf_lo(w[j].x) - mean, x1 = bf_hi(w[j].x) - mean, x2 = bf_lo(w[j].y) - mean, x3 = bf_hi(w[j].y) - mean; s2 += (x0 * x0 + x1 * x1) + (x2 * x2 + x3 * x3); }
    const float rstd = 1.f / sqrtf(wave_sum(s2) * (1.f / D) + LN_EPS);
    LN1_OPAQUE(w);
#pragma unroll
    for (int j = 0; j < 8; ++j) {
        const f32x4 gg = *(const LAS f32x4*)(gb + 4 * (lane + 64 * j)), bb = *(const LAS f32x4*)(gb + D + 4 * (lane + 64 * j));
        f32x4 y; y.x = (bf_lo(w[j].x) - mean) * rstd * gg.x + bb.x; y.y = (bf_hi(w[j].x) - mean) * rstd * gg.y + bb.y; y.z = (bf_lo(w[j].y) - mean) * rstd * gg.z + bb.z; y.w = (bf_hi(w[j].y) - mean) * rstd * gg.w + bb.w;
        *(LAS f32x4*)(trow + 4 * (lane + 64 * j)) = y; u32x2 o; o.x = pk2(y.x, y.y); o.y = pk2(y.z, y.w); ((GAS u32x2*)dst_bf16)[lane + 64 * j] = o;
        ((GAS unsigned*)dst_q)[lane + 64 * j] = pack_fp8x4(y.x * XSCALE, y.y * XSCALE, y.z * XSCALE, y.w * XSCALE); }
}
constexpr int LNP_OFF = 136192;
constexpr int LSUM_OFF = LNP_OFF + 8192;
constexpr int LBR_OFF = LSUM_OFF + 16 * 36 * 4;
constexpr int LGB1_OFF = LBR_OFF + 128;
static_assert(LGB1_OFF + 16384 <= LDS_BYTES, "gamma | beta");
__device__ __forceinline__ void router_top4(const Args& a, LAS unsigned char* lds, int r0, int lane) {
    int* rowtok = (int*)(a.ws + WS_ROWTOK); float* rowg = (float*)(a.ws + WS_ROWG); int* toksl = (int*)(a.ws + WS_TOKSL);
    unsigned* ecnt = (unsigned*)(a.ws + WS_CTL) + CW_ECNT;
    const LAS float* Pp = (const LAS float*)(lds + LNP_OFF); LAS float* Ls = (LAS float*)(lds + LSUM_OFF); const LAS float* Lb = (const LAS float*)(lds + LBR_OFF);
    const int row = lane & 15; const bool tl = lane < 16;
    { const int q = lane >> 4;
      f32x4 s0 = *(const LAS f32x4*)(Lb + 8 * q), s1 = *(const LAS f32x4*)(Lb + 8 * q + 4);
#pragma unroll
      for (int w = 0; w < 4; ++w) { if (w == 2) __builtin_amdgcn_sched_barrier(0); s0 += *(const LAS f32x4*)(Pp + (w * 16 + row) * 32 + 8 * q); s1 += *(const LAS f32x4*)(Pp + (w * 16 + row) * 32 + 8 * q + 4); }
      *(LAS f32x4*)(Ls + row * 36 + 8 * q) = s0; *(LAS f32x4*)(Ls + row * 36 + 8 * q + 4) = s1; }
    asm volatile("s_waitcnt lgkmcnt(0)" ::: "memory");
    float v0 = -INFINITY, v1 = -INFINITY, v2 = -INFINITY, v3 = -INFINITY; int e0 = 0, e1 = 0, e2 = 0, e3 = 0;
#pragma unroll
    for (int k = 0; k < 8; ++k) { if ((k & 3) == 0) __builtin_amdgcn_sched_barrier(0); const f32x4 gv = *(const LAS f32x4*)(Ls + row * 36 + 4 * k);
#pragma unroll
        for (int i = 0; i < 4; ++i) { const float g = gv[i]; const int e = 4 * k + i;
            const bool c0 = g > v0, c1 = g > v1, c2 = g > v2, c3 = g > v3;
            v3 = c2 ? v2 : (c3 ? g : v3); e3 = c2 ? e2 : (c3 ? e : e3);
            v2 = c1 ? v1 : (c2 ? g : v2); e2 = c1 ? e1 : (c2 ? e : e2);
            v1 = c0 ? v0 : (c1 ? g : v1); e1 = c0 ? e0 : (c1 ? e : e1);
            v0 = c0 ? g : v0; e0 = c0 ? e : e0; } }
    const float p1 = __expf(v1 - v0), p2 = __expf(v2 - v0), p3 = __expf(v3 - v0), inv = 1.f / (1.f + p1 + p2 + p3);
    const unsigned long long ltmask = (1ull << lane) - 1ull;
    int mycount = 0, r0k = 0, r1k = 0, r2k = 0, r3k = 0;
    for (int e = 0; e < 32; ++e) {
        const unsigned long long mk = __builtin_amdgcn_ballot_w64(tl && (e0 == e || e1 == e || e2 == e || e3 == e));
        const int c = __builtin_popcountll(mk), rk = __builtin_popcountll(mk & ltmask);
        if (lane == e) mycount = c;
        if (e0 == e) r0k = rk; if (e1 == e) r1k = rk; if (e2 == e) r2k = rk; if (e3 == e) r3k = rk;
    }
    int basev = 0;
    { int ln = lane; asm volatile("" : "+v"(ln));
      if (ln < 32 && mycount > 0) basev = (int)__hip_atomic_fetch_add(ecnt + 32 * ln, (unsigned)mycount, RLX_AGENT); }
    const int q0 = __shfl(basev, e0) + r0k, q1 = __shfl(basev, e1) + r1k, q2 = __shfl(basev, e2) + r2k, q3 = __shfl(basev, e3) + r3k;
    if (tl) {
        const int tok = r0 + lane;
        rowtok[e0 * ECAP + q0] = tok; rowg[e0 * ECAP + q0] = inv;
        rowtok[e1 * ECAP + q1] = tok; rowg[e1 * ECAP + q1] = p1 * inv;
        rowtok[e2 * ECAP + q2] = tok; rowg[e2 * ECAP + q2] = p2 * inv;
        rowtok[e3 * ECAP + q3] = tok; rowg[e3 * ECAP + q3] = p3 * inv;
        int4 sl; sl.x = (e0 << 16) | q0; sl.y = (e1 << 16) | q1; sl.z = (e2 << 16) | q2; sl.w = (e3 << 16) | q3;
        *(int4*)(toksl + 4 * tok) = sl;
    }
}
__device__ __forceinline__ void p7_ln1_router(const Args& a, LAS unsigned char* lds, int vcu, int G, int wave, int lane_) {
    const int lane = lane_;
    const bf16* hh = (const bf16*)(a.ws + WS_H); bf16* x1b = (bf16*)(a.ws + WS_X1B); unsigned char* x1q = (unsigned char*)(a.ws + WS_X1Q);
    LAS float* T = (LAS float*)(lds + RING_OFF); LAS float* Pp = (LAS float*)(lds + LNP_OFF);
    const int n16 = lane & 15, kq = lane >> 4;
    LAS float* gb = (LAS float*)(lds + LGB1_OFF);
    { const int tid = wave * 64 + lane;
      for (int i = tid; i < D / 4; i += 512) { *(LAS f32x4*)(gb + 4 * i) = ((const GAS f32x4*)a.ln1_g)[i]; *(LAS f32x4*)(gb + D + 4 * i) = ((const GAS f32x4*)a.ln1_b)[i]; }
      if (tid < 8) *(LAS f32x4*)(lds + LBR_OFF + 16 * tid) = ((const GAS f32x4*)a.b_router)[tid]; }
    constexpr int NRR = 4;
    float breg[64 - NRR][2];
#pragma unroll
    for (int sI = NRR; sI < 64; ++sI) { const float* bp = a.w_router + (size_t)(256 * wave + 4 * sI + kq) * NE + n16; breg[sI - NRR][0] = bp[0]; breg[sI - NRR][1] = bp[16]; }
    const bool has3 = wave == 4;
    const int rl0 = 2 * (wave - 1), rl2 = 14;
    u32x2 raw[2][8]; unsigned touch = 0u;
    if (wave != 0 && vcu < M / 16) {
        ln1_load(hh + (size_t)(vcu * 16 + rl0) * D, lane, raw[0]); ln1_load(hh + (size_t)(vcu * 16 + rl0 + 1) * D, lane, raw[1]);
        if (has3) touch = *(const GAS unsigned*)((const unsigned char*)(hh + (size_t)(vcu * 16 + 14) * D) + 128 * lane); }
    __syncthreads();
    int prev_r0 = -1;
    for (int tile = vcu;; tile += G) {
        const bool has = tile < M / 16;
        const int r0 = tile * 16;
        if (wave == 0) { const unsigned pb72 = pb_begin(72); int lane = lane_; asm volatile("" : "+v"(lane)); if (prev_r0 >= 0) router_top4(a, lds, prev_r0, lane); pb_end(72, pb72); }
        else if (has) { const unsigned pb73 = pb_begin(73);
            asm volatile("" :: "v"(touch));
            int lane = lane_; asm volatile("" : "+v"(lane));
            ln1_row(raw[0], gb, x1b + (size_t)(r0 + rl0) * D, x1q + (size_t)(r0 + rl0) * D, T + rl0 * LNT_STRIDE, lane);
            if (has3) ln1_load(hh + (size_t)(r0 + rl2) * D, lane, raw[0]);
            ln1_row(raw[1], gb, x1b + (size_t)(r0 + rl0 + 1) * D, x1q + (size_t)(r0 + rl0 + 1) * D, T + (rl0 + 1) * LNT_STRIDE, lane);
            if (has3) { ln1_load(hh + (size_t)(r0 + rl2 + 1) * D, lane, raw[1]);
                ln1_row(raw[0], gb, x1b + (size_t)(r0 + rl2) * D, x1q + (size_t)(r0 + rl2) * D, T + rl2 * LNT_STRIDE, lane);
                ln1_row(raw[1], gb, x1b + (size_t)(r0 + rl2 + 1) * D, x1q + (size_t)(r0 + rl2 + 1) * D, T + (rl2 + 1) * LNT_STRIDE, lane); }
            pb_end(73, pb73); }
        if (!has) break;
        asm volatile("s_waitcnt lgkmcnt(0)\n\ts_barrier" ::: "memory");
        const unsigned pb74 = pb_begin(74);
        float bt[NRR][2];
        { int kqo = kq; asm volatile("" : "+v"(kqo)); const float* bp = a.w_router + (size_t)(256 * wave + kqo) * NE + n16;
#pragma unroll
          for (int sI = 0; sI < NRR; ++sI) { bt[sI][0] = bp[4 * sI * NE]; bt[sI][1] = bp[4 * sI * NE + 16]; } }
        __builtin_amdgcn_sched_barrier(0);
        if (wave != 0 && tile + G < M / 16) { const bf16* nx = hh + (size_t)(r0 + 16 * G) * D;
            ln1_load(nx + (size_t)rl0 * D, lane, raw[0]); ln1_load(nx + (size_t)(rl0 + 1) * D, lane, raw[1]);
            if (has3) { int lo = lane_; asm volatile("" : "+v"(lo)); touch = *(const GAS unsigned*)((const unsigned char*)(nx + (size_t)14 * D) + 128 * lo); } }
        __builtin_amdgcn_sched_barrier(0);
        f32x4 acc0 = {0.f, 0.f, 0.f, 0.f}, acc1 = {0.f, 0.f, 0.f, 0.f};
        const LAS float* ap = T + n16 * LNT_STRIDE + 256 * wave + kq;
#pragma unroll
        for (int sI = NRR; sI < 64; ++sI) { if ((sI & 7) == (NRR & 7)) __builtin_amdgcn_sched_barrier(0);
            const float av = ap[4 * sI];
            acc0 = __builtin_amdgcn_mfma_f32_16x16x4f32(av, breg[sI - NRR][0], acc0, 0, 0, 0);
            acc1 = __builtin_amdgcn_mfma_f32_16x16x4f32(av, breg[sI - NRR][1], acc1, 0, 0, 0); }
        __builtin_amdgcn_sched_barrier(0);
#pragma unroll
        for (int sI = 0; sI < NRR; ++sI) { const float av = ap[4 * sI];
            acc0 = __builtin_amdgcn_mfma_f32_16x16x4f32(av, bt[sI][0], acc0, 0, 0, 0);
            acc1 = __builtin_amdgcn_mfma_f32_16x16x4f32(av, bt[sI][1], acc1, 0, 0, 0); }
        { LAS float* pw = Pp + ((wave & 3) * 16 + 4 * kq) * 32 + n16;
          if (wave >= 4) {
#pragma unroll
              for (int i = 0; i < 4; ++i) { pw[i * 32] = acc0[i]; pw[i * 32 + 16] = acc1[i]; } }
          asm volatile("s_waitcnt lgkmcnt(0)\n\ts_barrier" ::: "memory");
          if (wave < 4) {
#pragma unroll
              for (int i = 0; i < 4; ++i) { pw[i * 32] = acc0[i] + pw[i * 32]; pw[i * 32 + 16] = acc1[i] + pw[i * 32 + 16]; } } }
        pb_end(74, pb74);
        asm volatile("s_waitcnt lgkmcnt(0)\n\ts_barrier" ::: "memory");
        prev_r0 = r0;
    }
    __syncthreads();
}

__device__ __forceinline__ void p9_ln2(const Args& a, LAS unsigned char* lds, const LAS int* tab, int gw, int NGW, int lane) {
    const bf16* x1b = (const bf16*)(a.ws + WS_X1B); const unsigned char* Y = (const unsigned char*)(a.ws + WS_Y); const int* toksl = (const int*)(a.ws + WS_TOKSL);
    bf16* x2b = (bf16*)(a.ws + WS_X2B); unsigned char* x2q = (unsigned char*)(a.ws + WS_X2Q);
    LAS float* gb = (LAS float*)(lds + RING_OFF);
    for (int i = threadIdx.x; i < D / 4; i += 512) { *(LAS f32x4*)(gb + 4 * i) = ((const GAS f32x4*)a.ln2_g)[i]; *(LAS f32x4*)(gb + D + 4 * i) = ((const GAS f32x4*)a.ln2_b)[i]; }
    __syncthreads();
    u32x2 xw[8]; unsigned yw[4][8]; int4 sln = {0, 0, 0, 0};
#define LN2_ISSUE(mm, sl_) do { const int4 s_ = (sl_); const size_t r0_ = (size_t)(tab[s_.x >> 16] * 256 + (s_.x & 0xffff)), r1_ = (size_t)(tab[s_.y >> 16] * 256 + (s_.y & 0xffff)), \
        r2_ = (size_t)(tab[s_.z >> 16] * 256 + (s_.z & 0xffff)), r3_ = (size_t)(tab[s_.w >> 16] * 256 + (s_.w & 0xffff)); \
        const GAS u32x2* xr_ = (const GAS u32x2*)(x1b + (size_t)(mm) * D) + lane; \
        _Pragma("unroll") for (int j = 0; j < 8; ++j) { xw[j] = xr_[64 * j]; \
            yw[0][j] = ((const GAS unsigned*)(Y + r0_ * D))[lane + 64 * j]; yw[1][j] = ((const GAS unsigned*)(Y + r1_ * D))[lane + 64 * j]; \
            yw[2][j] = ((const GAS unsigned*)(Y + r2_ * D))[lane + 64 * j]; yw[3][j] = ((const GAS unsigned*)(Y + r3_ * D))[lane + 64 * j]; } } while (0)
    if (gw < M) { const int4 sl0 = *(const int4*)(toksl + 4 * gw); LN2_ISSUE(gw, sl0); if (gw + NGW < M) sln = *(const int4*)(toksl + 4 * (gw + NGW)); }
    for (int m = gw; m < M; m += NGW) {
        f32x4 v[8]; float s = 0.f;
#pragma unroll
        for (int j = 0; j < 8; ++j) { f32x4 t; t.x = bf_lo(xw[j].x) * DN_ALPHA; t.y = bf_hi(xw[j].x) * DN_ALPHA; t.z = bf_lo(xw[j].y) * DN_ALPHA; t.w = bf_hi(xw[j].y) * DN_ALPHA;
#pragma unroll
            for (int k = 0; k < 4; ++k) { const unsigned w = yw[k][j]; const f32x2 lo = __builtin_amdgcn_cvt_pk_f32_fp8(w, false), hi = __builtin_amdgcn_cvt_pk_f32_fp8(w, true);
                t.x = fmaf(lo.x, 1.f / YSCALE, t.x); t.y = fmaf(lo.y, 1.f / YSCALE, t.y); t.z = fmaf(hi.x, 1.f / YSCALE, t.z); t.w = fmaf(hi.y, 1.f / YSCALE, t.w); }
            v[j] = t; s += (t.x + t.y) + (t.z + t.w); }
        if (m + NGW < M) { LN2_ISSUE(m + NGW, sln); if (m + 2 * NGW < M) sln = *(const int4*)(toksl + 4 * (m + 2 * NGW)); }
        const float mean = wave_sum(s) * (1.f / D); float s2 = 0.f;
#pragma unroll
        for (int j = 0; j < 8; ++j) { v[j] = v[j] - mean; s2 += (v[j].x * v[j].x + v[j].y * v[j].y) + (v[j].z * v[j].z + v[j].w * v[j].w); }
        const float rstd = 1.f / sqrtf(wave_sum(s2) * (1.f / D) + LN_EPS);
#pragma unroll
        for (int j = 0; j < 8; ++j) { const f32x4 gg = *(const LAS f32x4*)(gb + 4 * (lane + 64 * j)), bb = *(const LAS f32x4*)(gb + D + 4 * (lane + 64 * j)); const f32x4 y = v[j] * rstd * gg + bb;
            u32x2 o; o.x = pk2(y.x, y.y); o.y = pk2(y.z, y.w); ((GAS u32x2*)(x2b + (size_t)m * D))[lane + 64 * j] = o;
            ((GAS unsigned*)(x2q + (size_t)m * D))[lane + 64 * j] = pack_fp8x4(y.x * XSCALE, y.y * XSCALE, y.z * XSCALE, y.w * XSCALE); }
    }
#undef LN2_ISSUE
    __syncthreads();
}

#ifndef REP_PHASE
#define REP_PHASE (-1)
#endif
constexpr int NPHASE = 13;
__global__ void __launch_bounds__(512, 2) fwd_kernel(Args args) {
    extern __shared__ __attribute__((aligned(16))) unsigned char lds_raw[];
    LAS unsigned char* lds = (LAS unsigned char*)lds_raw;
    volatile LAS unsigned* MISC = (volatile LAS unsigned*)(lds + MISC_OFF);
    const int tid = threadIdx.x, lane = tid & 63, wave = __builtin_amdgcn_readfirstlane(tid >> 6);
    const int G = gridDim.x; const int bx = blockIdx.x;
    const int vcu = (G % 8 == 0) ? (bx % 8) * (G / 8) + bx / 8 : bx;
    const int gw = vcu * 8 + wave, NGW = G * 8;
    unsigned char* ws = args.ws;
    unsigned* ctl = (unsigned*)(ws + WS_CTL);
    for (int u = tid; u < (LDS_BYTES - LDSCTL_OFF) / 4; u += 512) ((LAS unsigned*)(lds + LDSCTL_OFF))[u] = 0u;
    __syncthreads();
    const int lo = args.ph_lo, hi = args.ph_hi;
    const bool use_bar = (hi - lo) > 1;
    XcdBarrier bar; bar.bar = ctl + CW_BAR; bar.x = 0; bar.st = nullptr;
    if (use_bar) bar = xcd_barrier_post(ctl + CW_BAR, MISC + 8);
#ifdef ONLY_PHASE
#define IN(k) ((k) == ONLY_PHASE)
#else
#define IN(k) (lo <= (k) && (k) < hi)
#endif
#define SEAM(k) do { if (IN(k) && IN((k) + 1)) xcd_barrier(bar); } while (0)
    LAS int* moetab = (LAS int*)(lds + MOE_OFF);
    const bool cvon = (NGW == CV_LISTS);
    const bool cvfirst = ((bx >> 3) & 1) == 0;
    const int len_up = cvon ? cv_list_len(gw, CV_UP_END) : 0, len_all = cvon ? cv_list_len(gw, CV_BLOCKS) : 0;

    if (IN(0)) { const unsigned pbp_ = pb_begin(100); p0_prologue(args, lds, gw, NGW, wave, lane); pb_end(100, pbp_); SEAM(0); }
    if (IN(1)) { const unsigned pbp_ = pb_begin(101);
        if (cvon && cvfirst) cv_range(args, gw, 0, len_up, lane);
        { pg8::Gemm g{(const bf16*)(ws + WS_XB), (const bf16*)(ws + WS_WINT), D, 0, nullptr}; DenseSched S; S.init(M, NQKV, G, bx);
          EpiQKV E{(bf16*)(ws + WS_QKV), NQKV, true, (float*)(ws + WS_KMEAN)};
          pg8::gemm_phase<EpiQKV, DenseSched, false, true>(lds + RING_OFF, g, S, E); }
        { pg8::Gemm g{(const bf16*)(ws + WS_PB), (const bf16*)(ws + WS_WPLET), PLE, 0, nullptr}; DenseSched S; S.init(M, D, G, bx);
          EpiQKV E{(bf16*)(ws + WS_PLEB), D, false, nullptr};
          pg8::gemm_phase<EpiQKV, DenseSched, false, true>(lds + RING_OFF, g, S, E); }
        if (cvon && !cvfirst) cv_range(args, gw, 0, len_up, lane);
        pb_end(101, pbp_); SEAM(1);
    }
    if (IN(3)) { const unsigned pbp_ = pb_begin(103); p3_sb_and_gate(args, lds, G, bx, gw, NGW, lane); pb_end(103, pbp_); SEAM(3); }
    if (IN(4)) { const unsigned pbp_ = pb_begin(104); p4_moba(args, lds, G, bx); pb_end(104, pbp_); SEAM(4); }
    if (IN(5)) { const unsigned pbp_ = pb_begin(105); p5_combine(args, gw, NGW, lane); pb_end(105, pbp_); SEAM(5); }
    if (IN(6)) { const unsigned pbp_ = pb_begin(106);
        pg8::Gemm g{(const bf16*)(ws + WS_MIXED), (const bf16*)(ws + WS_WOUTT), D, 0, nullptr}; DenseSched S; S.init(M, D, G, bx);
        EpiH E{(const bf16*)(ws + WS_XB), (bf16*)(ws + WS_H)};
        pg8::gemm_phase<EpiH, DenseSched, false, true>(lds + RING_OFF, g, S, E);
        pb_end(106, pbp_); SEAM(6);
    }
    if (IN(7)) { const unsigned pbp_ = pb_begin(107); p7_ln1_router(args, lds, vcu, G, wave, lane); pb_end(107, pbp_); SEAM(7); }
    if (IN(8)) {
        if (!cvon) { for (int blk = gw; blk < CV_BLOCKS; blk += NGW) { P0Job j0; int it0; p0_locate_b(args, 2 * blk, j0, it0); f32x4 v0[16]; cv_load(j0, it0 >> 1, lane, v0); cv_store(j0, it0 >> 1, lane, v0); } SEAM(8); }
    }
    if (IN(9)) { const unsigned pbp_ = pb_begin(109);
        if (cvon && !cvfirst) cv_range(args, gw, len_up, len_all, lane);
        moe_table(moetab, ctl + CW_ECNT);
        pg8::Gemm g{(const bf16*)(ws + WS_X1Q), (const bf16*)(ws + WS_WUPT), D / 2, (size_t)2 * DFF * D / 2, (const int*)(ws + WS_ROWTOK)};
        MoeSched S{moetab, 2 * DFF / 256, G, bx};
        EpiUp E{(unsigned char*)(ws + WS_ACT), (const float*)(ws + WS_BUPP)};
        pg8::gemm_phase<EpiUp, MoeSched, true, true, true>(lds + RING_OFF, g, S, E);
        if (cvon && cvfirst) cv_range(args, gw, len_up, len_all, lane);
        pb_end(109, pbp_); SEAM(9);
    }
    if (IN(10)) { const unsigned pbp_ = pb_begin(110);
        moe_table(moetab, ctl + CW_ECNT);
        pg8::Gemm g{(const bf16*)(ws + WS_ACT), (const bf16*)(ws + WS_WDNT), DFF / 2, (size_t)D * DFF / 2, nullptr};
        MoeSched S{moetab, D / 256, G, bx};
        EpiDown E{(unsigned char*)(ws + WS_Y), args.b_down, (const float*)(ws + WS_ROWG)};
        pg8::gemm_phase<EpiDown, MoeSched, false, true, true>(lds + RING_OFF, g, S, E);
        pb_end(110, pbp_); SEAM(10);
    }
    if (IN(11)) { const unsigned pbp_ = pb_begin(111); moe_table(moetab, ctl + CW_ECNT); p9_ln2(args, lds, moetab, gw, NGW, lane); pb_end(111, pbp_); SEAM(11); }
    if (IN(12)) { const unsigned pbp_ = pb_begin(112);
        pg8::Gemm g{(const bf16*)(ws + WS_X2Q), (const bf16*)(ws + WS_WGT), D / 2, 0, nullptr}; DenseSched S; S.init(M, D, G, bx);
        EpiOut E{args.out, args.b_ple_gate, (const bf16*)(ws + WS_PLEB), (const bf16*)(ws + WS_X2B)};
        pg8::gemm_phase<EpiOut, DenseSched, false, true, true>(lds + RING_OFF, g, S, E);
        pb_end(112, pbp_);
    }
#undef IN
#undef SEAM
}

#ifndef N_LAUNCHES
#define N_LAUNCHES 1
#endif
extern "C" void kernel_launch(void* const* d_in, const int* in_sizes, int n_in, void* d_out, int out_size, void* d_ws, size_t ws_size, hipStream_t stream) {
    static int grid = 0;
    if (grid == 0) {
        if (n_in != 19 || in_sizes[0] != M * D || out_size != M * D || ws_size < WS_END) { fprintf(stderr, "kernel_launch: unexpected shapes: n_in %d in0 %d out %d ws %zu (need %zu)\n", n_in, n_in > 0 ? in_sizes[0] : -1, out_size, ws_size, (size_t)WS_END); grid = -1; return; }
        int dev = 0, cus = 0, per_cu = 0;
        if (hipGetDevice(&dev) != hipSuccess || hipDeviceGetAttribute(&cus, hipDeviceAttributeMultiprocessorCount, dev) != hipSuccess) { grid = -1; return; }
        if (hipFuncSetAttribute((const void*)fwd_kernel, hipFuncAttributeMaxDynamicSharedMemorySize, LDS_BYTES) != hipSuccess) { fprintf(stderr, "kernel_launch: hipFuncSetAttribute failed\n"); grid = -1; return; }
        if (hipOccupancyMaxActiveBlocksPerMultiprocessor(&per_cu, (const void*)fwd_kernel, 512, LDS_BYTES) != hipSuccess || per_cu < 1) fprintf(stderr, "kernel_launch: occupancy query says %d\n", per_cu);
        (void)hipGetLastError();
        grid = cus;
    }
    if (grid < 0) return;
    if (hipMemsetAsync((char*)d_ws + WS_CTL, 0, CTL_ZERO_BYTES, stream) != hipSuccess) { fprintf(stderr, "kernel_launch: memset failed\n"); return; }
    Args a{};
    a.x = (const float*)d_in[0]; a.p = (const float*)d_in[1]; a.w_in = (const float*)d_in[2]; a.norm_sb = (const float*)d_in[3]; a.norm_moba = (const float*)d_in[4];
    a.w_out = (const float*)d_in[5]; a.ln1_g = (const float*)d_in[6]; a.ln1_b = (const float*)d_in[7]; a.w_router = (const float*)d_in[8]; a.b_router = (const float*)d_in[9];
    a.w_up = (const float*)d_in[10]; a.b_up = (const float*)d_in[11]; a.w_down = (const float*)d_in[12]; a.b_down = (const float*)d_in[13]; a.ln2_g = (const float*)d_in[14]; a.ln2_b = (const float*)d_in[15];
    a.w_ple = (const float*)d_in[16]; a.w_ple_gate = (const float*)d_in[17]; a.b_ple_gate = (const float*)d_in[18];
    a.out = (float*)d_out; a.ws = (unsigned char*)d_ws;
    if (N_LAUNCHES == 1) { a.ph_lo = 0; a.ph_hi = NPHASE; hipLaunchKernelGGL(fwd_kernel, dim3(grid), dim3(512), LDS_BYTES, stream, a); }
    else for (int li = 0; li < NPHASE; ++li) { a.ph_lo = li; a.ph_hi = li + 1; hipLaunchKernelGGL(fwd_kernel, dim3(grid), dim3(512), LDS_BYTES, stream, a); }
    const hipError_t le = hipPeekAtLastError();
    if (le != hipSuccess) fprintf(stderr, "kernel_launch: launch failed: %s\n", hipGetErrorName(le));
}
```

```cpp
#include <hip/hip_runtime.h>
#include <cstdio>
#include <cstdint>
#include <cmath>

#define GAS __attribute__((address_space(1)))
#define LAS __attribute__((address_space(3)))
typedef unsigned short bf16;
typedef unsigned short bf16_t;
typedef short bf16x8 __attribute__((ext_vector_type(8)));
typedef float f32x4 __attribute__((ext_vector_type(4)));
typedef float f32x2 __attribute__((ext_vector_type(2)));
typedef float f32x16 __attribute__((ext_vector_type(16)));
typedef unsigned u32x4 __attribute__((ext_vector_type(4)));
typedef unsigned u32x2 __attribute__((ext_vector_type(2)));
typedef GAS unsigned gu32;
#define RLX_AGENT __ATOMIC_RELAXED, __HIP_MEMORY_SCOPE_AGENT
#define LDS_WAIT() asm volatile("s_waitcnt lgkmcnt(0)" ::: "memory")
#define VM_WAIT() asm volatile("s_waitcnt vmcnt(0)" ::: "memory")

#ifndef PROBE_ID
#define PROBE_ID 0
#endif
__device__ __forceinline__ unsigned pb_begin(int id) { return (PROBE_ID == id) ? (unsigned)__builtin_amdgcn_readfirstlane((int)(unsigned)__builtin_amdgcn_s_memrealtime()) : 0u; }
__device__ __forceinline__ void pb_end(int id, unsigned t0) {
    if (PROBE_ID == id) { const unsigned t1 = (unsigned)__builtin_amdgcn_s_memrealtime(), dt = t1 - t0; while ((unsigned)__builtin_amdgcn_s_memrealtime() - t1 < dt) __builtin_amdgcn_s_sleep(8); }
}
constexpr int BATCH = 2, SEQ = 8192, M = BATCH * SEQ, D = 2048, NQKV = 6144, HD = 128, NH = 8, NE = 32, TOPK = 4, DFF = 2048, PLE = 256;
constexpr int ECAP = 16384;
constexpr int ACT_ROWS = M * TOPK + NE * 256;
constexpr float LN_EPS = 1e-5f, RMS_EPS = 1e-6f;
constexpr float DN_ALPHA = 1.189207115002721f;
constexpr float LOG2E = 1.4426950408889634f;
constexpr float QSCALE = 0.08838834764831845f * LOG2E;
constexpr float SWIGLU_LIMIT = 7.0f, SWIGLU_ALPHA = 1.702f;
constexpr float YSCALE = 64.f;
constexpr float WSCALE = 512.f, XSCALE = 16.f, ASCALE = 8.f, UP_DESCALE = 1.f / (512.f * 16.f), DN_DESCALE = 1.f / (512.f * 8.f);

constexpr size_t MiB = 1u << 20;
constexpr size_t WS_CTL = 0, CTL_ZERO_BYTES = 1 * MiB;
constexpr size_t WS_WINT = 2 * MiB, WS_WOUTT = 26 * MiB, WS_WGT = 34 * MiB, WS_WPLET = 42 * MiB, WS_BUPP = 43 * MiB, WS_KMEAN = 44 * MiB;
constexpr size_t WS_XB = 48 * MiB, WS_PB = 112 * MiB, WS_QKV = 128 * MiB, WS_MIXED = 320 * MiB, WS_H = 384 * MiB, WS_X1 = 512 * MiB, WS_X1B = 640 * MiB;
constexpr size_t WS_PLEB = 704 * MiB, WS_ROWTOK = 768 * MiB, WS_ROWG = 770 * MiB, WS_TOKSL = 772 * MiB, WS_X2B = 776 * MiB;
constexpr size_t WS_ACT = 840 * MiB, WS_Y = 1128 * MiB, WS_WUPT = 1416 * MiB, WS_WDNT = 1928 * MiB;
constexpr size_t WS_MLIST = 2184 * MiB, WS_MPO = 2200 * MiB, WS_MPML = 2328 * MiB, WS_X1Q = 2336 * MiB, WS_X2Q = 2368 * MiB, WS_END = 2400 * MiB;
static_assert((size_t)ACT_ROWS * DFF * 2 <= 288 * MiB, "act rows");
constexpr int CW_TMO = 0, CW_CODE = 1;
constexpr int CW_BAR = 4096;
constexpr int CW_MCNT = 32768;
constexpr int CW_DONE = 49152;
constexpr int CW_CUR = 53248;
constexpr int CW_ECNT = 16384;

constexpr int RING_OFF = 0, RING_BYTES = 131072;
constexpr int LDSCTL_OFF = 135168;
constexpr int MISC_OFF = LDSCTL_OFF;
constexpr int MOE_OFF = LDSCTL_OFF + 256;
constexpr int LDS_BYTES = 163840;

__device__ __forceinline__ unsigned f2bf(float f) { unsigned r; asm("v_cvt_pk_bf16_f32 %0, %1, %1" : "=v"(r) : "v"(f)); return r & 0xffffu; }
__device__ __forceinline__ unsigned pk2(float lo, float hi) { unsigned r; asm("v_cvt_pk_bf16_f32 %0, %1, %2" : "=v"(r) : "v"(lo), "v"(hi)); return r; }
__device__ __forceinline__ float bf_lo(unsigned w) { return __builtin_bit_cast(float, w << 16); }
__device__ __forceinline__ float bf_hi(unsigned w) { return __builtin_bit_cast(float, w & 0xffff0000u); }

__device__ __forceinline__ float clamp448(float v) { return __builtin_amdgcn_fmed3f(v, -448.f, 448.f); }
__device__ __forceinline__ unsigned pack_fp8x4(float a, float b, float c, float d) {
    unsigned w = 0; w = __builtin_amdgcn_cvt_pk_fp8_f32(clamp448(a), clamp448(b), w, false); w = __builtin_amdgcn_cvt_pk_fp8_f32(clamp448(c), clamp448(d), w, true); return w;
}

__device__ __forceinline__ unsigned pack_fp8x4_nc(float a, float b, float c, float d) {
    unsigned w = 0; w = __builtin_amdgcn_cvt_pk_fp8_f32(a, b, w, false); w = __builtin_amdgcn_cvt_pk_fp8_f32(c, d, w, true); return w;
}

namespace pg8 {
constexpr bool DMA_IN_MMA = false;
constexpr bool BAL_DMA = true;
constexpr int BM = 256, BK = 64, HALF = 128, HTB = HALF * BK * 2, STAGE_BYTES = 8 * HTB;
__host__ __device__ __forceinline__ int lds_byte(int r, int c) { const int st = (r >> 4) * 2 + (c >> 5), rr = r & 15, cc = c & 31, ob = rr * 64 + cc * 2; return st * 1024 + (ob ^ (((ob >> 9) & 1) << 5)); }
__host__ __device__ __forceinline__ void stage_rc(int b, int& R, int& C) { const int st = b / 1024, sb = b % 1024, swz = sb ^ (((sb >> 9) & 1) << 5); R = (st >> 1) * 16 + swz / 64; C = (st & 1) * 32 + (swz % 64) / 2; }
__host__ __device__ __forceinline__ int q_f(int r) { return ((r >> 1) & 1) | (((r >> 3) & 1) << 2); }
__host__ __device__ __forceinline__ int lds_byte_q(int r, int c16) { return r * 128 + 16 * (c16 ^ q_f(r & 15)); }
__host__ __device__ __forceinline__ void stage_rc_q(int b, int& R, int& C) { const int s = b >> 4; R = s >> 3; C = 8 * ((s & 7) ^ q_f(R & 15)); }
__host__ __device__ __forceinline__ int perm32(int rho) { const int n = rho >> 4, i = rho & 15; return 8 * (i >> 2) + 4 * n + (i & 3); }

struct Unit { int pm, pn, e, tab, cnt; };
struct Gemm { const bf16_t* A; const bf16_t* Bt; int K; size_t bstride; const int* rowtab; };

__device__ __forceinline__ unsigned cvt_pk_bf16(float lo, float hi) { unsigned r; asm volatile("v_cvt_pk_bf16_f32 %0, %1, %2" : "=v"(r) : "v"(lo), "v"(hi)); return r; }

typedef int v8i __attribute__((ext_vector_type(8)));
typedef int v8i_u __attribute__((ext_vector_type(8), aligned(16)));
template <class Epi, class Sched, bool GATHER, bool ALIGN_EPI, bool FP8 = false>
__device__ __forceinline__ void gemm_phase(LAS unsigned char* lds, const Gemm g, const Sched& S, const Epi& E) {
    const int tid = threadIdx.x, wid = __builtin_amdgcn_readfirstlane(tid >> 6), lane = tid & 63, wr = wid >> 2, wc = wid & 3, fr = lane & 15, fq = lane >> 4;
    const int K = g.K, nt = K / BK;
    unsigned voffA[2], voffB[2]; int RA[2], CA[2];
#pragma unroll
    for (int i = 0; i < 2; ++i) { int R, C; if constexpr (FP8) stage_rc_q(tid * 16 + i * 8192, R, C); else stage_rc(tid * 16 + i * 8192, R, C); const int Rb = Epi::PERM ? ((R & ~31) + perm32(R & 31)) : R;
        voffA[i] = (unsigned)(R * K + C) * 2u; voffB[i] = (unsigned)(Rb * K + C) * 2u; RA[i] = R; CA[i] = C; }
    const size_t kstep = (size_t)(BK * 2);
    const size_t hstep = (size_t)HALF * K * 2;
    const size_t tstep = 2 * hstep;
    const unsigned ldsw = (unsigned)wid * 1024u;
    const int aoff = lds_byte(wr * 64 + fr, fq * 8), boff = lds_byte(wc * 32 + fr, fq * 8);
    const int aoq0 = lds_byte_q(wr * 64 + fr, 2 * fq), aoq1 = lds_byte_q(wr * 64 + fr, 2 * fq + 1), boq0 = lds_byte_q(wc * 32 + fr, 2 * fq), boq1 = lds_byte_q(wc * 32 + fr, 2 * fq + 1);
#define PG8_SA(b, h) (((b) * 2 + (h)) * HTB)
#define PG8_SB(b, h) ((4 + (b) * 2 + (h)) * HTB)
#define PG8_STAGE(bufoff, gbase, voff) do { _Pragma("unroll") for (int _i = 0; _i < 2; ++_i) { unsigned keep_; \
        asm volatile("s_mov_b32 %0, m0\n\ts_mov_b32 m0, %3\n\ts_nop 0\n\tglobal_load_lds_dwordx4 %1, %2\n\ts_mov_b32 m0, %0" \
            : "=&s"(keep_) : "v"((voff)[_i]), "s"((const char*)(gbase)), "s"((unsigned)(uintptr_t)(lds + (bufoff) + _i * 8192) + ldsw) : "memory"); } } while (0)
#define PG8_LDQ(dst, base, o0, o1) do { const u32x4 lo_ = *(const LAS u32x4*)(lds + (base) + (o0)), hi_ = *(const LAS u32x4*)(lds + (base) + (o1)); \
        dst = (v8i){(int)lo_.x, (int)lo_.y, (int)lo_.z, (int)lo_.w, (int)hi_.x, (int)hi_.y, (int)hi_.z, (int)hi_.w}; } while (0)
#define PG8_LDA(dst, b, h) do { if constexpr (FP8) { _Pragma("unroll") for (int m = 0; m < 4; ++m) PG8_LDQ(dst##q[m], PG8_SA(b, h) + m * 2048, aoq0, aoq1); } \
        else { _Pragma("unroll") for (int m = 0; m < 4; ++m) _Pragma("unroll") for (int k = 0; k < 2; ++k) dst[m][k] = *(const LAS bf16x8*)(lds + PG8_SA(b, h) + aoff + m * 2048 + k * 1024); } } while (0)
#define PG8_LDB(dst, b, h) do { if constexpr (FP8) { _Pragma("unroll") for (int n = 0; n < 2; ++n) PG8_LDQ(dst##q[n], PG8_SB(b, h) + n * 2048, boq0, boq1); } \
        else { _Pragma("unroll") for (int n = 0; n < 2; ++n) _Pragma("unroll") for (int k = 0; k < 2; ++k) dst[n][k] = *(const LAS bf16x8*)(lds + PG8_SB(b, h) + boff + n * 2048 + k * 1024); } } while (0)
#define PG8_MMA(ai, bj, At, Bt) do { __builtin_amdgcn_s_setprio(1); if constexpr (FP8) { _Pragma("unroll") for (int m = 0; m < 4; ++m) _Pragma("unroll") for (int n = 0; n < 2; ++n) \
            asm volatile("v_mfma_scale_f32_16x16x128_f8f6f4 %0, %1, %2, %0, %3, %3 op_sel_hi:[0,0,0]" : "+v"(acc[ai][bj][m][n]) : "v"(Bt##q[n]), "v"(At##q[m]), "v"(one_scale)); } \
        else { _Pragma("unroll") for (int m = 0; m < 4; ++m) _Pragma("unroll") for (int n = 0; n < 2; ++n) _Pragma("unroll") for (int k = 0; k < 2; ++k) \
            acc[ai][bj][m][n] = __builtin_amdgcn_mfma_f32_16x16x32_bf16(Bt[n][k], At[m][k], acc[ai][bj][m][n], 0, 0, 0); } __builtin_amdgcn_s_setprio(0); } while (0)
#define PG8_WAIT_V(n) asm volatile("s_waitcnt vmcnt(" #n ")" ::: "memory")
#define PG8_WAIT_L(n) asm volatile("s_waitcnt lgkmcnt(" #n ")" ::: "memory")
#define PG8_BAR __builtin_amdgcn_s_barrier()
#define PG8_SCHED __builtin_amdgcn_sched_barrier(0)
    const int one_scale = 0x7f7f7f7f;
    Unit cur, nxt; int ui = 0;
    if (!S.next(0, cur)) return;
    f32x4 acc[2][2][4][2];
#pragma unroll
    for (int a = 0; a < 2; ++a)
#pragma unroll
        for (int b = 0; b < 2; ++b)
#pragma unroll
            for (int m = 0; m < 4; ++m)
#pragma unroll
                for (int n = 0; n < 2; ++n) acc[a][b][m][n] = (f32x4){0.f, 0.f, 0.f, 0.f};
    bf16x8 At[4][2], B0[2][2], B1[2][2]; v8i Atq[4], B0q[2], B1q[2];
    unsigned voA[2][2], voN[2][2];
    const char* cA; const char* cB;
#define PG8_UNIT_PTRS(u, pa, pb, vo) do { \
        pb = (const char*)g.Bt + ((size_t)(u).e * g.bstride) * 2 + (size_t)(u).pn * tstep; \
        if constexpr (GATHER) { pa = (const char*)g.A; \
            _Pragma("unroll") for (int h = 0; h < 2; ++h) _Pragma("unroll") for (int i = 0; i < 2; ++i) { const int r = h * HALF + RA[i]; int tok = 0; if (r < (u).cnt) tok = g.rowtab[(u).tab + r]; \
                vo[h][i] = (unsigned)tok * (unsigned)(K * 2) + (unsigned)(CA[i] * 2); } \
        } else { pa = (const char*)g.A + (size_t)(u).pm * tstep; \
            _Pragma("unroll") for (int h = 0; h < 2; ++h) _Pragma("unroll") for (int i = 0; i < 2; ++i) vo[h][i] = voffA[i] + (unsigned)(h * hstep); } } while (0)
    PG8_UNIT_PTRS(cur, cA, cB, voA);
    PG8_STAGE(PG8_SB(0, 0), cB, voffB); PG8_STAGE(PG8_SB(0, 1), cB + hstep, voffB); PG8_STAGE(PG8_SA(0, 0), cA, voA[0]); PG8_STAGE(PG8_SA(0, 1), cA, voA[1]);
    if (wr == 1) PG8_BAR;
    PG8_WAIT_V(2); PG8_BAR;
    if constexpr (BAL_DMA) { PG8_STAGE(PG8_SB(1, 0), cB + kstep, voffB); PG8_STAGE(PG8_SB(1, 1), cB + hstep + kstep, voffB); PG8_WAIT_V(4); PG8_BAR; }
    else { PG8_STAGE(PG8_SB(1, 0), cB + kstep, voffB); PG8_STAGE(PG8_SA(1, 0), cA + kstep, voA[0]); PG8_STAGE(PG8_SB(1, 1), cB + hstep + kstep, voffB); PG8_WAIT_V(6); PG8_BAR; }
    for (;;) {
        const bool has_next = S.next(ui + 1, nxt);
        const char* nA = cA; const char* nB = cB;
#pragma unroll
        for (int h = 0; h < 2; ++h)
#pragma unroll
            for (int i = 0; i < 2; ++i) voN[h][i] = voA[h][i];
        if (has_next) PG8_UNIT_PTRS(nxt, nA, nB, voN);
        for (int t = 0; t < nt; t += 2) {
            const bool last = (t == nt - 2);
            const char* a1 = cA + (size_t)(t + 1) * kstep;
            const char* a2 = last ? nA : cA + (size_t)(t + 2) * kstep; const char* b2 = last ? nB : cB + (size_t)(t + 2) * kstep;
            const char* a3 = a2 + kstep; const char* b3 = b2 + kstep;
            unsigned vo2[2][2];
#pragma unroll
            for (int h = 0; h < 2; ++h)
#pragma unroll
                for (int i = 0; i < 2; ++i) vo2[h][i] = last ? voN[h][i] : voA[h][i];
            if constexpr (BAL_DMA) {
            PG8_LDB(B0, 0, 0); PG8_LDB(B1, 0, 1); PG8_SCHED; PG8_LDA(At, 0, 0); PG8_STAGE(PG8_SA(1, 0), a1, voA[0]); PG8_STAGE(PG8_SA(1, 1), a1, voA[1]);
            PG8_WAIT_V(8); PG8_WAIT_L(0); PG8_BAR; PG8_MMA(0, 0, At, B0); PG8_MMA(0, 1, At, B1); PG8_BAR; PG8_SCHED;
            PG8_LDA(At, 0, 1); PG8_STAGE(PG8_SB(0, 0), b2, voffB); PG8_STAGE(PG8_SB(0, 1), b2 + hstep, voffB);
            PG8_WAIT_V(6); PG8_WAIT_L(0); PG8_BAR; PG8_MMA(1, 0, At, B0); PG8_MMA(1, 1, At, B1); PG8_BAR; PG8_SCHED;
            PG8_LDB(B0, 1, 0); PG8_LDB(B1, 1, 1); PG8_SCHED; PG8_LDA(At, 1, 0); PG8_STAGE(PG8_SA(0, 0), a2, vo2[0]); PG8_STAGE(PG8_SA(0, 1), a2, vo2[1]);
            PG8_WAIT_V(8); PG8_WAIT_L(0); PG8_BAR; PG8_MMA(0, 0, At, B0); PG8_MMA(0, 1, At, B1); PG8_BAR; PG8_SCHED;
            PG8_LDA(At, 1, 1); PG8_STAGE(PG8_SB(1, 0), b3, voffB); PG8_STAGE(PG8_SB(1, 1), b3 + hstep, voffB);
            PG8_WAIT_V(6); PG8_WAIT_L(0); PG8_BAR; PG8_MMA(1, 0, At, B0); PG8_MMA(1, 1, At, B1); PG8_BAR; PG8_SCHED;
            } else if constexpr (DMA_IN_MMA) {
            PG8_LDB(B0, 0, 0); PG8_LDB(B1, 0, 1); PG8_SCHED; PG8_LDA(At, 0, 0);
            PG8_WAIT_V(6); PG8_WAIT_L(0); PG8_BAR; PG8_MMA(0, 0, At, B0); PG8_SCHED; PG8_STAGE(PG8_SA(1, 1), a1, voA[1]); PG8_SCHED; PG8_MMA(0, 1, At, B1); PG8_BAR; PG8_SCHED;
            PG8_LDA(At, 0, 1);
            PG8_WAIT_V(2); PG8_WAIT_L(0); PG8_BAR; PG8_MMA(1, 0, At, B0); PG8_SCHED; PG8_STAGE(PG8_SB(0, 0), b2, voffB); PG8_STAGE(PG8_SB(0, 1), b2 + hstep, voffB); PG8_SCHED;
            PG8_MMA(1, 1, At, B1); PG8_SCHED; PG8_STAGE(PG8_SA(0, 0), a2, vo2[0]); PG8_BAR; PG8_SCHED;
            PG8_LDB(B0, 1, 0); PG8_LDB(B1, 1, 1); PG8_SCHED; PG8_LDA(At, 1, 0);
            PG8_WAIT_V(6); PG8_WAIT_L(0); PG8_BAR; PG8_MMA(0, 0, At, B0); PG8_SCHED; PG8_STAGE(PG8_SA(0, 1), a2, vo2[1]); PG8_SCHED; PG8_MMA(0, 1, At, B1); PG8_BAR; PG8_SCHED;
            PG8_LDA(At, 1, 1);
            PG8_WAIT_V(2); PG8_WAIT_L(0); PG8_BAR; PG8_MMA(1, 0, At, B0); PG8_SCHED; PG8_STAGE(PG8_SB(1, 0), b3, voffB); PG8_STAGE(PG8_SB(1, 1), b3 + hstep, voffB); PG8_SCHED;
            PG8_MMA(1, 1, At, B1); PG8_SCHED; PG8_STAGE(PG8_SA(1, 0), a3, vo2[0]); PG8_BAR; PG8_SCHED;
            } else {
            PG8_LDB(B0, 0, 0); PG8_LDB(B1, 0, 1); PG8_SCHED; PG8_LDA(At, 0, 0); PG8_STAGE(PG8_SA(1, 1), a1, voA[1]);
            PG8_WAIT_V(8); PG8_WAIT_L(0); PG8_BAR; PG8_MMA(0, 0, At, B0); PG8_MMA(0, 1, At, B1); PG8_BAR; PG8_SCHED;
            PG8_LDA(At, 0, 1); PG8_STAGE(PG8_SB(0, 0), b2, voffB); PG8_STAGE(PG8_SB(0, 1), b2 + hstep, voffB); PG8_STAGE(PG8_SA(0, 0), a2, vo2[0]);
            PG8_WAIT_V(8); PG8_WAIT_L(0); PG8_BAR; PG8_MMA(1, 0, At, B0); PG8_MMA(1, 1, At, B1); PG8_BAR; PG8_SCHED;
            PG8_LDB(B0, 1, 0); PG8_LDB(B1, 1, 1); PG8_SCHED; PG8_LDA(At, 1, 0); PG8_STAGE(PG8_SA(0, 1), a2, vo2[1]);
            PG8_WAIT_V(8); PG8_WAIT_L(0); PG8_BAR; PG8_MMA(0, 0, At, B0); PG8_MMA(0, 1, At, B1); PG8_BAR; PG8_SCHED;
            PG8_LDA(At, 1, 1); PG8_STAGE(PG8_SB(1, 0), b3, voffB); PG8_STAGE(PG8_SB(1, 1), b3 + hstep, voffB); PG8_STAGE(PG8_SA(1, 0), a3, vo2[0]);
            PG8_WAIT_V(8); PG8_WAIT_L(0); PG8_BAR; PG8_MMA(1, 0, At, B0); PG8_MMA(1, 1, At, B1); PG8_BAR; PG8_SCHED;
            }
        }
        if constexpr (FP8) asm volatile("s_nop 15\n\ts_nop 15" ::: "memory");
        if constexpr (ALIGN_EPI) { if (wr == 0) PG8_BAR; }
        E(acc, cur, wr, wc, fr, fq);
        if (!has_next) break;
#pragma unroll
        for (int a = 0; a < 2; ++a)
#pragma unroll
            for (int b = 0; b < 2; ++b)
#pragma unroll
                for (int m = 0; m < 4; ++m)
#pragma unroll
                    for (int n = 0; n < 2; ++n) acc[a][b][m][n] = (f32x4){0.f, 0.f, 0.f, 0.f};
        cur = nxt; cA = nA; cB = nB; ++ui;
#pragma unroll
        for (int h = 0; h < 2; ++h)
#pragma unroll
            for (int i = 0; i < 2; ++i) voA[h][i] = voN[h][i];
        if constexpr (ALIGN_EPI) { if (wr == 1) PG8_BAR; }
    }
    PG8_WAIT_V(0);
    if constexpr (!ALIGN_EPI) { if (wr == 0) PG8_BAR; }
    PG8_BAR;
#undef PG8_UNIT_PTRS
#undef PG8_SA
#undef PG8_SB
#undef PG8_STAGE
#undef PG8_LDA
#undef PG8_LDQ
#undef PG8_LDB
#undef PG8_MMA
#undef PG8_WAIT_V
#undef PG8_WAIT_L
#undef PG8_BAR
#undef PG8_SCHED
}
}

#define XB_TMO      128
#define XB_XCNT(j)  (256  + 64 * (j))
#define XB_XSUB(j)  (1280 + 64 * (j))
#define XB_XGEN(j)  (2304 + 64 * (j))
#define XB_TOP      3328
#define XB_TOPGEN   3392
#define XCD_BAR_WORDS 3456
#define XB_SPIN_CAP (1u << 18)

__device__ __forceinline__ unsigned xb_ld(unsigned* p)              { return __hip_atomic_load(p, __ATOMIC_RELAXED, __HIP_MEMORY_SCOPE_AGENT); }
__device__ __forceinline__ unsigned xb_add(unsigned* p, unsigned v) { return __hip_atomic_fetch_add(p, v, __ATOMIC_RELAXED, __HIP_MEMORY_SCOPE_AGENT); }
__device__ __forceinline__ unsigned xb_xcc_id() { return (unsigned)__builtin_amdgcn_s_getreg((3 << 11) | 20) & 0xFu; }
#define XB_SPIN(cond, bar) do { unsigned _sp = 0; while (cond) { __builtin_amdgcn_s_sleep(1); \
    if ((++_sp & 255u) == 0u) { if (xb_ld(&(bar)[XB_TMO])) break; if (_sp > XB_SPIN_CAP) { atomicAdd(&(bar)[XB_TMO], 1u); break; } } } } while (0)

struct XcdBarrier {
    unsigned* bar; unsigned x;
    volatile LAS unsigned* st;
};

__device__ __forceinline__ XcdBarrier xcd_barrier_post(unsigned* bar, volatile LAS unsigned* st) {
    XcdBarrier b; b.bar = bar; b.x = xb_xcc_id(); b.st = st;
    if (threadIdx.x == 0) (void)xb_add(&bar[XB_XCNT(b.x)], 1u);
    return b;
}
__device__ __forceinline__ void xcd_barrier_complete(unsigned* bar, unsigned x, unsigned& nloc, unsigned& nx) {
    const unsigned G = gridDim.x * gridDim.y * gridDim.z;
    unsigned sum, cnt, mine, sp = 0u;
    for (;;) {
        sum = 0u; cnt = 0u; mine = 0u;
#pragma unroll
        for (unsigned j = 0; j < 16; ++j) { const unsigned c = xb_ld(&bar[XB_XCNT(j)]); sum += c; cnt += (c > 0u) ? 1u : 0u; mine = (j == x) ? c : mine; }
        if (sum == G) break;
        __builtin_amdgcn_s_sleep(1);
        if ((++sp & 255u) == 0u) { if (xb_ld(&bar[XB_TMO])) break; if (sp > XB_SPIN_CAP) { atomicAdd(&bar[XB_TMO], 1u); break; } }
    }
    nloc = mine > 0u ? mine : 1u; nx = cnt > 0u ? cnt : 1u;
}

__device__ __forceinline__ void xcd_barrier(const XcdBarrier& b) {
    asm volatile("s_waitcnt vmcnt(0)" ::: "memory");
    __syncthreads();
    if (threadIdx.x == 0) {
        unsigned* bar = b.bar;
        __builtin_amdgcn_s_waitcnt(0);
        unsigned nloc = b.st[0], nx = b.st[1];
        if (nloc == 0u) { xcd_barrier_complete(bar, b.x, nloc, nx); b.st[0] = nloc; b.st[1] = nx; }
        const unsigned old = xb_add(&bar[XB_XSUB(b.x)], 1u);
        const unsigned gen = old / nloc;
        if (old + 1u == (gen + 1u) * nloc) {
            __builtin_amdgcn_fence(__ATOMIC_RELEASE, "agent");
            asm volatile("s_waitcnt vmcnt(0)" ::: "memory");
            const unsigned og = xb_add(&bar[XB_TOP], 1u);
            const unsigned tg = og / nx;
            if (og + 1u == (tg + 1u) * nx) xb_add(&bar[XB_TOPGEN], 1u);
            else XB_SPIN(xb_ld(&bar[XB_TOPGEN]) == tg, bar);
            __builtin_amdgcn_fence(__ATOMIC_ACQUIRE, "agent");
            xb_add(&bar[XB_XGEN(b.x)], 1u);
            asm volatile("s_waitcnt vmcnt(0)" ::: "memory");
        } else {
            XB_SPIN(xb_ld(&bar[XB_XGEN(b.x)]) == gen, bar);
            __builtin_amdgcn_fence(__ATOMIC_ACQUIRE, "agent");
            asm volatile("s_waitcnt vmcnt(0)" ::: "memory");
        }
    }
    __syncthreads();
}

struct Args {
    const float* x; const float* p; const float* w_in; const float* norm_sb; const float* norm_moba; const float* w_out; const float* ln1_g; const float* ln1_b;
    const float* w_router; const float* b_router; const float* w_up; const float* b_up; const float* w_down; const float* b_down; const float* ln2_g; const float* ln2_b;
    const float* w_ple; const float* w_ple_gate; const float* b_ple_gate;
    float* out; unsigned char* ws; int ph_lo, ph_hi;
};

template <int CTRL> __device__ __forceinline__ float dppmov(float v) { return __builtin_bit_cast(float, __builtin_amdgcn_update_dpp(0, __builtin_bit_cast(int, v), CTRL, 0xF, 0xF, true)); }
__device__ __forceinline__ float reduce16(float v) { v += dppmov<0xB1>(v); v += dppmov<0x4E>(v); v += dppmov<0x141>(v); v += dppmov<0x140>(v); return v; }
__device__ __forceinline__ float wave_sum(float v) {
    v = reduce16(v);
    { const unsigned u = __builtin_bit_cast(unsigned, v); auto r = __builtin_amdgcn_permlane16_swap(u, u, false, false); v = __builtin_bit_cast(float, (unsigned)r[0]) + __builtin_bit_cast(float, (unsigned)r[1]); }
    { const unsigned u = __builtin_bit_cast(unsigned, v); auto r = __builtin_amdgcn_permlane32_swap(u, u, false, false); v = __builtin_bit_cast(float, (unsigned)r[0]) + __builtin_bit_cast(float, (unsigned)r[1]); }
    return v;
}

struct DenseSched {
    int nM, nN, nwg, G, c;
    __device__ void init(int Mrows, int N, int G_, int c_) { nM = Mrows / 256; nN = N / 256; nwg = nM * nN; G = G_; c = c_; }
    __device__ __forceinline__ bool next(int i, pg8::Unit& u) const {
        const long L = (long)i * G + c; if (L >= nwg) return false;
        int wgid = (int)L; { const int q = nwg / 8, r = nwg % 8, xcd = wgid % 8, off = wgid / 8; wgid = (xcd < r ? xcd * (q + 1) : r * (q + 1) + (xcd - r) * q) + off; }
        const int nig = 8 * nN, gid = wgid / nig, fm = gid * 8, gsz = (nM - fm) < 8 ? (nM - fm) : 8;
        u.pm = fm + ((wgid % nig) % gsz); u.pn = (wgid % nig) / gsz; u.e = 0; u.tab = 0; u.cnt = 256; return true;
    }
};
struct MoeSched {
    const LAS int* tab; int NPN, G, c;
    __device__ __forceinline__ bool next(int i, pg8::Unit& u) const {
        int tt, pn;
        if (G == 256 && (NPN == 8 || NPN == 16)) {
            const int x = c & 7, s = c >> 3;
            if (NPN == 8) { tt = 32 * i + 8 * (x >> 1) + (s >> 2); pn = 4 * (x & 1) + (s & 3); }
            else { tt = 16 * i + 8 * (x >> 2) + (s >> 2); pn = 4 * (x & 3) + (s & 3); }
            if (tt >= tab[32]) return false;
        } else {
            const int total = tab[32] * NPN; const int L = i * G + c; if (L >= total) return false;
            tt = L / NPN; pn = L - tt * NPN;
        }
        int e = 0;
        for (int k = 1; k < 32; ++k) e += (tab[k] <= tt) ? 1 : 0;
        e = __builtin_amdgcn_readfirstlane(e);
        const int mt = tt - tab[e]; const int cnt = tab[33 + e] - mt * 256;
        u.pm = __builtin_amdgcn_readfirstlane(tt); u.pn = __builtin_amdgcn_readfirstlane(pn); u.e = e; u.tab = __builtin_amdgcn_readfirstlane(e * ECAP + mt * 256); u.cnt = __builtin_amdgcn_readfirstlane(cnt < 256 ? cnt : 256); return true;
    }
};
__device__ __forceinline__ void moe_table(LAS int* tab, const unsigned* ecnt_words) {
    __syncthreads();
    if (threadIdx.x < 32) { const int e = threadIdx.x, c = (int)ecnt_words[32 * e], t = (c + 255) >> 8; int inc = t;
#pragma unroll
        for (int o = 1; o < 32; o <<= 1) { const int v = __shfl_up(inc, o); if (e >= o) inc += v; }
        tab[33 + e] = c; tab[e] = inc - t; if (e == 31) tab[32] = inc; }
    __syncthreads();
}

using pg8::Unit; using pg8::cvt_pk_bf16;
struct EpiQKV {
    static constexpr bool PERM = true;
    bf16* O; int ldc; bool qscale; float* kmean;
    __device__ __forceinline__ void operator()(const f32x4 (&acc)[2][2][4][2], const Unit& u, int wr, int wc, int fr, int fq) const {
        asm volatile("" : "+v"(fr), "+v"(fq));
        const int row0 = u.pm * 256 + wr * 64 + fr, col0 = u.pn * 256 + wc * 32 + 8 * fq;
        const float sc = (qscale && (u.pn < 4 || (u.pn >= 12 && u.pn < 16))) ? QSCALE : 1.f;
#pragma unroll
        for (int ai = 0; ai < 2; ++ai)
#pragma unroll
            for (int m = 0; m < 4; ++m) { bf16* rowp = O + (size_t)(row0 + ai * 128 + m * 16) * ldc + col0;
#pragma unroll
                for (int bj = 0; bj < 2; ++bj) { const f32x4 v0 = acc[ai][bj][m][0] * sc, v1 = acc[ai][bj][m][1] * sc;
                    u32x4 w; w.x = cvt_pk_bf16(v0[0], v0[1]); w.y = cvt_pk_bf16(v0[2], v0[3]); w.z = cvt_pk_bf16(v1[0], v1[1]); w.w = cvt_pk_bf16(v1[2], v1[3]);
                    *(u32x4*)(rowp + bj * 128) = w; } }
        if (qscale && u.pn >= 16 && u.pn < 20) {
#pragma unroll
            for (int bj = 0; bj < 2; ++bj)
#pragma unroll
                for (int n = 0; n < 2; ++n) { f32x4 cs = {0.f, 0.f, 0.f, 0.f};
#pragma unroll
                    for (int ai = 0; ai < 2; ++ai)
#pragma unroll
                        for (int m = 0; m < 4; ++m) cs += acc[ai][bj][m][n];
#pragma unroll
                    for (int j = 0; j < 4; ++j) { const float t = reduce16(cs[j]) * (1.f / 256.f);
                        if (fr == 0) { const int kc = (u.pn - 16) * 256 + bj * 128 + wc * 32 + 8 * fq + 4 * n + j;
                            const int bb = u.pm >> 5, blk = u.pm & 31;
                            atomicAdd(kmean + ((size_t)((bb * 8 + (kc >> 7)) * 32 + blk)) * 128 + (kc & 127), t); } } }
        }
    }
};
struct EpiH {
    static constexpr bool PERM = true;
    const bf16* XB; bf16* Hh;
    __device__ __forceinline__ void operator()(const f32x4 (&acc)[2][2][4][2], const Unit& u, int wr, int wc, int fr, int fq) const {
        asm volatile("" : "+v"(fr), "+v"(fq));
        const int row0 = u.pm * 256 + wr * 64 + fr, col0 = u.pn * 256 + wc * 32 + 8 * fq;
        u32x4 xw[2][4][2];
#pragma unroll
        for (int ai = 0; ai < 2; ++ai)
#pragma unroll
            for (int m = 0; m < 4; ++m)
#pragma unroll
                for (int bj = 0; bj < 2; ++bj) xw[ai][m][bj] = *(const u32x4*)(XB + (size_t)(row0 + ai * 128 + m * 16) * D + col0 + bj * 128);
        asm volatile("" : "+v"(xw[0][0][0]), "+v"(xw[0][0][1]), "+v"(xw[0][1][0]), "+v"(xw[0][1][1]), "+v"(xw[0][2][0]), "+v"(xw[0][2][1]), "+v"(xw[0][3][0]), "+v"(xw[0][3][1]),
                          "+v"(xw[1][0][0]), "+v"(xw[1][0][1]), "+v"(xw[1][1][0]), "+v"(xw[1][1][1]), "+v"(xw[1][2][0]), "+v"(xw[1][2][1]), "+v"(xw[1][3][0]), "+v"(xw[1][3][1]));
#pragma unroll
        for (int ai = 0; ai < 2; ++ai)
#pragma unroll
            for (int m = 0; m < 4; ++m) { const size_t ro = (size_t)(row0 + ai * 128 + m * 16) * D + col0;
#pragma unroll
                for (int bj = 0; bj < 2; ++bj) { const u32x4 x4 = xw[ai][m][bj];
                    const f32x4 a0 = acc[ai][bj][m][0], a1 = acc[ai][bj][m][1]; u32x4 w;
                    w.x = cvt_pk_bf16(fmaf(bf_lo(x4.x), DN_ALPHA, a0[0]), fmaf(bf_hi(x4.x), DN_ALPHA, a0[1])); w.y = cvt_pk_bf16(fmaf(bf_lo(x4.y), DN_ALPHA, a0[2]), fmaf(bf_hi(x4.y), DN_ALPHA, a0[3]));
                    w.z = cvt_pk_bf16(fmaf(bf_lo(x4.z), DN_ALPHA, a1[0]), fmaf(bf_hi(x4.z), DN_ALPHA, a1[1])); w.w = cvt_pk_bf16(fmaf(bf_lo(x4.w), DN_ALPHA, a1[2]), fmaf(bf_hi(x4.w), DN_ALPHA, a1[3]));
                    *(u32x4*)(Hh + ro + bj * 128) = w; } }
    }
};
struct EpiUp {
    static constexpr bool PERM = true;
    unsigned char* ACT; const float* biasp;
    __device__ __forceinline__ void operator()(const f32x4 (&acc)[2][2][4][2], const Unit& u, int wr, int wc, int fr, int fq) const {
        asm volatile("" : "+v"(fr), "+v"(fq));
        const int row0 = u.pm * 256 + wr * 64 + fr, cw = wc * 32 + 8 * fq;
        const float* bp = biasp + (size_t)u.e * 4096 + u.pn * 256 + cw;
        f32x4 bg[2], bl[2];
#pragma unroll
        for (int n = 0; n < 2; ++n) { bg[n] = *(const f32x4*)(bp + 4 * n); bl[n] = *(const f32x4*)(bp + 128 + 4 * n); }
#pragma unroll
        for (int ai = 0; ai < 2; ++ai)
#pragma unroll
            for (int m = 0; m < 4; ++m) {
                float a[8];
#pragma unroll
                for (int n = 0; n < 2; ++n)
#pragma unroll
                    for (int j = 0; j < 4; ++j) {
                        const float g8 = fminf(fmaf(acc[ai][0][m][n][j], 8.f * UP_DESCALE, bg[n][j]), 8.f * SWIGLU_LIMIT);
                        const float l1 = __builtin_amdgcn_fmed3f(fmaf(acc[ai][1][m][n][j], UP_DESCALE, bl[n][j]), 1.f - SWIGLU_LIMIT, 1.f + SWIGLU_LIMIT);
                        const float sg = __builtin_amdgcn_rcpf(1.f + __builtin_amdgcn_exp2f(g8 * (-SWIGLU_ALPHA * LOG2E / 8.f)));
                        a[n * 4 + j] = g8 * sg * l1;
                    }
                u32x2 w; w.x = pack_fp8x4_nc(a[0], a[1], a[2], a[3]); w.y = pack_fp8x4_nc(a[4], a[5], a[6], a[7]);
                *(u32x2*)(ACT + (size_t)(row0 + ai * 128 + m * 16) * DFF + u.pn * 128 + cw) = w;
            }
    }
};
struct EpiDown {
    static constexpr bool PERM = true;
    unsigned char* Y; const float* bias; const float* rowg;
    __device__ __forceinline__ void operator()(const f32x4 (&acc)[2][2][4][2], const Unit& u, int wr, int wc, int fr, int fq) const {
        asm volatile("" : "+v"(fr), "+v"(fq));
        const int rl0 = wr * 64 + fr, col0 = u.pn * 256 + wc * 32 + 8 * fq;
        const float* bp = bias + (size_t)u.e * D + col0;
        f32x4 bv[2][2];
#pragma unroll
        for (int bj = 0; bj < 2; ++bj)
#pragma unroll
            for (int n = 0; n < 2; ++n) bv[bj][n] = *(const f32x4*)(bp + bj * 128 + 4 * n);
        float gtv[2][4];
#pragma unroll
        for (int ai = 0; ai < 2; ++ai)
#pragma unroll
            for (int m = 0; m < 4; ++m) { const int rl = rl0 + ai * 128 + m * 16; gtv[ai][m] = (rl < u.cnt) ? rowg[u.tab + rl] : 0.f; }
        asm volatile("" : "+v"(gtv[0][0]), "+v"(gtv[0][1]), "+v"(gtv[0][2]), "+v"(gtv[0][3]), "+v"(gtv[1][0]), "+v"(gtv[1][1]), "+v"(gtv[1][2]), "+v"(gtv[1][3]));
#pragma unroll
        for (int ai = 0; ai < 2; ++ai)
#pragma unroll
            for (int m = 0; m < 4; ++m) { const int rl = rl0 + ai * 128 + m * 16; const float gt = gtv[ai][m] * YSCALE;
                unsigned char* rowp = Y + (size_t)(u.pm * 256 + rl) * D + col0;
#pragma unroll
                for (int bj = 0; bj < 2; ++bj) { const f32x4 v0 = (acc[ai][bj][m][0] * DN_DESCALE + bv[bj][0]) * gt, v1 = (acc[ai][bj][m][1] * DN_DESCALE + bv[bj][1]) * gt;
                    u32x2 w; w.x = pack_fp8x4(v0[0], v0[1], v0[2], v0[3]); w.y = pack_fp8x4(v1[0], v1[1], v1[2], v1[3]);
                    *(u32x2*)(rowp + bj * 128) = w; } }
    }
};
struct EpiOut {
    static constexpr bool PERM = true;
    float* OUT; const float* bias; const bf16* PLEB; const bf16* X2B;
    __device__ __forceinline__ void operator()(const f32x4 (&acc)[2][2][4][2], const Unit& u, int wr, int wc, int fr, int fq) const {
        asm volatile("" : "+v"(fr), "+v"(fq));
        const int row0 = u.pm * 256 + wr * 64 + fr, col0 = u.pn * 256 + wc * 32 + 8 * fq;
        f32x4 bv[2][2];
#pragma unroll
        for (int bj = 0; bj < 2; ++bj)
#pragma unroll
            for (int n = 0; n < 2; ++n) bv[bj][n] = *(const f32x4*)(bias + col0 + bj * 128 + 4 * n);
#pragma unroll
        for (int ai = 0; ai < 2; ++ai) {
            u32x4 xw[4][2], pw[4][2];
#pragma unroll
            for (int m = 0; m < 4; ++m)
#pragma unroll
                for (int bj = 0; bj < 2; ++bj) { const size_t o = (size_t)(row0 + ai * 128 + m * 16) * D + col0 + bj * 128; xw[m][bj] = *(const u32x4*)(X2B + o); pw[m][bj] = *(const u32x4*)(PLEB + o); }
            asm volatile("" : "+v"(xw[0][0]), "+v"(xw[0][1]), "+v"(xw[1][0]), "+v"(xw[1][1]), "+v"(xw[2][0]), "+v"(xw[2][1]), "+v"(xw[3][0]), "+v"(xw[3][1]),
                              "+v"(pw[0][0]), "+v"(pw[0][1]), "+v"(pw[1][0]), "+v"(pw[1][1]), "+v"(pw[2][0]), "+v"(pw[2][1]), "+v"(pw[3][0]), "+v"(pw[3][1]));
#pragma unroll
            for (int m = 0; m < 4; ++m) { const size_t ro = (size_t)(row0 + ai * 128 + m * 16) * D + col0;
#pragma unroll
                for (int bj = 0; bj < 2; ++bj) { const size_t o = ro + bj * 128; const u32x4 x4 = xw[m][bj], p4 = pw[m][bj];
                    const float xv[8] = {bf_lo(x4.x), bf_hi(x4.x), bf_lo(x4.y), bf_hi(x4.y), bf_lo(x4.z), bf_hi(x4.z), bf_lo(x4.w), bf_hi(x4.w)};
                    const float pl[8] = {bf_lo(p4.x), bf_hi(p4.x), bf_lo(p4.y), bf_hi(p4.y), bf_lo(p4.z), bf_hi(p4.z), bf_lo(p4.w), bf_hi(p4.w)};
#pragma unroll
                    for (int n = 0; n < 2; ++n) { const f32x4 g = acc[ai][bj][m][n] * UP_DESCALE + bv[bj][n]; f32x4 r;
#pragma unroll
                        for (int j = 0; j < 4; ++j) r[j] = xv[4 * n + j] + __builtin_amdgcn_rcpf(1.f + __builtin_amdgcn_exp2f(-LOG2E * g[j])) * pl[4 * n + j];
                        *(f32x4*)(OUT + o + 4 * n) = r; } } }
        }
    }
};

struct P0Job { const float* W; void* WT; int K, N, mode; };
__device__ __forceinline__ void cv_load(const P0Job& j, int blk, int lane, f32x4 (&v)[16]) {
    const int nb32 = j.N >> 5, kb = blk / nb32, nbp = blk - kb * nb32;
    const float* p = j.W + (size_t)(128 * kb + 16 * (lane >> 3)) * j.N + 32 * nbp + 4 * (lane & 7);
#pragma unroll
    for (int i = 0; i < 16; ++i) v[i] = __builtin_nontemporal_load((const GAS f32x4*)(p + (size_t)i * j.N));
}
__device__ __forceinline__ void cv_store(const P0Job& j, int blk, int lane, const f32x4 (&v)[16]) {
    const int nb32 = j.N >> 5, kb = blk / nb32, nbp = blk - kb * nb32, K = j.K;
    const int kk = 128 * kb + 16 * (lane >> 3), nc = 32 * nbp + 4 * (lane & 7);
#pragma unroll
    for (int jj = 0; jj < 4; ++jj) {
        int nn = nc + jj; if (j.mode & 1) { const int a2 = nn >> 1, bj = nn & 1; nn = 256 * (a2 >> 7) + 128 * bj + (a2 & 127); }
        if (j.mode < 2) {
            u32x4 o0, o1;
            o0.x = pk2(v[0][jj], v[1][jj]); o0.y = pk2(v[2][jj], v[3][jj]); o0.z = pk2(v[4][jj], v[5][jj]); o0.w = pk2(v[6][jj], v[7][jj]);
            o1.x = pk2(v[8][jj], v[9][jj]); o1.y = pk2(v[10][jj], v[11][jj]); o1.z = pk2(v[12][jj], v[13][jj]); o1.w = pk2(v[14][jj], v[15][jj]);
            GAS u32x4* d = (GAS u32x4*)((bf16*)j.WT + (size_t)nn * K + kk);
            *d = o0; *(d + 1) = o1;
        } else {
            u32x4 o;
            o.x = pack_fp8x4(v[0][jj] * WSCALE, v[1][jj] * WSCALE, v[2][jj] * WSCALE, v[3][jj] * WSCALE);
            o.y = pack_fp8x4(v[4][jj] * WSCALE, v[5][jj] * WSCALE, v[6][jj] * WSCALE, v[7][jj] * WSCALE);
            o.z = pack_fp8x4(v[8][jj] * WSCALE, v[9][jj] * WSCALE, v[10][jj] * WSCALE, v[11][jj] * WSCALE);
            o.w = pack_fp8x4(v[12][jj] * WSCALE, v[13][jj] * WSCALE, v[14][jj] * WSCALE, v[15][jj] * WSCALE);
            __builtin_nontemporal_store(o, (GAS u32x4*)((unsigned char*)j.WT + (size_t)nn * K + kk));
        }
    }
}
constexpr int P0_I_IN = (D / 64) * (NQKV / 32), P0_I_OUT = (D / 64) * (D / 32), P0_I_G = P0_I_OUT, P0_I_PLE = (PLE / 64) * (D / 32), P0_I_UP1 = (D / 64) * (2 * DFF / 32), P0_I_DN1 = (DFF / 64) * (D / 32);
constexpr int P0_NA = P0_I_IN + P0_I_OUT + P0_I_PLE, P0_NB = P0_I_G + NE * P0_I_UP1 + NE * P0_I_DN1;
constexpr int CV_LISTS = 2048, CV_BLOCKS = P0_NB / 2;
constexpr int CV_UP_END = (P0_I_G + NE * P0_I_UP1) / 2;
static_assert(P0_NA % 2 == 0 && P0_NB % 2 == 0, "item pairs");
__device__ __forceinline__ int cv_list_len(int l, int nblocks) { return l < nblocks ? (nblocks - l + CV_LISTS - 1) / CV_LISTS : 0; }
__device__ __forceinline__ void p0_locate_a(const Args& a, int it, P0Job& j, int& item) {
    unsigned char* ws = a.ws; int r = it;
    if (r < P0_I_IN) { j = P0Job{a.w_in, ws + WS_WINT, D, NQKV, 0}; item = r; return; } r -= P0_I_IN;
    if (r < P0_I_OUT) { j = P0Job{a.w_out, ws + WS_WOUTT, D, D, 0}; item = r; return; } r -= P0_I_OUT;
    j = P0Job{a.w_ple, ws + WS_WPLET, PLE, D, 0}; item = r;
}
__device__ __forceinline__ void p0_locate_b(const Args& a, int it, P0Job& j, int& item) {
    unsigned char* ws = a.ws; int r = it;
    if (r < P0_I_G) { j = P0Job{a.w_ple_gate, ws + WS_WGT, D, D, 2}; item = r; return; } r -= P0_I_G;
    if (r < NE * P0_I_UP1) { const int e = r / P0_I_UP1; item = r - e * P0_I_UP1; j = P0Job{a.w_up + (size_t)e * D * 2 * DFF, ws + WS_WUPT + (size_t)e * 2 * DFF * D, D, 2 * DFF, 3}; return; } r -= NE * P0_I_UP1;
    { const int e = r / P0_I_DN1; item = r - e * P0_I_DN1; j = P0Job{a.w_down + (size_t)e * DFF * D, ws + WS_WDNT + (size_t)e * D * DFF, DFF, D, 2}; }
}
__device__ __forceinline__ void cv_range(const Args& a, int l, int i0, int i1, int lane) {
    if (i0 >= i1) return;
    P0Job j0, j1; int it0 = 0, it1 = 0; f32x4 v0[16], v1[16];
    { p0_locate_b(a, 2 * (l + CV_LISTS * i0), j0, it0); cv_load(j0, it0 >> 1, lane, v0); }
    j1 = j0; it1 = it0;
    if (i0 + 1 < i1) { p0_locate_b(a, 2 * (l + CV_LISTS * (i0 + 1)), j1, it1); cv_load(j1, it1 >> 1, lane, v1); }
    for (int i = i0;;) {
        const int in2 = i + 2; const bool h2 = in2 < i1;
        P0Job n2 = j1; int nit2 = it1; f32x4 w2[16];
        if (h2) { p0_locate_b(a, 2 * (l + CV_LISTS * in2), n2, nit2); cv_load(n2, nit2 >> 1, lane, w2); }
        cv_store(j0, it0 >> 1, lane, v0);
        if (i + 1 >= i1) break;
#pragma unroll
        for (int k = 0; k < 16; ++k) { v0[k] = v1[k]; v1[k] = w2[k]; }
        j0 = j1; it0 = it1; j1 = n2; it1 = nit2; i = i + 1;
    }
}
__device__ __forceinline__ void p0_prologue(const Args& a, LAS unsigned char* lds, int gw, int NGW, int wave, int lane) {
    unsigned char* ws = a.ws;
    { int pr = gw; P0Job j0; int it0 = 0; f32x4 v0[16];
      if (pr < P0_NA / 2) { p0_locate_a(a, 2 * pr, j0, it0); cv_load(j0, it0 >> 1, lane, v0);
        for (;;) {
            const int pn = pr + NGW; const bool hn = pn < P0_NA / 2;
            P0Job n0 = j0; int nit = it0; f32x4 w0[16];
            if (hn) { p0_locate_a(a, 2 * pn, n0, nit); cv_load(n0, nit >> 1, lane, w0); }
            cv_store(j0, it0 >> 1, lane, v0);
            if (!hn) break;
#pragma unroll
            for (int k = 0; k < 16; ++k) v0[k] = w0[k];
            j0 = n0; it0 = nit; pr = pn;
        } } }
    { const GAS f32x4* src = (const GAS f32x4*)a.x; GAS u32x2* dst = (GAS u32x2*)(ws + WS_XB); const size_t n4 = (size_t)M * D / 4, stride = (size_t)NGW * 64;
      size_t i = (size_t)gw * 64 + lane; f32x4 v[8];
      if (i < n4) {
#pragma unroll
          for (int u = 0; u < 8; ++u) if (i + u * stride < n4) v[u] = __builtin_nontemporal_load(src + i + u * stride);
          for (;;) {
              const size_t in = i + 8 * stride; const bool hn = in < n4; f32x4 w[8];
              if (hn) {
#pragma unroll
                  for (int u = 0; u < 8; ++u) if (in + u * stride < n4) w[u] = __builtin_nontemporal_load(src + in + u * stride); }
#pragma unroll
              for (int u = 0; u < 8; ++u) if (i + u * stride < n4) { u32x2 o; o.x = pk2(v[u].x, v[u].y); o.y = pk2(v[u].z, v[u].w); dst[i + u * stride] = o; }
              if (!hn) break;
#pragma unroll
              for (int u = 0; u < 8; ++u) v[u] = w[u];
              i = in;
          } } }
    { const GAS f32x4* src = (const GAS f32x4*)a.p; GAS u32x2* dst = (GAS u32x2*)(ws + WS_PB); const size_t n4 = (size_t)M * PLE / 4, stride = (size_t)NGW * 64;
      for (size_t i = (size_t)gw * 64 + lane; i < n4; i += 8 * stride) { f32x4 v[8];
#pragma unroll
          for (int u = 0; u < 8; ++u) if (i + u * stride < n4) v[u] = __builtin_nontemporal_load(src + i + u * stride);
#pragma unroll
          for (int u = 0; u < 8; ++u) if (i + u * stride < n4) { u32x2 o; o.x = pk2(v[u].x, v[u].y); o.y = pk2(v[u].z, v[u].w); dst[i + u * stride] = o; } } }
    { float* km = (float*)(ws + WS_KMEAN); for (int i = gw * 64 + lane; i < 16 * 32 * 128; i += NGW * 64) km[i] = 0.f; }
    { float* bp = (float*)(ws + WS_BUPP);
      for (int i = gw * 64 + lane; i < NE * 2 * DFF; i += NGW * 64) { const int e = i >> 12, nn = i & 4095; const int a2 = nn >> 1, bj = nn & 1; bp[e * 4096 + 256 * (a2 >> 7) + 128 * bj + (a2 & 127)] = bj ? a.b_up[i] + 1.f : 8.f * a.b_up[i]; } }
}

__device__ __forceinline__ void p2_kmean(const Args& a, LAS unsigned char* lds, int G) {
    const bf16* qkv = (const bf16*)(a.ws + WS_QKV); float* km = (float*)(a.ws + WS_KMEAN);
    LAS float* red = (LAS float*)(lds + RING_OFF);
    const int tid = threadIdx.x, c = tid & 15, rg = tid >> 4;
    for (int it = blockIdx.x; it < 16 * 32; it += G) {
        const int bh = it >> 5, blk = it & 31, b = bh >> 3, h = bh & 7;
        float s[8] = {0, 0, 0, 0, 0, 0, 0, 0};
#pragma unroll
        for (int i = 0; i < 8; ++i) { const int row = b * SEQ + blk * 256 + rg + 32 * i; const u32x4 w = *(const u32x4*)(qkv + (size_t)row * NQKV + 4096 + h * 128 + 8 * c);
            s[0] += bf_lo(w.x); s[1] += bf_hi(w.x); s[2] += bf_lo(w.y); s[3] += bf_hi(w.y); s[4] += bf_lo(w.z); s[5] += bf_hi(w.z); s[6] += bf_lo(w.w); s[7] += bf_hi(w.w); }
#pragma unroll
        for (int j = 0; j < 8; ++j) red[rg * 128 + 8 * c + j] = s[j];
        __syncthreads();
        if (tid < 128) { float t = 0.f; for (int r = 0; r < 32; ++r) t += red[r * 128 + tid]; km[(size_t)it * 128 + tid] = t * (1.f / 256.f); }
        __syncthreads();
    }
}

namespace mix {
typedef short s16x4 __attribute__((ext_vector_type(4)));
#define KSWZ(row, colB) ((row) * 256 + ((colB) ^ (((row) & 7) << 4)))
constexpr int L_V = 0, L_K = 16384, L_WS = 32768, L_FLAG = 36864, L_PRE = 40960;
constexpr float THR2 = 11.5f;
__device__ __forceinline__ int crow(int r, int hi) { return (r & 3) + 8 * (r >> 2) + 4 * hi; }
__device__ __forceinline__ unsigned cvtpk(float lo, float hi) { unsigned r; asm volatile("v_cvt_pk_bf16_f32 %0, %1, %2" : "=v"(r) : "v"(lo), "v"(hi)); return r; }
__device__ __forceinline__ int v_st(int k, int c) { const int kk = (k & ~0xC) | ((k & 4) << 1) | ((k & 8) >> 1); return ((kk >> 3) * 4 + (c >> 5)) * 512 + ((kk & 7) * 32 + (c & 31)) * 2; }
__device__ __forceinline__ int v_rd_base(int lane) { return ((lane & 3) << 3) | (((lane >> 2) & 3) << 6) | (((lane >> 4) & 1) << 5) | (((lane >> 5) & 1) << 8); }
constexpr int v_rd_off(int d0, int ks, int half) { return d0 * 512 + ks * 4096 + half * 2048; }
template <int OFF> __device__ __forceinline__ s16x4 tr_read(int vb) { s16x4 r; asm volatile("ds_read_b64_tr_b16 %0, %1 offset:%2" : "=&v"(r) : "v"(vb), "i"(OFF) : "memory"); return r; }
template <int D0> __device__ __forceinline__ void pv_one(f32x16& od, int vb, bf16x8 pa0, bf16x8 pa1, bf16x8 pa2, bf16x8 pa3) {
    const s16x4 l0 = tr_read<v_rd_off(D0, 0, 0)>(vb), h0 = tr_read<v_rd_off(D0, 0, 1)>(vb), l1 = tr_read<v_rd_off(D0, 1, 0)>(vb), h1 = tr_read<v_rd_off(D0, 1, 1)>(vb);
    const s16x4 l2 = tr_read<v_rd_off(D0, 2, 0)>(vb), h2 = tr_read<v_rd_off(D0, 2, 1)>(vb), l3 = tr_read<v_rd_off(D0, 3, 0)>(vb), h3 = tr_read<v_rd_off(D0, 3, 1)>(vb);
    asm volatile("s_waitcnt lgkmcnt(0)" ::: "memory"); __builtin_amdgcn_sched_barrier(0);
#define PK(L, H) (bf16x8){L[0], L[1], L[2], L[3], H[0], H[1], H[2], H[3]}
    od = __builtin_amdgcn_mfma_f32_32x32x16_bf16(pa0, PK(l0, h0), od, 0, 0, 0);
    od = __builtin_amdgcn_mfma_f32_32x32x16_bf16(pa1, PK(l1, h1), od, 0, 0, 0);
    od = __builtin_amdgcn_mfma_f32_32x32x16_bf16(pa2, PK(l2, h2), od, 0, 0, 0);
    od = __builtin_amdgcn_mfma_f32_32x32x16_bf16(pa3, PK(l3, h3), od, 0, 0, 0);
#undef PK
}
__device__ __forceinline__ void pv_d0(f32x16 (&o)[4], int vb, bf16x8 pa0, bf16x8 pa1, bf16x8 pa2, bf16x8 pa3) {
    pv_one<0>(o[0], vb, pa0, pa1, pa2, pa3); pv_one<1>(o[1], vb, pa0, pa1, pa2, pa3); pv_one<2>(o[2], vb, pa0, pa1, pa2, pa3); pv_one<3>(o[3], vb, pa0, pa1, pa2, pa3);
}
__device__ __forceinline__ void qkt(f32x16& p0, f32x16& p1, const LAS unsigned char* Ks, const bf16x8 (&qr)[8], int r32, int hi) {
#pragma unroll
    for (int i = 0; i < 16; ++i) { p0[i] = 0.f; p1[i] = 0.f; }
#pragma unroll
    for (int d0 = 0; d0 < 8; ++d0) { const int cb = (d0 * 16 + hi * 8) * 2;
        const bf16x8 b0 = *(const LAS bf16x8*)(Ks + KSWZ(r32, cb));
        const bf16x8 b1 = *(const LAS bf16x8*)(Ks + KSWZ(32 + r32, cb));
        p0 = __builtin_amdgcn_mfma_f32_32x32x16_bf16(b0, qr[d0], p0, 0, 0, 0);
        p1 = __builtin_amdgcn_mfma_f32_32x32x16_bf16(b1, qr[d0], p1, 0, 0, 0); }
}
__device__ __forceinline__ void pack_p(const f32x16& p0, const f32x16& p1, bf16x8& pa0, bf16x8& pa1, bf16x8& pa2, bf16x8& pa3) {
#define PK4(P, BASE, OUT) do { unsigned a0 = cvtpk(P[BASE + 0], P[BASE + 1]), a1 = cvtpk(P[BASE + 2], P[BASE + 3]);   \
    unsigned b0 = cvtpk(P[BASE + 4], P[BASE + 5]), b1 = cvtpk(P[BASE + 6], P[BASE + 7]);                              \
    auto r0 = __builtin_amdgcn_permlane32_swap(a0, b0, false, false); auto r1 = __builtin_amdgcn_permlane32_swap(a1, b1, false, false); \
    u32x4 w = {r0[0], r1[0], r0[1], r1[1]}; OUT = __builtin_bit_cast(bf16x8, w); } while (0)
    PK4(p0, 0, pa0); PK4(p0, 8, pa1); PK4(p1, 0, pa2); PK4(p1, 8, pa3);
#undef PK4
}
__device__ __forceinline__ float pair_other(float x, int hi) {
    auto rr = __builtin_amdgcn_permlane32_swap(__builtin_bit_cast(unsigned, x), __builtin_bit_cast(unsigned, x), false, false);
    return __builtin_bit_cast(float, hi ? rr[0] : rr[1]);
}
struct TileRegs { u32x4 k0, k1, v0, v1; };
__device__ __forceinline__ void stage_load(TileRegs& r, const bf16* kg, const bf16* vg, int tid) {
    const int sr = tid >> 4, sc = (tid & 15) * 8;
    r.k0 = *(const u32x4*)(kg + (size_t)sr * NQKV + sc); r.k1 = *(const u32x4*)(kg + (size_t)(32 + sr) * NQKV + sc);
    r.v0 = *(const u32x4*)(vg + (size_t)sr * NQKV + sc); r.v1 = *(const u32x4*)(vg + (size_t)(32 + sr) * NQKV + sc);
}
__device__ __forceinline__ void stage_write(LAS unsigned char* lds, const TileRegs& r, int tid) {
    const int sr = tid >> 4, sc = (tid & 15) * 8;
    *(LAS u32x4*)(lds + L_V + v_st(sr, sc)) = r.v0; *(LAS u32x4*)(lds + L_V + v_st(32 + sr, sc)) = r.v1;
    *(LAS u32x4*)(lds + L_K + KSWZ(sr, sc * 2)) = r.k0; *(LAS u32x4*)(lds + L_K + KSWZ(32 + sr, sc * 2)) = r.k1;
}
__device__ __forceinline__ float reduce32(float v) { v = reduce16(v); v += __shfl_xor(v, 16); return v; }

__device__ __forceinline__ void sb_unit(const Args& a, LAS unsigned char* lds, int bh, int qb) {
    const bf16* qkv = (const bf16*)(a.ws + WS_QKV); bf16* mixed = (bf16*)(a.ws + WS_MIXED);
    const int tid = threadIdx.x, wid = __builtin_amdgcn_readfirstlane(tid >> 6), lane = tid & 63, r32 = lane & 31, hi = lane >> 5;
    const int b = bh >> 3, h = bh & 7, q0 = qb * 256, qpos = q0 + wid * 32 + r32;
    const bf16* base = qkv + (size_t)b * SEQ * NQKV + h * 128;
    volatile LAS int* flags = (volatile LAS int*)(lds + L_FLAG);
    bf16x8 qr[8];
#pragma unroll
    for (int d0 = 0; d0 < 8; ++d0) qr[d0] = *(const bf16x8*)(base + (size_t)qpos * NQKV + d0 * 16 + hi * 8);
    f32x16 o[4];
#pragma unroll
    for (int d = 0; d < 4; ++d)
#pragma unroll
        for (int i = 0; i < 16; ++i) o[d][i] = 0.f;
    float P = 1.f; bool wdone = false;
    const int vb0 = (int)(uintptr_t)(lds + L_V) + v_rd_base(lane);
    __syncthreads();
    if (tid < 8) flags[tid] = 0;
    TileRegs tr; stage_load(tr, base + (size_t)((qb * 4 + 3) * 64) * NQKV + 1024, base + (size_t)((qb * 4 + 3) * 64) * NQKV + 2048, tid);
    for (int kt = qb * 4 + 3; kt >= 0; --kt) {
        __syncthreads();
        { int alld = 1;
#pragma unroll
          for (int w = 0; w < 8; ++w) alld &= flags[w];
          if (alld) break; }
        stage_write(lds, tr, tid);
        if (kt > 0) stage_load(tr, base + (size_t)((kt - 1) * 64) * NQKV + 1024, base + (size_t)((kt - 1) * 64) * NQKV + 2048, tid);
        __syncthreads();
        const int kbase = kt * 64;
        if (!wdone && kbase < q0 + wid * 32 + 31) {
            f32x16 p0, p1; __builtin_amdgcn_s_setprio(1); qkt(p0, p1, lds + L_K, qr, r32, hi); __builtin_amdgcn_s_setprio(0);
            const int d0i = kbase + 4 * hi - qpos;
            f32x16 m0, m1;
#pragma unroll
            for (int r = 0; r < 16; ++r) {
                const int c = (r & 3) + 8 * (r >> 2);
                { const float z = fminf(fmaxf(p0[r], -120.f), 120.f); const float e = __builtin_amdgcn_exp2f(-z), be = __builtin_amdgcn_rcpf(1.f + e); const bool ok = (d0i + c) < 0;
                  p0[r] = ok ? be : 0.f; m0[r] = ok ? e * be : 1.f; }
                { const float z = fminf(fmaxf(p1[r], -120.f), 120.f); const float e = __builtin_amdgcn_exp2f(-z), be = __builtin_amdgcn_rcpf(1.f + e); const bool ok = (d0i + 32 + c) < 0;
                  p1[r] = ok ? be : 0.f; m1[r] = ok ? e * be : 1.f; }
            }
            float Go[2][4], Gp[2][4];
#pragma unroll
            for (int g = 0; g < 4; ++g) { Go[0][g] = (m0[4 * g] * m0[4 * g + 1]) * (m0[4 * g + 2] * m0[4 * g + 3]); Go[1][g] = (m1[4 * g] * m1[4 * g + 1]) * (m1[4 * g + 2] * m1[4 * g + 3]); }
#pragma unroll
            for (int ph = 0; ph < 2; ++ph)
#pragma unroll
                for (int g = 0; g < 4; ++g) Gp[ph][g] = pair_other(Go[ph][g], hi);
            float R = P;
#pragma unroll
            for (int ph = 1; ph >= 0; --ph)
#pragma unroll
                for (int g = 3; g >= 0; --g) {
                    const float Gf = hi ? Go[ph][g] : Gp[ph][g], Gs = hi ? Gp[ph][g] : Go[ph][g];
                    const float sA = R; R *= Gf; const float sB = R; R *= Gs;
                    float S = hi ? sA : sB;
                    if (ph == 1) { p1[4 * g + 3] *= S; S *= m1[4 * g + 3]; p1[4 * g + 2] *= S; S *= m1[4 * g + 2]; p1[4 * g + 1] *= S; S *= m1[4 * g + 1]; p1[4 * g] *= S; }
                    else         { p0[4 * g + 3] *= S; S *= m0[4 * g + 3]; p0[4 * g + 2] *= S; S *= m0[4 * g + 2]; p0[4 * g + 1] *= S; S *= m0[4 * g + 1]; p0[4 * g] *= S; }
                }
            P = R;
            bf16x8 pa0, pa1, pa2, pa3; pack_p(p0, p1, pa0, pa1, pa2, pa3);
            __builtin_amdgcn_s_setprio(1); pv_d0(o, vb0, pa0, pa1, pa2, pa3); __builtin_amdgcn_s_setprio(0);
            wdone = __builtin_amdgcn_ballot_w64(P >= 1e-30f) == 0ull;
        }
        if (lane == 0) flags[wid] = (wdone || kt == 0) ? 1 : 0;
    }
    f32x4 gn; gn.x = a.norm_sb[h * 128 + r32]; gn.y = a.norm_sb[h * 128 + 32 + r32]; gn.z = a.norm_sb[h * 128 + 64 + r32]; gn.w = a.norm_sb[h * 128 + 96 + r32];
#pragma unroll
    for (int r = 0; r < 16; ++r) {
        float ss = (o[0][r] * o[0][r] + o[1][r] * o[1][r]) + (o[2][r] * o[2][r] + o[3][r] * o[3][r]);
        ss = reduce32(ss) * (1.f / 128.f);
        const float rn = 1.f / sqrtf(ss + RMS_EPS);
        bf16* orow = mixed + (size_t)(b * SEQ + q0 + wid * 32 + crow(r, hi)) * D + h * 128 + r32;
        orow[0] = (bf16)f2bf(o[0][r] * rn * gn.x); orow[32] = (bf16)f2bf(o[1][r] * rn * gn.y); orow[64] = (bf16)f2bf(o[2][r] * rn * gn.z); orow[96] = (bf16)f2bf(o[3][r] * rn * gn.w);
    }
}

__device__ __forceinline__ int moba_entry(const int* list, int n, bool own_unit, int j, int ei) { return own_unit ? ((j * 256 + ei) | (3 << 16)) : list[ei < n ? ei : 0]; }
__device__ __forceinline__ void moba_unit(const Args& a, LAS unsigned char* lds, int bh, int j, int ent, int n, bool own_unit, bf16x8 (&qr)[8], TileRegs& tr, bool pre,
                                          bool hn, const int* nlist, int nn, bool nown, int nbh, int nj, int& ent_next) {
    const bf16* qkv = (const bf16*)(a.ws + WS_QKV); bf16* po = (bf16*)(a.ws + WS_MPO); float* pml = (float*)(a.ws + WS_MPML);
    const int tid = threadIdx.x, wid = __builtin_amdgcn_readfirstlane(tid >> 6), lane = tid & 63, r32 = lane & 31, hi = lane >> 5;
    const int b = bh >> 3, h = bh & 7;
    const bf16* base = qkv + (size_t)b * SEQ * NQKV + h * 128;
    LAS float* wsf = (LAS float*)(lds + L_WS + wid * 512); LAS float* al_l = wsf; LAS float* li_l = wsf + 32; LAS int* tb = (LAS int*)(wsf + 64);
    const int ei = wid * 32 + r32;
    const bool evalid = own_unit || (ei < n);
    const int qpos = ent & 0xffff, slot = ent >> 16;
    const int pslot = evalid ? (((bh * SEQ + qpos) << 2) + slot) : -1;
    __syncthreads();
    if (hi == 0) tb[r32] = pslot;
    if (!pre) {
#pragma unroll
        for (int d0 = 0; d0 < 8; ++d0) qr[d0] = *(const bf16x8*)(base + (size_t)qpos * NQKV + 3072 + d0 * 16 + hi * 8); }
    f32x16 o[4];
#pragma unroll
    for (int d = 0; d < 4; ++d)
#pragma unroll
        for (int i = 0; i < 16; ++i) o[d][i] = 0.f;
    float m_reg = -1e30f, l_reg = 0.f;
    const float slope2 = __builtin_amdgcn_exp2f(-(float)(h + 1)) * LOG2E;
    const int vb0 = (int)(uintptr_t)(lds + L_V) + v_rd_base(lane);
    if (!pre) stage_load(tr, base + (size_t)(j * 256) * NQKV + 4096, base + (size_t)(j * 256) * NQKV + 5120, tid);
    if (hn) ent_next = moba_entry(nlist, nn, nown, nj, ei);
    for (int jt = 0; jt < 4; ++jt) {
        if (jt) __syncthreads();
        const int kbase = j * 256 + jt * 64;
        stage_write(lds, tr, tid);
        if (jt < 3) stage_load(tr, base + (size_t)(kbase + 64) * NQKV + 4096, base + (size_t)(kbase + 64) * NQKV + 5120, tid);
        __syncthreads();
        if (own_unit && jt * 64 > wid * 32 + 31) continue;
        if (!own_unit && wid * 32 >= n) continue;
        f32x16 p0, p1; __builtin_amdgcn_s_setprio(1); qkt(p0, p1, lds + L_K, qr, r32, hi); __builtin_amdgcn_s_setprio(0);
        const int d0i = kbase + 4 * hi - qpos;
        float pmax = -1e30f;
#pragma unroll
        for (int r = 0; r < 16; ++r) {
            const int c = (r & 3) + 8 * (r >> 2);
            { const int x = d0i + c; const float s = fmaf(slope2, (float)x, p0[r]); p0[r] = (x <= 0) ? s : -1e30f; pmax = fmaxf(pmax, p0[r]); }
            { const int x = d0i + 32 + c; const float s = fmaf(slope2, (float)x, p1[r]); p1[r] = (x <= 0) ? s : -1e30f; pmax = fmaxf(pmax, p1[r]); }
        }
        pmax = fmaxf(pmax, pair_other(pmax, hi));
        float mn, alpha;
        if (__builtin_amdgcn_ballot_w64(pmax - m_reg > THR2) == 0ull) { mn = m_reg; alpha = 1.f; }
        else { mn = fmaxf(m_reg, pmax); alpha = __builtin_amdgcn_exp2f(m_reg - mn); m_reg = mn; }
        float ps = 0.f;
#pragma unroll
        for (int r = 0; r < 16; ++r) { p0[r] = __builtin_amdgcn_exp2f(p0[r] - mn); p1[r] = __builtin_amdgcn_exp2f(p1[r] - mn); ps += p0[r] + p1[r]; }
        ps += pair_other(ps, hi);
        l_reg = l_reg * alpha + ps;
        if (__builtin_amdgcn_ballot_w64(alpha < 1.f) != 0ull) {
            if (hi == 0) al_l[r32] = alpha;
            asm volatile("s_waitcnt lgkmcnt(0)" ::: "memory");
#pragma unroll
            for (int r = 0; r < 16; ++r) { const float al = al_l[crow(r, hi)];
#pragma unroll
                for (int d = 0; d < 4; ++d) o[d][r] *= al; }
        }
        bf16x8 pa0, pa1, pa2, pa3; pack_p(p0, p1, pa0, pa1, pa2, pa3);
        __builtin_amdgcn_s_setprio(1); pv_d0(o, vb0, pa0, pa1, pa2, pa3); __builtin_amdgcn_s_setprio(0);
    }
    if (hn) {
        const int nqpos = ent_next & 0xffff; const bf16* nbase = qkv + (size_t)(nbh >> 3) * SEQ * NQKV + (nbh & 7) * 128;
#pragma unroll
        for (int d0 = 0; d0 < 8; ++d0) qr[d0] = *(const bf16x8*)(nbase + (size_t)nqpos * NQKV + 3072 + d0 * 16 + hi * 8);
        stage_load(tr, nbase + (size_t)(nj * 256) * NQKV + 4096, nbase + (size_t)(nj * 256) * NQKV + 5120, tid);
    }
    if (hi == 0) { li_l[r32] = l_reg; if (evalid) { f32x2 ml; ml.x = m_reg; ml.y = l_reg; *(f32x2*)(pml + 2 * (size_t)pslot) = ml; } }
    asm volatile("s_waitcnt lgkmcnt(0)" ::: "memory");
#pragma unroll
    for (int r = 0; r < 16; ++r) {
        const int rw = crow(r, hi); const int ps_ = tb[rw]; const float rl = __builtin_amdgcn_rcpf(li_l[rw]);
        if (ps_ >= 0) { bf16* orow = po + (size_t)ps_ * 128 + r32;
            orow[0] = (bf16)f2bf(o[0][r] * rl); orow[32] = (bf16)f2bf(o[1][r] * rl); orow[64] = (bf16)f2bf(o[2][r] * rl); orow[96] = (bf16)f2bf(o[3][r] * rl); }
    }
}
}

__device__ __forceinline__ void unpack8(const u32x4 w, float (&f)[8]) { f[0] = bf_lo(w.x); f[1] = bf_hi(w.x); f[2] = bf_lo(w.y); f[3] = bf_hi(w.y); f[4] = bf_lo(w.z); f[5] = bf_hi(w.z); f[6] = bf_lo(w.w); f[7] = bf_hi(w.w); }
__device__ __forceinline__ float dot8(const float (&q)[8], const float (&k)[8]) { float s = q[0] * k[0];
#pragma unroll
    for (int j = 1; j < 8; ++j) s = fmaf(q[j], k[j], s); return s; }
__device__ __forceinline__ bool gate_better(float v, int i, float w, int j) { return (v > w) || (v == w && i < j); }
#define TOP3_INSERT(ok, g, n) do { const float g_ = (g); const int n_ = (n); const bool ok_ = (ok); \
    const bool b0_ = ok_ && gate_better(g_, n_, v0, i0), b1_ = ok_ && gate_better(g_, n_, v1, i1), b2_ = ok_ && gate_better(g_, n_, v2, i2); \
    v2 = b1_ ? v1 : (b2_ ? g_ : v2); i2 = b1_ ? i1 : (b2_ ? n_ : i2); \
    v1 = b0_ ? v0 : (b1_ ? g_ : v1); i1 = b0_ ? i0 : (b1_ ? n_ : i1); \
    v0 = b0_ ? g_ : v0; i0 = b0_ ? n_ : i0; } while (0)
__device__ __forceinline__ void p3_gate_tile(const Args& a, int bh, int qt, int lane) {
    const bf16* qkv = (const bf16*)(a.ws + WS_QKV); const float* km = (const float*)(a.ws + WS_KMEAN);
    unsigned* mcnt = (unsigned*)(a.ws + WS_CTL) + CW_MCNT; int* mlist = (int*)(a.ws + WS_MLIST);
    const int b = bh >> 3, h = bh & 7, r32 = lane & 31, hi = lane >> 5, t0 = 32 * qt, own = t0 >> 8, t = t0 + r32;
    if (own == 0) return;
    f32x16 p;
#pragma unroll
    for (int i = 0; i < 16; ++i) p[i] = 0.f;
    const float* kp = km + ((size_t)bh * 32 + r32) * 128 + hi * 8;
    const bf16* qp = qkv + (size_t)(b * SEQ + t) * NQKV + 3072 + h * 128 + hi * 8;
#pragma unroll
    for (int d0 = 0; d0 < 8; ++d0) {
        const f32x4 k0 = *(const f32x4*)(kp + d0 * 16), k1 = *(const f32x4*)(kp + d0 * 16 + 4);
        u32x4 kw; kw.x = pk2(k0.x, k0.y); kw.y = pk2(k0.z, k0.w); kw.z = pk2(k1.x, k1.y); kw.w = pk2(k1.z, k1.w);
        const bf16x8 qf = *(const bf16x8*)(qp + d0 * 16);
        p = __builtin_amdgcn_mfma_f32_32x32x16_bf16(__builtin_bit_cast(bf16x8, kw), qf, p, 0, 0, 0);
    }
    float v0 = -INFINITY, v1 = -INFINITY, v2 = -INFINITY; int i0 = 64, i1 = 64, i2 = 64;
#pragma unroll
    for (int r = 0; r < 16; ++r) { const int n = (r & 3) + 8 * (r >> 2) + 4 * hi; TOP3_INSERT(n < own, p[r], n); }
    { const float w0 = mix::pair_other(v0, hi), w1 = mix::pair_other(v1, hi), w2 = mix::pair_other(v2, hi);
      const int j0 = __builtin_bit_cast(int, mix::pair_other(__builtin_bit_cast(float, i0), hi)), j1 = __builtin_bit_cast(int, mix::pair_other(__builtin_bit_cast(float, i1), hi)), j2 = __builtin_bit_cast(int, mix::pair_other(__builtin_bit_cast(float, i2), hi));
      TOP3_INSERT(j0 < 64, w0, j0); TOP3_INSERT(j1 < 64, w1, j1); TOP3_INSERT(j2 < 64, w2, j2); }
    const int nsel = own < 3 ? own : 3;
    const bool ql = hi == 0;
    const bool s1 = nsel > 1, s2 = nsel > 2;
    const unsigned long long ltmask = (1ull << lane) - 1ull;
    int mycount = 0, r0 = 0, r1 = 0, r2 = 0;
    for (int n = 0; n < own; ++n) {
        const unsigned long long mk = __builtin_amdgcn_ballot_w64(ql && (i0 == n || (s1 && i1 == n) || (s2 && i2 == n)));
        const int c = __builtin_popcountll(mk), rk = __builtin_popcountll(mk & ltmask);
        if (lane == n) mycount = c;
        if (i0 == n) r0 = rk; if (i1 == n) r1 = rk; if (i2 == n) r2 = rk;
    }
    int basev = 0;
    if (lane < own && mycount > 0) basev = (int)__hip_atomic_fetch_add(mcnt + 16 * (bh * 32 + lane), (unsigned)mycount, RLX_AGENT);
    const int q0 = __shfl(basev, i0 & 31) + r0, q1 = __shfl(basev, i1 & 31) + r1, q2 = __shfl(basev, i2 & 31) + r2;
    if (ql) {
        mlist[(size_t)(bh * 32 + i0) * SEQ + q0] = t | (0 << 16);
        if (s1) mlist[(size_t)(bh * 32 + i1) * SEQ + q1] = t | (1 << 16);
        if (s2) mlist[(size_t)(bh * 32 + i2) * SEQ + q2] = t | (2 << 16);
    }
}
__device__ __forceinline__ void p3_sb_and_gate(const Args& a, LAS unsigned char* lds, int G, int wg, int gw, int NGW, int lane) {
    for (int it = gw; it < 16 * (SEQ / 32); it += NGW) p3_gate_tile(a, it >> 8, it & 255, lane);
}
__device__ __forceinline__ void p4_moba(const Args& a, LAS unsigned char* lds, int G, int wg) {
    const unsigned* mcnt = (const unsigned*)(a.ws + WS_CTL) + CW_MCNT; const int* mlist = (const int*)(a.ws + WS_MLIST);
    LAS int* pre = (LAS int*)(lds + mix::L_PRE);
    const int tid = threadIdx.x;
    __syncthreads();
    if (tid < 64) {
        int c[8], s = 0;
#pragma unroll
        for (int i = 0; i < 8; ++i) { c[i] = ((int)mcnt[16 * (tid * 8 + i)] + 255) >> 8; s += c[i]; }
        int inc = s;
#pragma unroll
        for (int o = 1; o < 64; o <<= 1) { const int v = __shfl_up(inc, o); if (tid >= o) inc += v; }
        int run = inc - s;
#pragma unroll
        for (int i = 0; i < 8; ++i) { pre[tid * 8 + i] = run; run += c[i]; }
        if (tid == 63) pre[512] = run;
    }
    __syncthreads();
    const int usel = pre[512], total = usel + 512;
#define P4_DECODE(uu_, k_, n_, own_, lp_) do { const int u_ = (uu_) - 16 * 32; \
        if (u_ < usel) { int lo_ = 0, hi_ = 511; while (lo_ < hi_) { const int mid_ = (lo_ + hi_ + 1) >> 1; if (pre[mid_] <= u_) lo_ = mid_; else hi_ = mid_ - 1; } \
            k_ = __builtin_amdgcn_readfirstlane(lo_); const int c_ = u_ - pre[k_]; const int cnt_ = (int)mcnt[16 * k_]; \
            lp_ = mlist + (size_t)k_ * SEQ + c_ * 256; n_ = (cnt_ - c_ * 256) < 256 ? (cnt_ - c_ * 256) : 256; own_ = false; } \
        else { k_ = u_ - usel; lp_ = nullptr; n_ = 256; own_ = true; } } while (0)
    int uu = wg;
    for (; uu < 16 * 32; uu += G) { const unsigned pb41 = pb_begin(41); mix::sb_unit(a, lds, uu >> 5, uu & 31); pb_end(41, pb41); }
    const int ei = (tid >> 6) * 32 + (tid & 31);
    int ent = 0; bool have = false;
    int k = 0, n = 0; bool own = false; const int* lp = nullptr;
    bf16x8 qr[8]; mix::TileRegs tr;
#pragma unroll
    for (int d0 = 0; d0 < 8; ++d0) qr[d0] = (bf16x8){0, 0, 0, 0, 0, 0, 0, 0};
    tr.k0 = tr.k1 = tr.v0 = tr.v1 = (u32x4){0u, 0u, 0u, 0u};
    for (; uu < total + 16 * 32; uu += G) {
        if (!have) { P4_DECODE(uu, k, n, own, lp); ent = mix::moba_entry(lp, n, own, k & 31, ei); }
        const bool hn = uu + G < total + 16 * 32;
        int nk = 0, nn = 0; bool nown = false; const int* nlp = nullptr; if (hn) P4_DECODE(uu + G, nk, nn, nown, nlp);
        int ent_next = 0;
        const unsigned pb42 = pb_begin(42); mix::moba_unit(a, lds, k >> 5, k & 31, ent, n, own, qr, tr, have, hn, nlp, nn, nown, nk >> 5, nk & 31, ent_next); pb_end(42, pb42);
        ent = ent_next; have = hn; k = nk; n = nn; own = nown; lp = nlp;
    }
#undef P4_DECODE
}
__device__ __forceinline__ void p5_combine(const Args& a, int gw, int NGW, int lane) {
    const bf16* po = (const bf16*)(a.ws + WS_MPO); const float* pml = (const float*)(a.ws + WS_MPML); bf16* mixed = (bf16*)(a.ws + WS_MIXED);
    const int sub = lane >> 4, dl = lane & 15;
    const int total = 16 * (SEQ / 4);
    const bool ginv = (NGW & 15) == 0;
    f32x4 g0 = {0.f, 0.f, 0.f, 0.f}, g1 = g0;
    if (ginv) { const float* gain = a.norm_moba + (gw & 7) * 128 + 8 * dl; g0 = *(const f32x4*)gain; g1 = *(const f32x4*)(gain + 4); }
    f32x2 ml[4]; u32x4 pw[4];
#pragma unroll
    for (int s = 0; s < 4; ++s) { ml[s] = (f32x2){-1e30f, 0.f}; pw[s] = (u32x4){0u, 0u, 0u, 0u}; }
#define P5_ISSUE(it_) do { const int bh_ = (it_) & 15, t_ = 4 * ((it_) >> 4) + sub, own_ = t_ >> 8, nsel_ = own_ < 3 ? own_ : 3; const size_t ps_ = ((size_t)(bh_ * SEQ + t_)) << 2; \
        _Pragma("unroll") for (int s = 0; s < 4; ++s) { const bool ok_ = (s == 3) || (s < nsel_); ml[s] = ok_ ? *(const f32x2*)(pml + 2 * (ps_ + s)) : (f32x2){-1e30f, 0.f}; \
            if (ok_) pw[s] = __builtin_nontemporal_load((const GAS u32x4*)(po + (ps_ + s) * 128 + 8 * dl)); } } while (0)
    if (gw < total) P5_ISSUE(gw);
    for (int it = gw; it < total; it += NGW) {
        const int bh = it & 15, t = 4 * (it >> 4) + sub, b = bh >> 3, h = bh & 7, own = t >> 8, nsel = own < 3 ? own : 3;
        float M = -1e30f;
#pragma unroll
        for (int s = 0; s < 4; ++s) M = fmaxf(M, ml[s].x);
        float w[4], W = 0.f;
#pragma unroll
        for (int s = 0; s < 4; ++s) { w[s] = ml[s].y * __builtin_amdgcn_exp2f(ml[s].x - M); W += w[s]; }
        const float iw = 1.f / W;
        float o[8] = {0, 0, 0, 0, 0, 0, 0, 0};
#pragma unroll
        for (int s = 0; s < 4; ++s) { const bool ok = (s == 3) || (s < nsel);
            if (ok) { float f[8]; unpack8(pw[s], f); const float ws_ = w[s] * iw;
#pragma unroll
                for (int jj = 0; jj < 8; ++jj) o[jj] = fmaf(ws_, f[jj], o[jj]); } }
        if (it + NGW < total) P5_ISSUE(it + NGW);
        float ss = 0.f;
#pragma unroll
        for (int jj = 0; jj < 8; ++jj) ss = fmaf(o[jj], o[jj], ss);
        ss = reduce16(ss) * (1.f / 128.f);
        const float r = 1.f / sqrtf(ss + RMS_EPS);
        if (!ginv) { const float* gain = a.norm_moba + h * 128 + 8 * dl; g0 = *(const f32x4*)gain; g1 = *(const f32x4*)(gain + 4); }
        u32x4 wv; wv.x = pk2(o[0] * r * g0.x, o[1] * r * g0.y); wv.y = pk2(o[2] * r * g0.z, o[3] * r * g0.w); wv.z = pk2(o[4] * r * g1.x, o[5] * r * g1.y); wv.w = pk2(o[6] * r * g1.z, o[7] * r * g1.w);
        *(u32x4*)(mixed + (size_t)(b * SEQ + t) * D + 1024 + h * 128 + 8 * dl) = wv;
    }
#undef P5_ISSUE
}

constexpr int LNT_STRIDE = 2052;
__device__ __forceinline__ void ln1_load(const bf16* src, int lane, u32x2 (&w)[8]) {
    const GAS u32x2* xr = (const GAS u32x2*)src + lane;
#pragma unroll
    for (int j = 0; j < 8; ++j) w[j] = __builtin_nontemporal_load(xr + 64 * j);
}
#define LN1_OPAQUE(w) do { _Pragma("unroll") for (int j_ = 0; j_ < 8; ++j_) asm volatile("" : "+v"(w[j_].x), "+v"(w[j_].y)); } while (0)
__device__ __forceinline__ void ln1_row(u32x2 (&w)[8], const LAS float* gb, float* dst_stat, unsigned char* dst_q, LAS float* trow, int lane) {
    float s = 0.f;
#pragma unroll
    for (int j = 0; j < 8; ++j) s += (bf_lo(w[j].x) + bf_hi(w[j].x)) + (bf_lo(w[j].y) + bf_hi(w[j].y));
    const float mean = wave_sum(s) * (1.f / D); float s2 = 0.f;
    LN1_OPAQUE(w);
#pragma unroll
    for (int j = 0; j < 8; ++j) { const float x0 = bf_lo(w[j].x) - mean, x1 = bf_hi(w[j].x) - mean, x2 = bf_lo(w[j].y) - mean, x3 = bf_hi(w[j].y) - mean; s2 += (x0 * x0 + x1 * x1) + (x2 * x2 + x3 * x3); }
    const float rstd = 1.f / sqrtf(wave_sum(s2) * (1.f / D) + LN_EPS);
    LN1_OPAQUE(w);
#pragma unroll
    for (int j = 0; j < 8; ++j) {
        const f32x4 gg = *(const LAS f32x4*)(gb + 4 * (lane + 64 * j)), bb = *(const LAS f32x4*)(gb + D + 4 * (lane + 64 * j));
        f32x4 y; y.x = (bf_lo(w[j].x) - mean) * rstd * gg.x + bb.x; y.y = (bf_hi(w[j].x) - mean) * rstd * gg.y + bb.y; y.z = (bf_lo(w[j].y) - mean) * rstd * gg.z + bb.z; y.w = (bf_hi(w[j].y) - mean) * rstd * gg.w + bb.w;
        *(LAS f32x4*)(trow + 4 * (lane + 64 * j)) = y;
        ((GAS unsigned*)dst_q)[lane + 64 * j] = pack_fp8x4(y.x * XSCALE, y.y * XSCALE, y.z * XSCALE, y.w * XSCALE); }
    if (lane == 0) { f32x2 st; st.x = mean; st.y = rstd; *(f32x2*)dst_stat = st; }
}
constexpr int LNP_OFF = 136192;
constexpr int LSUM_OFF = LNP_OFF + 8192;
constexpr int LBR_OFF = LSUM_OFF + 16 * 36 * 4;
constexpr int LGB1_OFF = LBR_OFF + 128;
static_assert(LGB1_OFF + 16384 <= LDS_BYTES, "gamma | beta");
__device__ __forceinline__ void router_top4(const Args& a, LAS unsigned char* lds, int r0, int lane) {
    int* rowtok = (int*)(a.ws + WS_ROWTOK); float* rowg = (float*)(a.ws + WS_ROWG); int* toksl = (int*)(a.ws + WS_TOKSL);
    unsigned* ecnt = (unsigned*)(a.ws + WS_CTL) + CW_ECNT;
    const LAS float* Pp = (const LAS float*)(lds + LNP_OFF); LAS float* Ls = (LAS float*)(lds + LSUM_OFF); const LAS float* Lb = (const LAS float*)(lds + LBR_OFF);
    const int row = lane & 15; const bool tl = lane < 16;
    { const int q = lane >> 4;
      f32x4 s0 = *(const LAS f32x4*)(Lb + 8 * q), s1 = *(const LAS f32x4*)(Lb + 8 * q + 4);
#pragma unroll
      for (int w = 0; w < 4; ++w) { if (w == 2) __builtin_amdgcn_sched_barrier(0); s0 += *(const LAS f32x4*)(Pp + (w * 16 + row) * 32 + 8 * q); s1 += *(const LAS f32x4*)(Pp + (w * 16 + row) * 32 + 8 * q + 4); }
      *(LAS f32x4*)(Ls + row * 36 + 8 * q) = s0; *(LAS f32x4*)(Ls + row * 36 + 8 * q + 4) = s1; }
    asm volatile("s_waitcnt lgkmcnt(0)" ::: "memory");
    float v0 = -INFINITY, v1 = -INFINITY, v2 = -INFINITY, v3 = -INFINITY; int e0 = 0, e1 = 0, e2 = 0, e3 = 0;
#pragma unroll
    for (int k = 0; k < 8; ++k) { if ((k & 3) == 0) __builtin_amdgcn_sched_barrier(0); const f32x4 gv = *(const LAS f32x4*)(Ls + row * 36 + 4 * k);
#pragma unroll
        for (int i = 0; i < 4; ++i) { const float g = gv[i]; const int e = 4 * k + i;
            const bool c0 = g > v0, c1 = g > v1, c2 = g > v2, c3 = g > v3;
            v3 = c2 ? v2 : (c3 ? g : v3); e3 = c2 ? e2 : (c3 ? e : e3);
            v2 = c1 ? v1 : (c2 ? g : v2); e2 = c1 ? e1 : (c2 ? e : e2);
            v1 = c0 ? v0 : (c1 ? g : v1); e1 = c0 ? e0 : (c1 ? e : e1);
            v0 = c0 ? g : v0; e0 = c0 ? e : e0; } }
    const float p1 = __expf(v1 - v0), p2 = __expf(v2 - v0), p3 = __expf(v3 - v0), inv = 1.f / (1.f + p1 + p2 + p3);
    const unsigned emask = (1u << e0) | (1u << e1) | (1u << e2) | (1u << e3);
    unsigned mt[16];
#pragma unroll
    for (int t = 0; t < 16; ++t) mt[t] = (unsigned)__builtin_amdgcn_readlane((int)emask, t);
    int mycount = 0;
#pragma unroll
    for (int t = 0; t < 16; ++t) mycount += (int)((mt[t] >> (lane & 31)) & 1u);
    int basev = 0;
    { int ln = lane; asm volatile("" : "+v"(ln));
      if (ln < 32 && mycount > 0) basev = (int)__hip_atomic_fetch_add(ecnt + 32 * ln, (unsigned)mycount, RLX_AGENT); }
    int r0k = 0, r1k = 0, r2k = 0, r3k = 0;
#pragma unroll
    for (int t = 0; t < 15; ++t) { const unsigned b = (t < lane) ? mt[t] : 0u;
        r0k += (int)((b >> e0) & 1u); r1k += (int)((b >> e1) & 1u); r2k += (int)((b >> e2) & 1u); r3k += (int)((b >> e3) & 1u); }
    const int q0 = __shfl(basev, e0) + r0k, q1 = __shfl(basev, e1) + r1k, q2 = __shfl(basev, e2) + r2k, q3 = __shfl(basev, e3) + r3k;
    if (tl) {
        const int tok = r0 + lane;
        rowtok[e0 * ECAP + q0] = tok; rowg[e0 * ECAP + q0] = inv;
        rowtok[e1 * ECAP + q1] = tok; rowg[e1 * ECAP + q1] = p1 * inv;
        rowtok[e2 * ECAP + q2] = tok; rowg[e2 * ECAP + q2] = p2 * inv;
        rowtok[e3 * ECAP + q3] = tok; rowg[e3 * ECAP + q3] = p3 * inv;
        int4 sl; sl.x = (e0 << 16) | q0; sl.y = (e1 << 16) | q1; sl.z = (e2 << 16) | q2; sl.w = (e3 << 16) | q3;
        *(int4*)(toksl + 4 * tok) = sl;
    }
}
__device__ __forceinline__ void p7_ln1_router(const Args& a, LAS unsigned char* lds, int vcu, int G, int wave, int lane_) {
    const int lane = lane_;
    const bf16* hh = (const bf16*)(a.ws + WS_H); float* x1st = (float*)(a.ws + WS_X1B); unsigned char* x1q = (unsigned char*)(a.ws + WS_X1Q);
    LAS float* T = (LAS float*)(lds + RING_OFF); LAS float* Pp = (LAS float*)(lds + LNP_OFF);
    const int n16 = lane & 15, kq = lane >> 4;
    LAS float* gb = (LAS float*)(lds + LGB1_OFF);
    { const int tid = wave * 64 + lane;
      for (int i = tid; i < D / 4; i += 512) { *(LAS f32x4*)(gb + 4 * i) = ((const GAS f32x4*)a.ln1_g)[i]; *(LAS f32x4*)(gb + D + 4 * i) = ((const GAS f32x4*)a.ln1_b)[i]; }
      if (tid < 8) *(LAS f32x4*)(lds + LBR_OFF + 16 * tid) = ((const GAS f32x4*)a.b_router)[tid]; }
    constexpr int NRR = 0;
    float breg[64 - NRR][2];
#pragma unroll
    for (int sI = NRR; sI < 64; ++sI) { const float* bp = a.w_router + (size_t)(256 * wave + 4 * sI + kq) * NE + n16; breg[sI - NRR][0] = bp[0]; breg[sI - NRR][1] = bp[16]; }
    const bool has3 = wave == 4;
    const int rl0 = 2 * (wave - 1), rl2 = 14;
    u32x2 raw[2][8]; unsigned touch = 0u;
    if (wave != 0 && vcu < M / 16) {
        ln1_load(hh + (size_t)(vcu * 16 + rl0) * D, lane, raw[0]); ln1_load(hh + (size_t)(vcu * 16 + rl0 + 1) * D, lane, raw[1]);
        if (has3) touch = *(const GAS unsigned*)((const unsigned char*)(hh + (size_t)(vcu * 16 + 14) * D) + 128 * lane); }
    __syncthreads();
    int prev_r0 = -1;
    for (int tile = vcu;; tile += G) {
        const bool has = tile < M / 16;
        const int r0 = tile * 16;
        if (wave == 0) { const unsigned pb72 = pb_begin(72); int lane = lane_; asm volatile("" : "+v"(lane)); if (prev_r0 >= 0) router_top4(a, lds, prev_r0, lane); pb_end(72, pb72); }
        else if (has) { const unsigned pb73 = pb_begin(73);
            asm volatile("" :: "v"(touch));
            int lane = lane_; asm volatile("" : "+v"(lane));
            ln1_row(raw[0], gb, x1st + 2 * (size_t)(r0 + rl0), x1q + (size_t)(r0 + rl0) * D, T + rl0 * LNT_STRIDE, lane);
            if (has3) ln1_load(hh + (size_t)(r0 + rl2) * D, lane, raw[0]);
            ln1_row(raw[1], gb, x1st + 2 * (size_t)(r0 + rl0 + 1), x1q + (size_t)(r0 + rl0 + 1) * D, T + (rl0 + 1) * LNT_STRIDE, lane);
            if (has3) { ln1_load(hh + (size_t)(r0 + rl2 + 1) * D, lane, raw[1]);
                ln1_row(raw[0], gb, x1st + 2 * (size_t)(r0 + rl2), x1q + (size_t)(r0 + rl2) * D, T + rl2 * LNT_STRIDE, lane);
                ln1_row(raw[1], gb, x1st + 2 * (size_t)(r0 + rl2 + 1), x1q + (size_t)(r0 + rl2 + 1) * D, T + (rl2 + 1) * LNT_STRIDE, lane); }
            pb_end(73, pb73); }
        if (!has) break;
        asm volatile("s_waitcnt lgkmcnt(0)\n\ts_barrier" ::: "memory");
        const unsigned pb74 = pb_begin(74);
        float bt[NRR ? NRR : 1][2];
        { int kqo = kq; asm volatile("" : "+v"(kqo)); const float* bp = a.w_router + (size_t)(256 * wave + kqo) * NE + n16;
#pragma unroll
          for (int sI = 0; sI < NRR; ++sI) { bt[sI][0] = bp[4 * sI * NE]; bt[sI][1] = bp[4 * sI * NE + 16]; } }
        __builtin_amdgcn_sched_barrier(0);
        if (wave != 0 && tile + G < M / 16) { const bf16* nx = hh + (size_t)(r0 + 16 * G) * D;
            ln1_load(nx + (size_t)rl0 * D, lane, raw[0]); ln1_load(nx + (size_t)(rl0 + 1) * D, lane, raw[1]);
            if (has3) { int lo = lane_; asm volatile("" : "+v"(lo)); touch = *(const GAS unsigned*)((const unsigned char*)(nx + (size_t)14 * D) + 128 * lo); } }
        __builtin_amdgcn_sched_barrier(0);
        f32x4 acc0 = {0.f, 0.f, 0.f, 0.f}, acc1 = {0.f, 0.f, 0.f, 0.f};
        const LAS float* ap = T + n16 * LNT_STRIDE + 256 * wave + kq;
#pragma unroll
        for (int sI = NRR; sI < 64; ++sI) { if ((sI & 7) == (NRR & 7)) __builtin_amdgcn_sched_barrier(0);
            const float av = ap[4 * sI];
            acc0 = __builtin_amdgcn_mfma_f32_16x16x4f32(av, breg[sI - NRR][0], acc0, 0, 0, 0);
            acc1 = __builtin_amdgcn_mfma_f32_16x16x4f32(av, breg[sI - NRR][1], acc1, 0, 0, 0); }
        __builtin_amdgcn_sched_barrier(0);
#pragma unroll
        for (int sI = 0; sI < NRR; ++sI) { const float av = ap[4 * sI];
            acc0 = __builtin_amdgcn_mfma_f32_16x16x4f32(av, bt[sI][0], acc0, 0, 0, 0);
            acc1 = __builtin_amdgcn_mfma_f32_16x16x4f32(av, bt[sI][1], acc1, 0, 0, 0); }
        { LAS float* pw = Pp + ((wave & 3) * 16 + 4 * kq) * 32 + n16;
          if (wave >= 4) {
#pragma unroll
              for (int i = 0; i < 4; ++i) { pw[i * 32] = acc0[i]; pw[i * 32 + 16] = acc1[i]; } }
          asm volatile("s_waitcnt lgkmcnt(0)\n\ts_barrier" ::: "memory");
          if (wave < 4) {
#pragma unroll
              for (int i = 0; i < 4; ++i) { pw[i * 32] = acc0[i] + pw[i * 32]; pw[i * 32 + 16] = acc1[i] + pw[i * 32 + 16]; } } }
        pb_end(74, pb74);
        asm volatile("s_waitcnt lgkmcnt(0)\n\ts_barrier" ::: "memory");
        prev_r0 = r0;
    }
    __syncthreads();
}

__device__ __forceinline__ void p9_ln2(const Args& a, LAS unsigned char* lds, const LAS int* tab, int gw, int NGW, int lane) {
    const bf16* hh = (const bf16*)(a.ws + WS_H); const float* x1st = (const float*)(a.ws + WS_X1B); const unsigned char* Y = (const unsigned char*)(a.ws + WS_Y); const int* toksl = (const int*)(a.ws + WS_TOKSL);
    bf16* x2b = (bf16*)(a.ws + WS_X2B); unsigned char* x2q = (unsigned char*)(a.ws + WS_X2Q);
    LAS float* gb = (LAS float*)(lds + RING_OFF);
    LAS float* gb1 = gb + 2 * D;
    for (int i = threadIdx.x; i < D / 4; i += 512) { *(LAS f32x4*)(gb + 4 * i) = ((const GAS f32x4*)a.ln2_g)[i]; *(LAS f32x4*)(gb + D + 4 * i) = ((const GAS f32x4*)a.ln2_b)[i];
        *(LAS f32x4*)(gb1 + 4 * i) = ((const GAS f32x4*)a.ln1_g)[i]; *(LAS f32x4*)(gb1 + D + 4 * i) = ((const GAS f32x4*)a.ln1_b)[i]; }
    __syncthreads();
    u32x2 xw[8]; unsigned yw[4][8]; int4 sln = {0, 0, 0, 0}; f32x2 stx = {0.f, 1.f};
#define LN2_ISSUE(mm, sl_) do { const int4 s_ = (sl_); const size_t r0_ = (size_t)(tab[s_.x >> 16] * 256 + (s_.x & 0xffff)), r1_ = (size_t)(tab[s_.y >> 16] * 256 + (s_.y & 0xffff)), \
        r2_ = (size_t)(tab[s_.z >> 16] * 256 + (s_.z & 0xffff)), r3_ = (size_t)(tab[s_.w >> 16] * 256 + (s_.w & 0xffff)); \
        const GAS u32x2* xr_ = (const GAS u32x2*)(hh + (size_t)(mm) * D) + lane; stx = *(const f32x2*)(x1st + 2 * (size_t)(mm)); \
        _Pragma("unroll") for (int j = 0; j < 8; ++j) { xw[j] = __builtin_nontemporal_load(xr_ + 64 * j); \
            yw[0][j] = __builtin_nontemporal_load((const GAS unsigned*)(Y + r0_ * D) + lane + 64 * j); yw[1][j] = __builtin_nontemporal_load((const GAS unsigned*)(Y + r1_ * D) + lane + 64 * j); \
            yw[2][j] = __builtin_nontemporal_load((const GAS unsigned*)(Y + r2_ * D) + lane + 64 * j); yw[3][j] = __builtin_nontemporal_load((const GAS unsigned*)(Y + r3_ * D) + lane + 64 * j); } } while (0)
    if (gw < M) { const int4 sl0 = *(const int4*)(toksl + 4 * gw); LN2_ISSUE(gw, sl0); if (gw + NGW < M) sln = *(const int4*)(toksl + 4 * (gw + NGW)); }
    for (int m = gw; m < M; m += NGW) {
        f32x4 v[8]; float s = 0.f;
#pragma unroll
        for (int j = 0; j < 8; ++j) { const f32x4 g1 = *(const LAS f32x4*)(gb1 + 4 * (lane + 64 * j)), b1 = *(const LAS f32x4*)(gb1 + D + 4 * (lane + 64 * j)); f32x4 t;
            t.x = ((bf_lo(xw[j].x) - stx.x) * stx.y * g1.x + b1.x) * DN_ALPHA; t.y = ((bf_hi(xw[j].x) - stx.x) * stx.y * g1.y + b1.y) * DN_ALPHA;
            t.z = ((bf_lo(xw[j].y) - stx.x) * stx.y * g1.z + b1.z) * DN_ALPHA; t.w = ((bf_hi(xw[j].y) - stx.x) * stx.y * g1.w + b1.w) * DN_ALPHA;
#pragma unroll
            for (int k = 0; k < 4; ++k) { const unsigned w = yw[k][j]; const f32x2 lo = __builtin_amdgcn_cvt_pk_f32_fp8(w, false), hi = __builtin_amdgcn_cvt_pk_f32_fp8(w, true);
                t.x = fmaf(lo.x, 1.f / YSCALE, t.x); t.y = fmaf(lo.y, 1.f / YSCALE, t.y); t.z = fmaf(hi.x, 1.f / YSCALE, t.z); t.w = fmaf(hi.y, 1.f / YSCALE, t.w); }
            v[j] = t; s += (t.x + t.y) + (t.z + t.w); }
        if (m + NGW < M) { LN2_ISSUE(m + NGW, sln); if (m + 2 * NGW < M) sln = *(const int4*)(toksl + 4 * (m + 2 * NGW)); }
        const float mean = wave_sum(s) * (1.f / D); float s2 = 0.f;
#pragma unroll
        for (int j = 0; j < 8; ++j) { v[j] = v[j] - mean; s2 += (v[j].x * v[j].x + v[j].y * v[j].y) + (v[j].z * v[j].z + v[j].w * v[j].w); }
        const float rstd = 1.f / sqrtf(wave_sum(s2) * (1.f / D) + LN_EPS);
#pragma unroll
        for (int j = 0; j < 8; ++j) { const f32x4 gg = *(const LAS f32x4*)(gb + 4 * (lane + 64 * j)), bb = *(const LAS f32x4*)(gb + D + 4 * (lane + 64 * j)); const f32x4 y = v[j] * rstd * gg + bb;
            u32x2 o; o.x = pk2(y.x, y.y); o.y = pk2(y.z, y.w); ((GAS u32x2*)(x2b + (size_t)m * D))[lane + 64 * j] = o;
            ((GAS unsigned*)(x2q + (size_t)m * D))[lane + 64 * j] = pack_fp8x4(y.x * XSCALE, y.y * XSCALE, y.z * XSCALE, y.w * XSCALE); }
    }
#undef LN2_ISSUE
    __syncthreads();
}

#ifndef REP_PHASE
#define REP_PHASE (-1)
#endif
constexpr int NPHASE = 13;
__global__ void __launch_bounds__(512, 2) fwd_kernel(Args args) {
    extern __shared__ __attribute__((aligned(16))) unsigned char lds_raw[];
    LAS unsigned char* lds = (LAS unsigned char*)lds_raw;
    volatile LAS unsigned* MISC = (volatile LAS unsigned*)(lds + MISC_OFF);
    const int tid = threadIdx.x, lane = tid & 63, wave = __builtin_amdgcn_readfirstlane(tid >> 6);
    const int G = gridDim.x; const int bx = blockIdx.x;
    const int vcu = (G % 8 == 0) ? (bx % 8) * (G / 8) + bx / 8 : bx;
    const int gw = vcu * 8 + wave, NGW = G * 8;
    unsigned char* ws = args.ws;
    unsigned* ctl = (unsigned*)(ws + WS_CTL);
    for (int u = tid; u < (LDS_BYTES - LDSCTL_OFF) / 4; u += 512) ((LAS unsigned*)(lds + LDSCTL_OFF))[u] = 0u;
    __syncthreads();
    const int lo = args.ph_lo, hi = args.ph_hi;
    const bool use_bar = (hi - lo) > 1;
    XcdBarrier bar; bar.bar = ctl + CW_BAR; bar.x = 0; bar.st = nullptr;
    if (use_bar) bar = xcd_barrier_post(ctl + CW_BAR, MISC + 8);
#ifdef ONLY_PHASE
#define IN(k) ((k) == ONLY_PHASE)
#else
#define IN(k) (lo <= (k) && (k) < hi)
#endif
#define SEAM(k) do { if (IN(k) && IN((k) + 1)) xcd_barrier(bar); } while (0)
    LAS int* moetab = (LAS int*)(lds + MOE_OFF);
    const bool cvon = (NGW == CV_LISTS);
    const bool cvfirst = ((bx >> 3) & 1) == 0;
    const int len_up = cvon ? cv_list_len(gw, CV_UP_END) : 0, len_all = cvon ? cv_list_len(gw, CV_BLOCKS) : 0;

    if (IN(0)) { const unsigned pbp_ = pb_begin(100); p0_prologue(args, lds, gw, NGW, wave, lane); pb_end(100, pbp_); SEAM(0); }
    if (IN(1)) { const unsigned pbp_ = pb_begin(101);
        if (cvon && cvfirst) cv_range(args, gw, 0, len_up, lane);
        { pg8::Gemm g{(const bf16*)(ws + WS_XB), (const bf16*)(ws + WS_WINT), D, 0, nullptr}; DenseSched S; S.init(M, NQKV, G, bx);
          EpiQKV E{(bf16*)(ws + WS_QKV), NQKV, true, (float*)(ws + WS_KMEAN)};
          pg8::gemm_phase<EpiQKV, DenseSched, false, true>(lds + RING_OFF, g, S, E); }
        { pg8::Gemm g{(const bf16*)(ws + WS_PB), (const bf16*)(ws + WS_WPLET), PLE, 0, nullptr}; DenseSched S; S.init(M, D, G, bx);
          EpiQKV E{(bf16*)(ws + WS_PLEB), D, false, nullptr};
          pg8::gemm_phase<EpiQKV, DenseSched, false, true>(lds + RING_OFF, g, S, E); }
        if (cvon && !cvfirst) cv_range(args, gw, 0, len_up, lane);
        pb_end(101, pbp_); SEAM(1);
    }
    if (IN(3)) { const unsigned pbp_ = pb_begin(103); p3_sb_and_gate(args, lds, G, bx, gw, NGW, lane); pb_end(103, pbp_); SEAM(3); }
    if (IN(4)) { const unsigned pbp_ = pb_begin(104); p4_moba(args, lds, G, bx); pb_end(104, pbp_); SEAM(4); }
    if (IN(5)) { const unsigned pbp_ = pb_begin(105); p5_combine(args, gw, NGW, lane); pb_end(105, pbp_); SEAM(5); }
    if (IN(6)) { const unsigned pbp_ = pb_begin(106);
        pg8::Gemm g{(const bf16*)(ws + WS_MIXED), (const bf16*)(ws + WS_WOUTT), D, 0, nullptr}; DenseSched S; S.init(M, D, G, bx);
        EpiH E{(const bf16*)(ws + WS_XB), (bf16*)(ws + WS_H)};
        pg8::gemm_phase<EpiH, DenseSched, false, true>(lds + RING_OFF, g, S, E);
        pb_end(106, pbp_); SEAM(6);
    }
    if (IN(7)) { const unsigned pbp_ = pb_begin(107); p7_ln1_router(args, lds, vcu, G, wave, lane); pb_end(107, pbp_); SEAM(7); }
    if (IN(8)) {
        if (!cvon) { for (int blk = gw; blk < CV_BLOCKS; blk += NGW) { P0Job j0; int it0; p0_locate_b(args, 2 * blk, j0, it0); f32x4 v0[16]; cv_load(j0, it0 >> 1, lane, v0); cv_store(j0, it0 >> 1, lane, v0); } SEAM(8); }
    }
    if (IN(9)) { const unsigned pbp_ = pb_begin(109);
        if (cvon && !cvfirst) cv_range(args, gw, len_up, len_all, lane);
        moe_table(moetab, ctl + CW_ECNT);
        pg8::Gemm g{(const bf16*)(ws + WS_X1Q), (const bf16*)(ws + WS_WUPT), D / 2, (size_t)2 * DFF * D / 2, (const int*)(ws + WS_ROWTOK)};
        MoeSched S{moetab, 2 * DFF / 256, G, bx};
        EpiUp E{(unsigned char*)(ws + WS_ACT), (const float*)(ws + WS_BUPP)};
        pg8::gemm_phase<EpiUp, MoeSched, true, true, true>(lds + RING_OFF, g, S, E);
        if (cvon && cvfirst) cv_range(args, gw, len_up, len_all, lane);
        pb_end(109, pbp_); SEAM(9);
    }
    if (IN(10)) { const unsigned pbp_ = pb_begin(110);
        if (!IN(9)) moe_table(moetab, ctl + CW_ECNT);
        pg8::Gemm g{(const bf16*)(ws + WS_ACT), (const bf16*)(ws + WS_WDNT), DFF / 2, (size_t)D * DFF / 2, nullptr};
        MoeSched S{moetab, D / 256, G, bx};
        EpiDown E{(unsigned char*)(ws + WS_Y), args.b_down, (const float*)(ws + WS_ROWG)};
        pg8::gemm_phase<EpiDown, MoeSched, false, true, true>(lds + RING_OFF, g, S, E);
        pb_end(110, pbp_); SEAM(10);
    }
    if (IN(11)) { const unsigned pbp_ = pb_begin(111); if (!IN(9) && !IN(10)) moe_table(moetab, ctl + CW_ECNT); p9_ln2(args, lds, moetab, gw, NGW, lane); pb_end(111, pbp_); SEAM(11); }
    if (IN(12)) { const unsigned pbp_ = pb_begin(112);
        pg8::Gemm g{(const bf16*)(ws + WS_X2Q), (const bf16*)(ws + WS_WGT), D / 2, 0, nullptr}; DenseSched S; S.init(M, D, G, bx);
        EpiOut E{args.out, args.b_ple_gate, (const bf16*)(ws + WS_PLEB), (const bf16*)(ws + WS_X2B)};
        pg8::gemm_phase<EpiOut, DenseSched, false, true, true>(lds + RING_OFF, g, S, E);
        pb_end(112, pbp_);
    }
#undef IN
#undef SEAM
}

#ifndef N_LAUNCHES
#define N_LAUNCHES 1
#endif
extern "C" void kernel_launch(void* const* d_in, const int* in_sizes, int n_in, void* d_out, int out_size, void* d_ws, size_t ws_size, hipStream_t stream) {
    static int grid = 0;
    if (grid == 0) {
        if (n_in != 19 || in_sizes[0] != M * D || out_size != M * D || ws_size < WS_END) { fprintf(stderr, "kernel_launch: unexpected shapes: n_in %d in0 %d out %d ws %zu (need %zu)\n", n_in, n_in > 0 ? in_sizes[0] : -1, out_size, ws_size, (size_t)WS_END); grid = -1; return; }
        int dev = 0, cus = 0, per_cu = 0;
        if (hipGetDevice(&dev) != hipSuccess || hipDeviceGetAttribute(&cus, hipDeviceAttributeMultiprocessorCount, dev) != hipSuccess) { grid = -1; return; }
        if (hipFuncSetAttribute((const void*)fwd_kernel, hipFuncAttributeMaxDynamicSharedMemorySize, LDS_BYTES) != hipSuccess) { fprintf(stderr, "kernel_launch: hipFuncSetAttribute failed\n"); grid = -1; return; }
        if (hipOccupancyMaxActiveBlocksPerMultiprocessor(&per_cu, (const void*)fwd_kernel, 512, LDS_BYTES) != hipSuccess || per_cu < 1) fprintf(stderr, "kernel_launch: occupancy query says %d\n", per_cu);
        (void)hipGetLastError();
        grid = cus;
    }
    if (grid < 0) return;
    if (hipMemsetAsync((char*)d_ws + WS_CTL, 0, CTL_ZERO_BYTES, stream) != hipSuccess) { fprintf(stderr, "kernel_launch: memset failed\n"); return; }
    Args a{};
    a.x = (const float*)d_in[0]; a.p = (const float*)d_in[1]; a.w_in = (const float*)d_in[2]; a.norm_sb = (const float*)d_in[3]; a.norm_moba = (const float*)d_in[4];
    a.w_out = (const float*)d_in[5]; a.ln1_g = (const float*)d_in[6]; a.ln1_b = (const float*)d_in[7]; a.w_router = (const float*)d_in[8]; a.b_router = (const float*)d_in[9];
    a.w_up = (const float*)d_in[10]; a.b_up = (const float*)d_in[11]; a.w_down = (const float*)d_in[12]; a.b_down = (const float*)d_in[13]; a.ln2_g = (const float*)d_in[14]; a.ln2_b = (const float*)d_in[15];
    a.w_ple = (const float*)d_in[16]; a.w_ple_gate = (const float*)d_in[17]; a.b_ple_gate = (const float*)d_in[18];
    a.out = (float*)d_out; a.ws = (unsigned char*)d_ws;
    if (N_LAUNCHES == 1) { a.ph_lo = 0; a.ph_hi = NPHASE; hipLaunchKernelGGL(fwd_kernel, dim3(grid), dim3(512), LDS_BYTES, stream, a); }
    else for (int li = 0; li < NPHASE; ++li) { a.ph_lo = li; a.ph_hi = li + 1; hipLaunchKernelGGL(fwd_kernel, dim3(grid), dim3(512), LDS_BYTES, stream, a); }
    const hipError_t le = hipPeekAtLastError();
    if (le != hipSuccess) fprintf(stderr, "kernel_launch: launch failed: %s\n", hipGetErrorName(le));
}
```
